# Optimizing an MI355X kernel written in HIP

```python
import math
import jax, jax.numpy as jnp
from jax import lax
import numpy as np

D_MODEL = 1024
BATCH = 8
SEQ = 4096
DEPTH = 4

HEAD_DIM = 64
HEADS_PER_GROUP = 4
GROUP_WIDTH = HEADS_PER_GROUP * HEAD_DIM
N_MIXERS = 4
D_MIX = N_MIXERS * GROUP_WIDTH

MLA_Q_RANK = 192
MLA_KV_RANK = 128
MLA_NOPE_DIM = HEAD_DIM
MLA_ROPE_DIM = 32
MLA_V_DIM = HEAD_DIM
ROPE_THETA = 10000.0

Q_BLOCK = 128

MOBA_BLOCK = 256
MOBA_TOPK = 3
MOBA_Q_CHUNK = 32

CONV_WIDTH = 31

NUM_BUCKETS = 32
MAX_DISTANCE = 1024

NORM_EPS = 1e-6

COLS_MLA = MLA_Q_RANK + MLA_KV_RANK + MLA_ROPE_DIM
COLS_SB = 3 * GROUP_WIDTH
COLS_MOBA = 3 * GROUP_WIDTH
COLS_CONV = 2 * GROUP_WIDTH
COLS_GATE = D_MIX
D_IN_PROJ = COLS_MLA + COLS_SB + COLS_MOBA + COLS_CONV + COLS_GATE
SPLITS = [COLS_MLA, COLS_MLA + COLS_SB, COLS_MLA + COLS_SB + COLS_MOBA,
          COLS_MLA + COLS_SB + COLS_MOBA + COLS_CONV]

kernel_name = "hymba_mla_stickbreak_moba_conformer"


def rms_norm(x, g):
    x32 = x.astype(jnp.float32)
    y = x32 * lax.rsqrt(jnp.mean(x32 * x32, axis=-1, keepdims=True) + NORM_EPS)
    return (y * g.astype(jnp.float32)).astype(x.dtype)


def layer_norm(x, g, b):
    x32 = x.astype(jnp.float32)
    mu = jnp.mean(x32, axis=-1, keepdims=True)
    xc = x32 - mu
    var = jnp.mean(xc * xc, axis=-1, keepdims=True)
    y = xc * lax.rsqrt(var + NORM_EPS)
    return (y * g.astype(jnp.float32) + b.astype(jnp.float32)).astype(x.dtype)


def split_heads(t, n_heads):
    B, S, E = t.shape
    return t.reshape(B, S, n_heads, E // n_heads).transpose(0, 2, 1, 3)


def merge_heads(t):
    B, H, S, d = t.shape
    return t.transpose(0, 2, 1, 3).reshape(B, S, H * d)


def to_blocks(t, blk):
    B, H, S, d = t.shape
    return t.reshape(B, H, S // blk, blk, d).transpose(2, 0, 1, 3, 4)


def from_blocks(t):
    n, B, H, blk, d = t.shape
    return t.transpose(1, 2, 0, 3, 4).reshape(B, H, n * blk, d)


def rope_tables(pos):
    half = MLA_ROPE_DIM // 2
    freqs = ROPE_THETA ** (-jnp.arange(half, dtype=jnp.float32) / half)
    ang = pos.astype(jnp.float32)[:, None] * freqs[None, :]
    return jnp.cos(ang), jnp.sin(ang)


def apply_rope(x, cos, sin):
    half = x.shape[-1] // 2
    c = cos.astype(x.dtype)
    s = sin.astype(x.dtype)
    x1, x2 = x[..., :half], x[..., half:]
    return jnp.concatenate([x1 * c - x2 * s, x1 * s + x2 * c], axis=-1)


def t5_bucket(dist):
    n = jnp.maximum(dist, 0)
    max_exact = NUM_BUCKETS // 2
    n_large = jnp.maximum(n, max_exact).astype(jnp.float32)
    large = max_exact + (jnp.log(n_large / max_exact) / math.log(MAX_DISTANCE / max_exact)
                         * (NUM_BUCKETS - max_exact)).astype(jnp.int32)
    large = jnp.minimum(large, NUM_BUCKETS - 1)
    return jnp.where(n < max_exact, n, large)


def mla_attention(q_nope, q_rope, k_nope, k_rope, v):
    S = q_nope.shape[2]
    scale = (MLA_NOPE_DIM + MLA_ROPE_DIM) ** -0.5
    key_pos = jnp.arange(S, dtype=jnp.int32)

    def one_block(args):
        qn_b, qr_b, i = args
        s = (jnp.einsum('bhqd,bhkd->bhqk', qn_b, k_nope)
             + jnp.einsum('bhqd,bkd->bhqk', qr_b, k_rope)).astype(jnp.float32) * scale
        qpos = i * Q_BLOCK + jnp.arange(Q_BLOCK, dtype=jnp.int32)
        s = jnp.where(key_pos[None, :] <= qpos[:, None], s, -jnp.inf)
        p = jax.nn.softmax(s, axis=-1).astype(v.dtype)
        return jnp.einsum('bhqk,bhkd->bhqd', p, v)

    n = S // Q_BLOCK
    out = lax.map(one_block, (to_blocks(q_nope, Q_BLOCK), to_blocks(q_rope, Q_BLOCK),
                              jnp.arange(n, dtype=jnp.int32)))
    return from_blocks(out)


def stick_breaking_attention(q, k, v):
    S = q.shape[2]
    scale = q.shape[-1] ** -0.5
    key_pos = jnp.arange(S, dtype=jnp.int32)

    def one_block(args):
        q_b, i = args
        z = jnp.einsum('bhqd,bhkd->bhqk', q_b, k).astype(jnp.float32) * scale
        qpos = i * Q_BLOCK + jnp.arange(Q_BLOCK, dtype=jnp.int32)
        past = key_pos[None, :] < qpos[:, None]
        log_beta = jax.nn.log_sigmoid(z)
        log_1m_beta = jnp.where(past, jax.nn.log_sigmoid(-z), 0.0)
        suffix = lax.cumsum(log_1m_beta, axis=3, reverse=True) - log_1m_beta
        a = jnp.where(past, jnp.exp(log_beta + suffix), 0.0).astype(v.dtype)
        return jnp.einsum('bhqk,bhkd->bhqd', a, v)

    n = S // Q_BLOCK
    out = lax.map(one_block, (to_blocks(q, Q_BLOCK), jnp.arange(n, dtype=jnp.int32)))
    return from_blocks(out)


def moba_attention(q, k, v, rel_bias):
    B, H, S, d = q.shape
    nb = -(-S // MOBA_BLOCK)
    pad = nb * MOBA_BLOCK - S
    k_p = jnp.pad(k, ((0, 0), (0, 0), (0, pad), (0, 0)))
    v_p = jnp.pad(v, ((0, 0), (0, 0), (0, pad), (0, 0)))
    k_blocks = k_p.reshape(B, H, nb, MOBA_BLOCK, d)
    v_blocks = v_p.reshape(B, H, nb, MOBA_BLOCK, d)
    k_mean = jnp.mean(k_blocks.astype(jnp.float32), axis=3)
    top_k = min(MOBA_TOPK, nb)
    scale = d ** -0.5
    offs = jnp.arange(MOBA_BLOCK, dtype=jnp.int32)
    blk_ids = jnp.arange(nb, dtype=jnp.int32)
    bi = jnp.arange(B)[:, None, None, None]
    hi = jnp.arange(H)[None, :, None, None]
    bias_t = rel_bias.T

    def one_chunk(args):
        q_c, i = args
        start = i * MOBA_Q_CHUNK
        qpos = start + jnp.arange(MOBA_Q_CHUNK, dtype=jnp.int32)
        own_blk = start // MOBA_BLOCK
        gate = jnp.einsum('bhqd,bhnd->bhqn', q_c.astype(jnp.float32), k_mean)
        gate = jnp.where((blk_ids < own_blk)[None, :], gate, -jnp.inf)
        _, idx = lax.top_k(gate, top_k)
        valid = idx < own_blk
        k_sel = k_blocks[bi, hi, idx]
        v_sel = v_blocks[bi, hi, idx]
        s_sel = jnp.einsum('bhqd,bhqkcd->bhqkc', q_c, k_sel).astype(jnp.float32) * scale
        kpos_sel = idx[..., None] * MOBA_BLOCK + offs
        s_sel = s_sel + bias_t[hi[..., None], t5_bucket(qpos[:, None, None] - kpos_sel)]
        s_sel = jnp.where(valid[..., None], s_sel, -jnp.inf)
        s_sel = s_sel.reshape(B, H, MOBA_Q_CHUNK, top_k * MOBA_BLOCK)
        k_own = lax.dynamic_slice_in_dim(k_p, own_blk * MOBA_BLOCK, MOBA_BLOCK, axis=2)
        v_own = lax.dynamic_slice_in_dim(v_p, own_blk * MOBA_BLOCK, MOBA_BLOCK, axis=2)
        dist_own = qpos[:, None] - (own_blk * MOBA_BLOCK + offs)[None, :]
        s_own = (jnp.einsum('bhqd,bhcd->bhqc', q_c, k_own).astype(jnp.float32) * scale
                 + bias_t[:, t5_bucket(dist_own)])
        s_own = jnp.where(dist_own >= 0, s_own, -jnp.inf)
        p = jax.nn.softmax(jnp.concatenate([s_sel, s_own], axis=-1), axis=-1).astype(v.dtype)
        p_sel = p[..., :top_k * MOBA_BLOCK].reshape(B, H, MOBA_Q_CHUNK, top_k, MOBA_BLOCK)
        p_own = p[..., top_k * MOBA_BLOCK:]
        return (jnp.einsum('bhqkc,bhqkcd->bhqd', p_sel, v_sel)
                + jnp.einsum('bhqc,bhcd->bhqd', p_own, v_own))

    n = S // MOBA_Q_CHUNK
    out = lax.map(one_chunk, (to_blocks(q, MOBA_Q_CHUNK), jnp.arange(n, dtype=jnp.int32)))
    return from_blocks(out)


def conformer_conv(u, dw_w, dw_b, ln_g, ln_b, pw_w, pw_b):
    a, g = jnp.split(u, 2, axis=-1)
    xg = a * jax.nn.sigmoid(g)
    y = lax.conv_general_dilated(
        xg, dw_w[:, None, :].astype(xg.dtype), window_strides=(1,),
        padding=[(CONV_WIDTH - 1, 0)], dimension_numbers=('NWC', 'WIO', 'NWC'),
        feature_group_count=GROUP_WIDTH) + dw_b
    y = jax.nn.silu(layer_norm(y, ln_g, ln_b))
    return jnp.einsum('bsc,ce->bse', y, pw_w) + pw_b


def setup_inputs(seed: int = 0) -> dict:
    key = jax.random.key(seed)
    ks = jax.random.split(key, 16)
    f32 = jnp.float32

    def nrm(k, shape, fan_in):
        return jax.random.normal(k, shape, f32) * (fan_in ** -0.5)

    def gain(k, shape):
        return 1.0 + 0.05 * jax.random.normal(k, shape, f32)

    return {
        "x": jax.random.normal(ks[0], (BATCH, SEQ, D_MODEL), f32),
        "pre_norm_g": gain(ks[1], (DEPTH, D_MODEL)),
        "w_in": nrm(ks[2], (DEPTH, D_MODEL, D_IN_PROJ), D_MODEL),
        "mla_q_norm_g": gain(ks[3], (DEPTH, MLA_Q_RANK)),
        "mla_w_uq": nrm(ks[4], (DEPTH, MLA_Q_RANK, HEADS_PER_GROUP * (MLA_NOPE_DIM + MLA_ROPE_DIM)), MLA_Q_RANK),
        "mla_kv_norm_g": gain(ks[5], (DEPTH, MLA_KV_RANK)),
        "mla_w_ukv": nrm(ks[6], (DEPTH, MLA_KV_RANK, HEADS_PER_GROUP * (MLA_NOPE_DIM + MLA_V_DIM)), MLA_KV_RANK),
        "rel_bias": 0.2 * jax.random.normal(ks[7], (NUM_BUCKETS, HEADS_PER_GROUP), f32),
        "conv_dw_w": nrm(ks[8], (DEPTH, CONV_WIDTH, GROUP_WIDTH), CONV_WIDTH),
        "conv_dw_b": 0.02 * jax.random.normal(ks[9], (DEPTH, GROUP_WIDTH), f32),
        "conv_ln_g": gain(ks[10], (DEPTH, GROUP_WIDTH)),
        "conv_ln_b": 0.02 * jax.random.normal(ks[11], (DEPTH, GROUP_WIDTH), f32),
        "conv_pw_w": nrm(ks[12], (DEPTH, GROUP_WIDTH, GROUP_WIDTH), GROUP_WIDTH),
        "conv_pw_b": 0.02 * jax.random.normal(ks[13], (DEPTH, GROUP_WIDTH), f32),
        "w_out": nrm(ks[14], (DEPTH, D_MIX, D_MODEL), D_MIX),
        "post_norm_g": gain(ks[15], (DEPTH, D_MODEL)),
    }


def reference(x, pre_norm_g, w_in, mla_q_norm_g, mla_w_uq, mla_kv_norm_g, mla_w_ukv,
              rel_bias, conv_dw_w, conv_dw_b, conv_ln_g, conv_ln_b, conv_pw_w, conv_pw_b,
              w_out, post_norm_g):
    S = x.shape[1]
    cos, sin = rope_tables(jnp.arange(S, dtype=jnp.int32))
    H = HEADS_PER_GROUP
    for l in range(DEPTH):
        h = rms_norm(x, pre_norm_g[l])
        u = jnp.einsum('bsd,de->bse', h, w_in[l])
        u_mla, u_sb, u_moba, u_conv, u_gate = jnp.split(u, SPLITS, axis=-1)

        c_q, c_kv, k_rope_raw = jnp.split(u_mla, [MLA_Q_RANK, MLA_Q_RANK + MLA_KV_RANK], axis=-1)
        qa = split_heads(jnp.einsum('bsr,re->bse', rms_norm(c_q, mla_q_norm_g[l]), mla_w_uq[l]), H)
        q_nope = qa[..., :MLA_NOPE_DIM]
        q_rope = apply_rope(qa[..., MLA_NOPE_DIM:], cos, sin)
        kva = split_heads(jnp.einsum('bsr,re->bse', rms_norm(c_kv, mla_kv_norm_g[l]), mla_w_ukv[l]), H)
        k_nope = kva[..., :MLA_NOPE_DIM]
        v_a = kva[..., MLA_NOPE_DIM:]
        k_rope = apply_rope(k_rope_raw, cos, sin)
        o_a = merge_heads(mla_attention(q_nope, q_rope, k_nope, k_rope, v_a))

        qb, kb, vb = jnp.split(u_sb, 3, axis=-1)
        o_b = merge_heads(stick_breaking_attention(split_heads(qb, H), split_heads(kb, H), split_heads(vb, H)))

        qc, kc, vc = jnp.split(u_moba, 3, axis=-1)
        o_c = merge_heads(moba_attention(split_heads(qc, H), split_heads(kc, H), split_heads(vc, H), rel_bias))

        o_d = conformer_conv(u_conv, conv_dw_w[l], conv_dw_b[l], conv_ln_g[l], conv_ln_b[l],
                             conv_pw_w[l], conv_pw_b[l])

        y = jnp.concatenate([o_a, o_b, o_c, o_d], axis=-1) * jax.nn.silu(u_gate)
        y = jnp.einsum('bse,ed->bsd', y, w_out[l])
        x = x + rms_norm(y, post_norm_g[l])
    return x
```

```cpp
#include <hip/hip_runtime.h>
#include <hip/hip_bf16.h>
#include <cstdio>
#include <cstdint>
#include <cmath>
namespace pg8 {
#define PG8_LAS __attribute__((address_space(3)))
typedef unsigned short bf16_t;
typedef short bf16x8 __attribute__((ext_vector_type(8)));
typedef float f32x4 __attribute__((ext_vector_type(4)));
typedef unsigned u32x4 __attribute__((ext_vector_type(4)));
constexpr int BM = 256, BK = 64, HALF = 128, HTB = HALF * BK * 2  , STAGE_BYTES = 8 * HTB, NXCD = 8, WGM = 8;

__host__ __device__ __forceinline__ int lds_byte(int r, int c) { const int st = (r >> 4) * 2 + (c >> 5), rr = r & 15, cc = c & 31, ob = rr * 64 + cc * 2; return st * 1024 + (ob ^ (((ob >> 9) & 1) << 5)); }
__host__ __device__ __forceinline__ void stage_rc(int b, int& R, int& C) { const int st = b / 1024, sb = b % 1024, swz = sb ^ (((sb >> 9) & 1) << 5); R = (st >> 1) * 16 + swz / 64; C = (st & 1) * 32 + (swz % 64) / 2; }
__host__ __device__ __forceinline__ int perm32(int rho) { const int n = rho >> 4, i = rho & 15; return 8 * (i >> 2) + 4 * n + (i & 3); }

struct Unit { int pm, pn; };
struct Gemm { const bf16_t* A; const bf16_t* Bt; int M, N, K, lda; };

struct StaticOrder {
    int nM, nN, nwg, G, c;
    __host__ __device__ void init(int M, int N, int G_, int c_) { nM = M / BM; nN = N / BM; nwg = nM * nN; G = G_; c = c_; }
    __host__ __device__ bool next(int i, Unit& u) const {
        const long L = (long)i * G + c; if (L >= nwg) return false;
        int wgid = (int)L; { const int q = nwg / NXCD, r = nwg % NXCD, xcd = wgid % NXCD, off = wgid / NXCD; wgid = (xcd < r ? xcd * (q + 1) : r * (q + 1) + (xcd - r) * q) + off; }
        const int nig = WGM * nN, gid = wgid / nig, fm = gid * WGM, gsz = (nM - fm) < WGM ? (nM - fm) : WGM;
        u.pm = fm + ((wgid % nig) % gsz); u.pn = (wgid % nig) / gsz; return true;
    }
    __device__ __forceinline__ void a_ready(const Unit&) const {}
    __device__ __forceinline__ void done(const Unit&) const {}
};

__device__ __forceinline__ unsigned cvt_pk_bf16(float lo, float hi) { unsigned r; asm volatile("v_cvt_pk_bf16_f32 %0, %1, %2" : "=v"(r) : "v"(lo), "v"(hi)); return r; }
typedef float f32x2 __attribute__((ext_vector_type(2)));
__device__ __forceinline__ u32x4 pack8(f32x4 a, f32x4 b) { u32x4 w; w.x = cvt_pk_bf16(a[0], a[1]); w.y = cvt_pk_bf16(a[2], a[3]); w.z = cvt_pk_bf16(b[0], b[1]); w.w = cvt_pk_bf16(b[2], b[3]); return w; }
__device__ __forceinline__ float bf_lo(unsigned w) { return __uint_as_float(w << 16); }
__device__ __forceinline__ float bf_hi(unsigned w) { return __uint_as_float(w & 0xffff0000u); }
__device__ __forceinline__ float silu_f(float g) { return g / (1.0f + __expf(-g)); }

struct EpiIn {
    static constexpr bool PERM = true, AFTER_DRAIN = false;
    bf16_t* U; float* ssq_q; float* ssq_kv; bf16_t* KR; const float* cosT; const float* sinT; float qscale;
    __device__ __forceinline__ void operator()(const f32x4 (&acc)[2][2][4][2], const Unit& u, int wr, int wc, int fr, int fq) const {
        const int pn = u.pn;
        const float sc = (pn == 2 || pn == 5) ? qscale : 1.0f;
        const int row0 = u.pm * BM + wr * 64 + fr, col0 = pn * BM + wc * 32 + 8 * fq;
#pragma unroll
        for (int ai = 0; ai < 2; ++ai)
#pragma unroll
            for (int m = 0; m < 4; ++m) { bf16_t* rowp = U + (size_t)(row0 + ai * HALF + m * 16) * 3584 + col0;
#pragma unroll
                for (int bj = 0; bj < 2; ++bj) *(u32x4*)(rowp + bj * HALF) = pack8(acc[ai][bj][m][0] * sc, acc[ai][bj][m][1] * sc); }
        if (pn <= 1) {
            float* ssq = pn == 0 ? ssq_q : ssq_kv;
#pragma unroll
            for (int ai = 0; ai < 2; ++ai)
#pragma unroll
                for (int m = 0; m < 4; ++m) {
                    float s = 0.f;
#pragma unroll
                    for (int n = 0; n < 2; ++n) { const f32x4 x = acc[ai][0][m][n]; s += (x[0] * x[0] + x[1] * x[1]) + (x[2] * x[2] + x[3] * x[3]); }
                    if (pn == 0) {
#pragma unroll
                        for (int n = 0; n < 2; ++n) { const f32x4 x = acc[ai][1][m][n]; s += (x[0] * x[0] + x[1] * x[1]) + (x[2] * x[2] + x[3] * x[3]); } }
                    s += __shfl_xor(s, 16); s += __shfl_xor(s, 32);
                    if (fq == 0) ssq[(size_t)(row0 + ai * HALF + m * 16) * 4 + wc] = s;
                }
        }
        if (pn == 1 && wc == 0) {
#pragma unroll
            for (int ai = 0; ai < 2; ++ai)
#pragma unroll
                for (int m = 0; m < 4; ++m) { const int row = row0 + ai * HALF + m * 16, pos = row & 4095;
                    const f32x4 c = *(const f32x4*)(cosT + pos * 16 + 4 * fq), s = *(const f32x4*)(sinT + pos * 16 + 4 * fq);
                    const f32x4 x1 = acc[ai][1][m][0], x2 = acc[ai][1][m][1];
                    *(u32x4*)(KR + (size_t)row * 32 + 8 * fq) = pack8(x1 * c - x2 * s, x1 * s + x2 * c);
                    asm volatile("" ::: "memory"); }
        }
    }
};
struct EpiQ {
    static constexpr bool PERM = true, AFTER_DRAIN = false;
    bf16_t* QA; const float* ssq_q; const float* cosT; const float* sinT; float scale; float eps;
    __device__ __forceinline__ void operator()(const f32x4 (&acc)[2][2][4][2], const Unit& u, int wr, int wc, int fr, int fq) const {
        const int row0 = u.pm * BM + wr * 64 + fr;
#pragma unroll
        for (int ai = 0; ai < 2; ++ai)
#pragma unroll
            for (int m = 0; m < 4; ++m) { const int row = row0 + ai * HALF + m * 16;
                const f32x4 s4 = *(const f32x4*)(ssq_q + (size_t)row * 4);
                const float rs = scale / sqrtf(((s4[0] + s4[1]) + (s4[2] + s4[3])) * (1.0f / 192.0f) + eps);
                if (u.pn == 0) {
#pragma unroll
                    for (int bj = 0; bj < 2; ++bj) *(u32x4*)(QA + (size_t)row * 384 + bj * HALF + wc * 32 + 8 * fq) = pack8(acc[ai][bj][m][0] * rs, acc[ai][bj][m][1] * rs);
                } else {
                    const int pos = row & 4095;
                    const f32x4 c = *(const f32x4*)(cosT + pos * 16 + 4 * fq), s = *(const f32x4*)(sinT + pos * 16 + 4 * fq);
                    const f32x4 x1 = acc[ai][0][m][0] * rs, x2 = acc[ai][0][m][1] * rs;
                    *(u32x4*)(QA + (size_t)row * 384 + 256 + wc * 32 + 8 * fq) = pack8(x1 * c - x2 * s, x1 * s + x2 * c);
                }
                asm volatile("" ::: "memory"); }
    }
};
struct EpiKV {
    static constexpr bool PERM = true, AFTER_DRAIN = false;
    bf16_t* KVA; const float* ssq_kv; float eps;
    __device__ __forceinline__ void operator()(const f32x4 (&acc)[2][2][4][2], const Unit& u, int wr, int wc, int fr, int fq) const {
        const int row0 = u.pm * BM + wr * 64 + fr;
#pragma unroll
        for (int ai = 0; ai < 2; ++ai)
#pragma unroll
            for (int m = 0; m < 4; ++m) { const int row = row0 + ai * HALF + m * 16;
                const f32x4 s4 = *(const f32x4*)(ssq_kv + (size_t)row * 4);
                const float rs = 1.0f / sqrtf(((s4[0] + s4[1]) + (s4[2] + s4[3])) * (1.0f / 128.0f) + eps);
#pragma unroll
                for (int bj = 0; bj < 2; ++bj) *(u32x4*)(KVA + (size_t)row * 512 + u.pn * BM + bj * HALF + wc * 32 + 8 * fq) = pack8(acc[ai][bj][m][0] * rs, acc[ai][bj][m][1] * rs);
                asm volatile("" ::: "memory"); }
    }
};
struct EpiPW {
    static constexpr bool PERM = true, AFTER_DRAIN = false;
    bf16_t* Y; const bf16_t* U; const float* pwb;
    __device__ __forceinline__ void operator()(const f32x4 (&acc)[2][2][4][2], const Unit& u, int wr, int wc, int fr, int fq) const {
        const int row0 = u.pm * BM + wr * 64 + fr, c0 = wc * 32 + 8 * fq;
#pragma unroll
        for (int ai = 0; ai < 2; ++ai)
#pragma unroll
            for (int m = 0; m < 4; ++m) { const int row = row0 + ai * HALF + m * 16;
#pragma unroll
                for (int bj = 0; bj < 2; ++bj) { const int c = c0 + bj * HALF;
                    const f32x4 b0 = *(const f32x4*)(pwb + c), b1 = *(const f32x4*)(pwb + c + 4);
                    const u32x4 g = *(const u32x4*)(U + (size_t)row * 3584 + 2560 + 768 + c);
                    f32x4 v0 = acc[ai][bj][m][0] + b0, v1 = acc[ai][bj][m][1] + b1;
                    v0[0] *= silu_f(bf_lo(g.x)); v0[1] *= silu_f(bf_hi(g.x)); v0[2] *= silu_f(bf_lo(g.y)); v0[3] *= silu_f(bf_hi(g.y));
                    v1[0] *= silu_f(bf_lo(g.z)); v1[1] *= silu_f(bf_hi(g.z)); v1[2] *= silu_f(bf_lo(g.w)); v1[3] *= silu_f(bf_hi(g.w));
                    *(u32x4*)(Y + (size_t)row * 1024 + 768 + c) = pack8(v0, v1);
                    asm volatile("" ::: "memory"); } }
    }
};
struct EpiOut {
    static constexpr bool PERM = true, AFTER_DRAIN = false;
    bf16_t* T; float* ssq_o;
    __device__ __forceinline__ void operator()(const f32x4 (&acc)[2][2][4][2], const Unit& u, int wr, int wc, int fr, int fq) const {
        const int row0 = u.pm * BM + wr * 64 + fr, col0 = u.pn * BM + wc * 32 + 8 * fq;
#pragma unroll
        for (int ai = 0; ai < 2; ++ai)
#pragma unroll
            for (int m = 0; m < 4; ++m) { const int row = row0 + ai * HALF + m * 16; float s = 0.f;
#pragma unroll
                for (int bj = 0; bj < 2; ++bj) { *(u32x4*)(T + (size_t)row * 1024 + col0 + bj * HALF) = pack8(acc[ai][bj][m][0], acc[ai][bj][m][1]);
#pragma unroll
                    for (int n = 0; n < 2; ++n) { const f32x4 x = acc[ai][bj][m][n]; s += (x[0] * x[0] + x[1] * x[1]) + (x[2] * x[2] + x[3] * x[3]); } }
                s += __shfl_xor(s, 16); s += __shfl_xor(s, 32);
                if (fq == 0) ssq_o[(size_t)row * 16 + u.pn * 4 + wc] = s; }
    }
};
template <class Epi, class Sched, bool ALIGN_EPI = false, bool SP2 = false>
__device__ __forceinline__ void gemm_phase(PG8_LAS unsigned char* lds, const Gemm g, const Sched& S, const Epi& E) {
    int tid_ = threadIdx.x; asm volatile("" : "+v"(tid_));
    const int tid = tid_, wid = __builtin_amdgcn_readfirstlane(tid >> 6), lane = tid & 63, wr = wid >> 2, wc = wid & 3, fr = lane & 15, fq = lane >> 4;
    const int K = g.K, nt = K / BK;
    unsigned voffA[2], voffB[2];
#pragma unroll
    for (int i = 0; i < 2; ++i) { int R, C; stage_rc(tid * 16 + i * 8192, R, C); const int Rb = Epi::PERM ? ((R & ~31) + perm32(R & 31)) : R;
        voffA[i] = (unsigned)(R * g.lda + C) * 2u; voffB[i] = (unsigned)(Rb * K + C) * 2u; }
    const size_t kstep = (size_t)(BK * 2);
    const size_t hstepA = (size_t)HALF * g.lda * 2, hstepB = (size_t)HALF * K * 2;
    const size_t tstepA = 2 * hstepA, tstepB = 2 * hstepB;
    const unsigned ldsw = (unsigned)wid * 1024u;
    const int aoff = lds_byte(wr * 64 + fr, fq * 8), boff = lds_byte(wc * 32 + fr, fq * 8);
#define PG8_SA(b, h) (((b) * 2 + (h)) * HTB)
#define PG8_SB(b, h) ((4 + (b) * 2 + (h)) * HTB)
#define PG8_STAGE(bufoff, gbase, voff) do { _Pragma("unroll") for (int _i = 0; _i < 2; ++_i) \
        __builtin_amdgcn_global_load_lds((const unsigned*)((const char*)(gbase) + (voff)[_i]), (PG8_LAS unsigned*)(lds + (bufoff) + ldsw + _i * 8192), 16, 0, 0); } while (0)
#define PG8_LDA(dst, b, h) do { _Pragma("unroll") for (int m = 0; m < 4; ++m) _Pragma("unroll") for (int k = 0; k < 2; ++k) dst[m][k] = *(const PG8_LAS bf16x8*)(lds + PG8_SA(b, h) + aoff + m * 2048 + k * 1024); } while (0)
#define PG8_LDB(dst, b, h) do { _Pragma("unroll") for (int n = 0; n < 2; ++n) _Pragma("unroll") for (int k = 0; k < 2; ++k) dst[n][k] = *(const PG8_LAS bf16x8*)(lds + PG8_SB(b, h) + boff + n * 2048 + k * 1024); } while (0)
#define PG8_MMA(ai, bj, At, Bt) do { __builtin_amdgcn_s_setprio(1); _Pragma("unroll") for (int m = 0; m < 4; ++m) _Pragma("unroll") for (int n = 0; n < 2; ++n) _Pragma("unroll") for (int k = 0; k < 2; ++k) \
        acc[ai][bj][m][n] = __builtin_amdgcn_mfma_f32_16x16x32_bf16(Bt[n][k], At[m][k], acc[ai][bj][m][n], 0, 0, 0); __builtin_amdgcn_s_setprio(0); } while (0)
#define PG8_WAIT_V(n) asm volatile("s_waitcnt vmcnt(" #n ")" ::: "memory")
#define PG8_WAIT_L(n) asm volatile("s_waitcnt lgkmcnt(" #n ")" ::: "memory")
#define PG8_BAR __builtin_amdgcn_s_barrier()
#define PG8_SCHED __builtin_amdgcn_sched_barrier(0)
    Unit cur, nxt; int ui = 0;
    if (!S.next(0, cur)) return;
    f32x4 acc[2][2][4][2];
#pragma unroll
    for (int a = 0; a < 2; ++a)
#pragma unroll
        for (int b = 0; b < 2; ++b)
#pragma unroll
            for (int m = 0; m < 4; ++m)
#pragma unroll
                for (int n = 0; n < 2; ++n) acc[a][b][m][n] = (f32x4){0.f, 0.f, 0.f, 0.f};
    bf16x8 At[4][2], B0[2][2], B1[2][2];
    const char* cA = (const char*)g.A + (size_t)cur.pm * tstepA; const char* cB = (const char*)g.Bt + (size_t)cur.pn * tstepB;
    S.a_ready(cur);
    if constexpr (SP2) {
        PG8_STAGE(PG8_SB(0, 0), cB, voffB); PG8_STAGE(PG8_SB(0, 1), cB + hstepB, voffB); PG8_STAGE(PG8_SA(0, 0), cA, voffA); PG8_STAGE(PG8_SA(0, 1), cA + hstepA, voffA);
        if (wr == 1) PG8_BAR;
        PG8_WAIT_V(2); PG8_BAR;
        PG8_STAGE(PG8_SB(1, 0), cB + kstep, voffB); PG8_STAGE(PG8_SA(1, 0), cA + kstep, voffA); PG8_STAGE(PG8_SB(1, 1), cB + hstepB + kstep, voffB);
        PG8_WAIT_V(6); PG8_BAR;
    } else {
        PG8_STAGE(PG8_SB(0, 0), cB, voffB); PG8_STAGE(PG8_SA(0, 0), cA, voffA); PG8_STAGE(PG8_SB(0, 1), cB + hstepB, voffB); PG8_STAGE(PG8_SA(0, 1), cA + hstepA, voffA);
        if (wr == 1) PG8_BAR;
        PG8_WAIT_V(4); PG8_BAR;
        PG8_STAGE(PG8_SB(1, 0), cB + kstep, voffB); PG8_STAGE(PG8_SA(1, 0), cA + kstep, voffA); PG8_STAGE(PG8_SB(1, 1), cB + hstepB + kstep, voffB);
        PG8_WAIT_V(6); PG8_BAR;
    }
    for (;;) {
        const bool has_next = S.next(ui + 1, nxt);
        const char* nA = has_next ? (const char*)g.A + (size_t)nxt.pm * tstepA : cA; const char* nB = has_next ? (const char*)g.Bt + (size_t)nxt.pn * tstepB : cB;
#pragma nounroll
        for (int t = 0; t < nt; t += 2) {
            const bool last = (t == nt - 2);
            const char* a1 = cA + (size_t)(t + 1) * kstep;
            const char* a2 = last ? nA : cA + (size_t)(t + 2) * kstep; const char* b2 = last ? nB : cB + (size_t)(t + 2) * kstep;
            const char* a3 = a2 + kstep; const char* b3 = b2 + kstep;
            if (last && has_next) S.a_ready(nxt);
            if constexpr (SP2) {
            PG8_LDB(B0, 0, 0); PG8_LDB(B1, 0, 1); PG8_SCHED; PG8_LDA(At, 0, 0); PG8_STAGE(PG8_SA(1, 1), a1 + hstepA, voffA);
            PG8_WAIT_V(8); PG8_WAIT_L(0); PG8_BAR; PG8_MMA(0, 0, At, B0); PG8_MMA(0, 1, At, B1); PG8_BAR; PG8_SCHED;
            PG8_LDA(At, 0, 1); PG8_STAGE(PG8_SB(0, 0), b2, voffB); PG8_STAGE(PG8_SB(0, 1), b2 + hstepB, voffB); PG8_STAGE(PG8_SA(0, 0), a2, voffA);
            PG8_WAIT_V(8); PG8_WAIT_L(0); PG8_BAR; PG8_MMA(1, 0, At, B0); PG8_MMA(1, 1, At, B1); PG8_BAR; PG8_SCHED;
            PG8_LDB(B0, 1, 0); PG8_LDB(B1, 1, 1); PG8_SCHED; PG8_LDA(At, 1, 0); PG8_STAGE(PG8_SA(0, 1), a2 + hstepA, voffA);
            PG8_WAIT_V(8); PG8_WAIT_L(0); PG8_BAR; PG8_MMA(0, 0, At, B0); PG8_MMA(0, 1, At, B1); PG8_BAR; PG8_SCHED;
            PG8_LDA(At, 1, 1); PG8_STAGE(PG8_SB(1, 0), b3, voffB); PG8_STAGE(PG8_SB(1, 1), b3 + hstepB, voffB); PG8_STAGE(PG8_SA(1, 0), a3, voffA);
            PG8_WAIT_V(8); PG8_WAIT_L(0); PG8_BAR; PG8_MMA(1, 0, At, B0); PG8_MMA(1, 1, At, B1); PG8_BAR; PG8_SCHED;
            } else {
            PG8_LDB(B0, 0, 0); PG8_SCHED; PG8_LDA(At, 0, 0); PG8_STAGE(PG8_SA(1, 1), a1 + hstepA, voffA);
            PG8_WAIT_L(8); PG8_BAR; PG8_WAIT_L(0); PG8_MMA(0, 0, At, B0); PG8_BAR; PG8_SCHED;
            PG8_LDB(B1, 0, 1); PG8_STAGE(PG8_SB(0, 0), b2, voffB);
            PG8_BAR; PG8_WAIT_L(0); PG8_MMA(0, 1, At, B1); PG8_BAR;
            PG8_LDA(At, 0, 1); PG8_STAGE(PG8_SA(0, 0), a2, voffA);
            PG8_BAR; PG8_WAIT_L(0); PG8_MMA(1, 0, At, B0); PG8_BAR; PG8_SCHED;
            PG8_STAGE(PG8_SB(0, 1), b2 + hstepB, voffB);
            PG8_WAIT_V(6); PG8_BAR; PG8_MMA(1, 1, At, B1); PG8_BAR;
            PG8_LDB(B0, 1, 0); PG8_SCHED; PG8_LDA(At, 1, 0); PG8_STAGE(PG8_SA(0, 1), a2 + hstepA, voffA);
            PG8_WAIT_L(8); PG8_BAR; PG8_WAIT_L(0); PG8_MMA(0, 0, At, B0); PG8_BAR; PG8_SCHED;
            PG8_LDB(B1, 1, 1); PG8_STAGE(PG8_SB(1, 0), b3, voffB);
            PG8_BAR; PG8_WAIT_L(0); PG8_MMA(0, 1, At, B1); PG8_BAR;
            PG8_LDA(At, 1, 1); PG8_STAGE(PG8_SA(1, 0), a3, voffA);
            PG8_BAR; PG8_WAIT_L(0); PG8_MMA(1, 0, At, B0); PG8_BAR; PG8_SCHED;
            PG8_STAGE(PG8_SB(1, 1), b3 + hstepB, voffB);
            PG8_WAIT_V(6); PG8_BAR; PG8_MMA(1, 1, At, B1); PG8_BAR;
            }
        }
        if constexpr (ALIGN_EPI) { if (wr == 0) PG8_BAR; }
        if constexpr (!Epi::AFTER_DRAIN) { E(acc, cur, wr, wc, fr, fq); S.done(cur); }
        if (!has_next) break;
#pragma unroll
        for (int a = 0; a < 2; ++a)
#pragma unroll
            for (int b = 0; b < 2; ++b)
#pragma unroll
                for (int m = 0; m < 4; ++m)
#pragma unroll
                    for (int n = 0; n < 2; ++n) acc[a][b][m][n] = (f32x4){0.f, 0.f, 0.f, 0.f};
        cur = nxt; cA = nA; cB = nB; ++ui;
        if constexpr (ALIGN_EPI) { if (wr == 1) PG8_BAR; }
    }
    PG8_WAIT_V(0);
    if constexpr (!ALIGN_EPI) { if (wr == 0) PG8_BAR; }
    PG8_BAR;
    if constexpr (Epi::AFTER_DRAIN) { E.fused(acc, cur, wr, wc, fr, fq, lds, wid, lane); S.done(cur); }
#undef PG8_SA
#undef PG8_SB
#undef PG8_STAGE
#undef PG8_LDA
#undef PG8_LDB
#undef PG8_MMA
#undef PG8_WAIT_V
#undef PG8_WAIT_L
#undef PG8_BAR
#undef PG8_SCHED
}
}
namespace att {
typedef __hip_bfloat16 hbf16;
typedef short bf16x8 __attribute__((ext_vector_type(8)));
typedef short s16x4 __attribute__((ext_vector_type(4)));
typedef float f32x16 __attribute__((ext_vector_type(16)));
typedef float f32x4 __attribute__((ext_vector_type(4)));
typedef unsigned u32x4 __attribute__((ext_vector_type(4)));
typedef unsigned short bf16_t;
#define ALAS __attribute__((address_space(3)))
typedef ALAS const char* lds_cptr;
constexpr int SEQ = 4096, QB = 256, KVBLK = 64;
constexpr int SLOTK = 12288, SLOTV = 8192, NSLOT = 3;
constexpr int L_K = 0, L_V = NSLOT * SLOTK, L_WS = L_V + NSLOT * SLOTV, L_OST = L_WS + 8 * 256, L_TBL = L_OST + 8 * 4096, TBL_N = 256 + 4096, L_NINF = L_TBL + TBL_N * 4,
              L_KM = L_NINF + 256, L_FLAG = L_KM + 4096, L_END = L_FLAG + 64;
constexpr int UP = 3584;
constexpr float SB_EXIT = -160.0f;
#define ASBAR() __builtin_amdgcn_sched_barrier(0)
#define AWAIT_BAR(N) asm volatile("s_waitcnt vmcnt(" #N ") lgkmcnt(0)\n\ts_barrier" ::: "memory")
__device__ __forceinline__ int crow(int r, int hi) { return (r & 3) + 8 * (r >> 2) + 4 * hi; }
__device__ __forceinline__ void glds16(const void* gsrc, unsigned lds_dst) { unsigned keep;
    asm volatile("s_mov_b32 %0, m0\n\ts_mov_b32 m0, %2\n\ts_nop 0\n\tglobal_load_lds_dwordx4 %1, off\n\ts_mov_b32 m0, %0" : "=&s"(keep) : "v"(gsrc), "s"(lds_dst) : "memory"); }
typedef float f32x2_t __attribute__((ext_vector_type(2))); typedef __bf16 bf16x2_t __attribute__((ext_vector_type(2)));
__device__ __forceinline__ unsigned cvtpk(float lo, float hi) { f32x2_t v = {lo, hi}; bf16x2_t b = __builtin_convertvector(v, bf16x2_t); return __builtin_bit_cast(unsigned, b); }
__device__ __forceinline__ float bflo(unsigned w) { return __uint_as_float(w << 16); }
__device__ __forceinline__ float bfhi(unsigned w) { return __uint_as_float(w & 0xffff0000u); }
__device__ __forceinline__ float swap_max(float m) { auto rr = __builtin_amdgcn_permlane32_swap(__float_as_uint(m), __float_as_uint(m), false, false); return fmaxf(__uint_as_float(rr[0]), __uint_as_float(rr[1])); }
__device__ __forceinline__ float swap_add(float m) { auto rr = __builtin_amdgcn_permlane32_swap(__float_as_uint(m), __float_as_uint(m), false, false); return __uint_as_float(rr[0]) + __uint_as_float(rr[1]); }

template <int ND> __device__ __forceinline__ void qkt(f32x16& p0, f32x16& p1, lds_cptr kslot, const bf16x8* qr, int r32, int hi) {
    const lds_cptr kb = kslot + hi * 1024 + r32 * 16;
    p0 = f32x16{}; p1 = f32x16{};
#pragma unroll
    for (int d0 = 0; d0 < ND; ++d0) {
        const bf16x8 b0 = *(const ALAS bf16x8*)(kb + d0 * 2048);
        const bf16x8 b1 = *(const ALAS bf16x8*)(kb + d0 * 2048 + 512);
        p0 = __builtin_amdgcn_mfma_f32_32x32x16_bf16(b0, qr[d0], p0, 0, 0, 0);
        p1 = __builtin_amdgcn_mfma_f32_32x32x16_bf16(b1, qr[d0], p1, 0, 0, 0);
    }
}
__device__ __forceinline__ void pv(f32x16* o, int vb, bf16x8 pa0, bf16x8 pa1, bf16x8 pa2, bf16x8 pa3) {
#pragma unroll
    for (int d0 = 0; d0 < 2; ++d0) { s16x4 lo[4], hi[4];
#pragma unroll
        for (int ks = 0; ks < 4; ++ks) {
            asm volatile("ds_read_b64_tr_b16 %0,%1 offset:%c2" : "=&v"(lo[ks]) : "v"(vb), "i"(d0 * 4096 + ks * 1024) : "memory");
            asm volatile("ds_read_b64_tr_b16 %0,%1 offset:%c2" : "=&v"(hi[ks]) : "v"(vb), "i"(d0 * 4096 + ks * 1024 + 512) : "memory"); }
        asm volatile("s_waitcnt lgkmcnt(0)" ::: "memory"); ASBAR();
#define APK(k) (bf16x8){lo[k][0], lo[k][1], lo[k][2], lo[k][3], hi[k][0], hi[k][1], hi[k][2], hi[k][3]}
        o[d0] = __builtin_amdgcn_mfma_f32_32x32x16_bf16(pa0, APK(0), o[d0], 0, 0, 0);
        o[d0] = __builtin_amdgcn_mfma_f32_32x32x16_bf16(pa1, APK(1), o[d0], 0, 0, 0);
        o[d0] = __builtin_amdgcn_mfma_f32_32x32x16_bf16(pa2, APK(2), o[d0], 0, 0, 0);
        o[d0] = __builtin_amdgcn_mfma_f32_32x32x16_bf16(pa3, APK(3), o[d0], 0, 0, 0);
#undef APK
    }
}
__device__ __forceinline__ bf16x8 pk8(const f32x16& p, int b) { u32x4 w; w.x = cvtpk(p[b], p[b + 1]); w.y = cvtpk(p[b + 2], p[b + 3]); w.z = cvtpk(p[b + 4], p[b + 5]); w.w = cvtpk(p[b + 6], p[b + 7]); return __builtin_bit_cast(bf16x8, w); }

struct Tensors { const bf16_t* U; const bf16_t* QA; const bf16_t* KVA; const bf16_t* KR; bf16_t* Y; const float* BT; const float* KMEAN; };

template <int TYPE> __device__ __forceinline__ void attn_unit(const Tensors& T, int b, int h, int qb, ALAS char* shm, unsigned lds0) {
    constexpr int ND = (TYPE == 0) ? 6 : 4;
    int tid_ = threadIdx.x; asm volatile("" : "+v"(tid_));
    const int tid = tid_, lane = tid & 63, r32 = lane & 31, hi = lane >> 5; const int wid = __builtin_amdgcn_readfirstlane(tid >> 6);
    const long rowbase = (long)b * SEQ; const int q0 = qb * QB;
    const int NT = (q0 + QB) / KVBLK;
    const bf16_t *Qp, *Kp, *Vp; int pitchQ, pitchK, pitchV, gcol, ycol;
    if (TYPE == 0) { Qp = T.QA + h * 64; pitchQ = 384; Kp = T.KVA + h * 64; pitchK = 512; Vp = T.KVA + 256 + h * 64; pitchV = 512; }
    else { const int base = (TYPE == 1 ? 512 : 1280) + h * 64; Qp = T.U + base; Kp = T.U + base + 256; Vp = T.U + base + 512; pitchQ = pitchK = pitchV = UP; }
    gcol = 2560 + TYPE * 256 + h * 64; ycol = TYPE * 256 + h * 64;
    ALAS float* wsf = (ALAS float*)(shm + L_WS) + wid * 64;
    const long qrow = rowbase + q0 + wid * 32 + r32;
    bf16x8 qr[ND];
#pragma unroll
    for (int d0 = 0; d0 < 4; ++d0) qr[d0] = *(const bf16x8*)(Qp + qrow * pitchQ + d0 * 16 + hi * 8);
    if (TYPE == 0) {
#pragma unroll
        for (int d0 = 4; d0 < ND; ++d0) qr[d0] = *(const bf16x8*)(T.QA + qrow * 384 + 256 + h * 32 + (d0 - 4) * 16 + hi * 8);
    }
    const bf16_t* ksrc = Kp + (rowbase + lane) * pitchK + wid * 8;
    const bf16_t* vsrc = Vp + (rowbase + 16 * (wid & 3) + (lane >> 2)) * pitchV + (wid >> 2) * 32 + (lane & 3) * 8;
    const bf16_t* krsrc = T.KR + (rowbase + lane) * 32 + (wid & 3) * 8;
    const unsigned kdst = lds0 + L_K + wid * 1024, vdst = lds0 + L_V + wid * 1024, krdst = lds0 + L_K + (8 + (wid & 3)) * 1024;
#define DMA_TILE(t, s) do { glds16(ksrc + (long)(t) * KVBLK * pitchK, (unsigned)__builtin_amdgcn_readfirstlane(kdst + (s) * SLOTK)); \
        if (TYPE == 0) glds16(krsrc + (long)(t) * KVBLK * 32, (unsigned)__builtin_amdgcn_readfirstlane(krdst + (s) * SLOTK)); \
        glds16(vsrc + (long)(t) * KVBLK * pitchV, (unsigned)__builtin_amdgcn_readfirstlane(vdst + (s) * SLOTV)); } while (0)
#define TILE_WAIT(more) do { if (more) { if (TYPE == 0) AWAIT_BAR(3); else AWAIT_BAR(2); } else AWAIT_BAR(0); } while (0)
    const int vb0 = (int)(lds0 + L_V) + ((lane >> 4) & 1) * 32 + (lane & 3) * 8 + (4 * hi + ((lane & 15) >> 2)) * 64;
    const lds_cptr kbase = (lds_cptr)shm + L_K;
    const int qrel = wid * 32 + r32;
    f32x16 o[2]; o[0] = f32x16{}; o[1] = f32x16{};
    f32x16 p0, p1;

    if (TYPE != 1) {
        unsigned selmask = 0u;
        ALAS const float* tbl = (ALAS const float*)(shm + L_TBL);
        ALAS const float* ninf = (ALAS const float*)(shm + L_NINF);
        if (TYPE == 2) {
            const float* bt = T.BT + (size_t)h * TBL_N;
            const int nfill = 256 + q0 + 256;
            for (int i = tid; i < nfill; i += 512) ((ALAS float*)(shm + L_TBL))[i] = bt[i];
            if (tid < 64) ((ALAS float*)(shm + L_NINF))[tid] = -INFINITY;
            for (int i = tid; i < 16 * 64; i += 512) ((ALAS float*)(shm + L_KM))[i] = T.KMEAN[((size_t)b * 16 + (i >> 6)) * 256 + h * 64 + (i & 63)];
            asm volatile("s_waitcnt vmcnt(0) lgkmcnt(0)\n\ts_barrier" ::: "memory");
            float qf[32];
#pragma unroll
            for (int d0 = 0; d0 < 4; ++d0) { const u32x4 w = __builtin_bit_cast(u32x4, qr[d0]);
                qf[d0 * 8 + 0] = bflo(w.x); qf[d0 * 8 + 1] = bfhi(w.x); qf[d0 * 8 + 2] = bflo(w.y); qf[d0 * 8 + 3] = bfhi(w.y);
                qf[d0 * 8 + 4] = bflo(w.z); qf[d0 * 8 + 5] = bfhi(w.z); qf[d0 * 8 + 6] = bflo(w.w); qf[d0 * 8 + 7] = bfhi(w.w); }
            float v1 = -INFINITY, v2 = -INFINITY, v3 = -INFINITY; int i1 = -1, i2 = -1, i3 = -1;
            for (int j = 0; j < qb; ++j) {
                ALAS const float* km = (ALAS const float*)(shm + L_KM) + j * 64 + hi * 8;
                float g = 0.f;
#pragma unroll
                for (int d0 = 0; d0 < 4; ++d0) { const f32x4 a = *(ALAS const f32x4*)(km + d0 * 16), c = *(ALAS const f32x4*)(km + d0 * 16 + 4);
                    g += qf[d0 * 8 + 0] * a[0] + qf[d0 * 8 + 1] * a[1] + qf[d0 * 8 + 2] * a[2] + qf[d0 * 8 + 3] * a[3];
                    g += qf[d0 * 8 + 4] * c[0] + qf[d0 * 8 + 5] * c[1] + qf[d0 * 8 + 6] * c[2] + qf[d0 * 8 + 7] * c[3]; }
                g = swap_add(g);
                if (g > v1) { v3 = v2; i3 = i2; v2 = v1; i2 = i1; v1 = g; i1 = j; }
                else if (g > v2) { v3 = v2; i3 = i2; v2 = g; i2 = j; }
                else if (g > v3) { v3 = g; i3 = j; }
            }
            if (i1 >= 0) selmask |= 1u << i1;
            if (i2 >= 0) selmask |= 1u << i2;
            if (i3 >= 0) selmask |= 1u << i3;
        }
        float m_run = -1.0e30f, l_run = 0.f;
        DMA_TILE(0, 0); DMA_TILE(1, 1);
        int sl = 0, sl2 = 2;
        for (int t = 0; t < NT; ++t) {
            TILE_WAIT(t + 1 < NT);
            if (t + 2 < NT) DMA_TILE(t + 2, sl2);
            const int jb = t - (NT - 4);
            const bool wave_active = (jb < 0) || (64 * jb <= wid * 32 + 31);
            bool sel = true;
            if (TYPE == 2 && jb < 0) sel = (selmask >> (t >> 2)) & 1u;
            if (wave_active && (TYPE != 2 || __any(sel))) {
                qkt<ND>(p0, p1, kbase + sl * SLOTK, qr, r32, hi);
                if (TYPE == 2) {
                    ALAS const float* pb = sel ? tbl + (q0 + qrel - 64 * t - 4 * hi + 197) : ninf;
#pragma unroll
                    for (int r = 0; r < 16; ++r) { const int ko = (r & 3) + 8 * (r >> 2); p0[r] += pb[59 - ko]; p1[r] += pb[27 - ko]; }
                }
                if (jb >= 0) {
#pragma unroll
                    for (int r = 0; r < 16; ++r) { const int kv = 64 * jb + 4 * hi + (r & 3) + 8 * (r >> 2); if (kv > qrel) p0[r] = -INFINITY; if (kv + 32 > qrel) p1[r] = -INFINITY; }
                }
                float mx = fmaxf(p0[0], p1[0]);
#pragma unroll
                for (int r = 1; r < 16; ++r) mx = fmaxf(mx, fmaxf(p0[r], p1[r]));
                mx = swap_max(mx);
                const float m_new = fmaxf(m_run, mx);
                if (__any(m_new > m_run)) {
                    const float alpha = __builtin_amdgcn_exp2f(m_run - m_new);
                    l_run *= alpha; m_run = m_new;
                    if (hi == 0) wsf[r32] = alpha;
                    asm volatile("s_waitcnt lgkmcnt(0)" ::: "memory");
#pragma unroll
                    for (int r = 0; r < 16; ++r) { const float f = wsf[crow(r, hi)]; o[0][r] *= f; o[1][r] *= f; }
                    asm volatile("s_waitcnt lgkmcnt(0)" ::: "memory");
                }
                float rs = 0.f;
#pragma unroll
                for (int r = 0; r < 16; ++r) { p0[r] = __builtin_amdgcn_exp2f(p0[r] - m_run); p1[r] = __builtin_amdgcn_exp2f(p1[r] - m_run); rs += p0[r] + p1[r]; }
                l_run += rs;
                pv(o, vb0 + sl * SLOTV, pk8(p0, 0), pk8(p0, 8), pk8(p1, 0), pk8(p1, 8));
            }
            sl = (sl == 2) ? 0 : sl + 1; sl2 = (sl2 == 2) ? 0 : sl2 + 1;
        }
        l_run = swap_add(l_run);
        if (hi == 0) wsf[32 + r32] = l_run;
        asm volatile("s_waitcnt lgkmcnt(0)" ::: "memory");
#pragma unroll
        for (int r = 0; r < 16; ++r) { const float f = __builtin_amdgcn_rcpf(wsf[32 + crow(r, hi)]); o[0][r] *= f; o[1][r] *= f; }
    } else {
        bf16x8 Ta, Tb, Tones;
        { short ta[8], tb[8];
#pragma unroll
          for (int j = 0; j < 8; ++j) { const int kk = 8 * (j >> 2) + 4 * hi + (j & 3); ta[j] = (kk > r32) ? (short)0x3F80 : (short)0; tb[j] = (16 + kk > r32) ? (short)0x3F80 : (short)0; }
          Ta = (bf16x8){ta[0], ta[1], ta[2], ta[3], ta[4], ta[5], ta[6], ta[7]}; Tb = (bf16x8){tb[0], tb[1], tb[2], tb[3], tb[4], tb[5], tb[6], tb[7]};
          Tones = (bf16x8){(short)0x3F80, (short)0x3F80, (short)0x3F80, (short)0x3F80, (short)0x3F80, (short)0x3F80, (short)0x3F80, (short)0x3F80}; }
        float c = 0.f;
        ALAS unsigned* flags = (ALAS unsigned*)(shm + L_FLAG);
        DMA_TILE(NT - 1, 0); DMA_TILE(NT - 2, 1);
        int sl = 0, sl2 = 2;
        for (int i = 0; i < NT; ++i) {
            const int t = NT - 1 - i;
            TILE_WAIT(i + 1 < NT);
            if (i > 0) { const ALAS unsigned* fl = flags + ((i - 1) & 1) * 8; unsigned all = fl[0] & fl[1] & fl[2] & fl[3] & fl[4] & fl[5] & fl[6] & fl[7];
                         if (__builtin_amdgcn_readfirstlane(all) != 0u) break; }
            if (i + 2 < NT) DMA_TILE(t - 2, sl2);
            const int jb = t - (NT - 4);
            const bool wave_active = (jb < 0) || (64 * jb < wid * 32 + 31);
            if (wave_active) {
                qkt<ND>(p0, p1, kbase + sl * SLOTK, qr, r32, hi);
                f32x16 L0, L1;
#pragma unroll
                for (int r = 0; r < 16; ++r) {
                    { const float z = p0[r]; const float e = __builtin_amdgcn_exp2f(-fabsf(z)); const float sp = fmaxf(z, 0.f) + __builtin_amdgcn_logf(1.0f + e); p0[r] = z - sp; L0[r] = -sp; }
                    { const float z = p1[r]; const float e = __builtin_amdgcn_exp2f(-fabsf(z)); const float sp = fmaxf(z, 0.f) + __builtin_amdgcn_logf(1.0f + e); p1[r] = z - sp; L1[r] = -sp; }
                }
                if (jb >= 0) {
#pragma unroll
                    for (int r = 0; r < 16; ++r) { const int kv = 64 * jb + 4 * hi + (r & 3) + 8 * (r >> 2);
                        if (kv >= qrel) { p0[r] = -INFINITY; L0[r] = 0.f; } if (kv + 32 >= qrel) { p1[r] = -INFINITY; L1[r] = 0.f; } }
                }
                const bf16x8 B0 = pk8(L0, 0), B1 = pk8(L0, 8), B2 = pk8(L1, 0), B3 = pk8(L1, 8);
                f32x16 X = __builtin_amdgcn_mfma_f32_32x32x16_bf16(Tones, B2, f32x16{}, 0, 0, 0);
                X = __builtin_amdgcn_mfma_f32_32x32x16_bf16(Tones, B3, X, 0, 0, 0);
                f32x16 D0 = __builtin_amdgcn_mfma_f32_32x32x16_bf16(Ta, B0, X, 0, 0, 0);
                D0 = __builtin_amdgcn_mfma_f32_32x32x16_bf16(Tb, B1, D0, 0, 0, 0);
                f32x16 D1 = __builtin_amdgcn_mfma_f32_32x32x16_bf16(Ta, B2, f32x16{}, 0, 0, 0);
                D1 = __builtin_amdgcn_mfma_f32_32x32x16_bf16(Tb, B3, D1, 0, 0, 0);
                f32x16 TT = __builtin_amdgcn_mfma_f32_32x32x16_bf16(Tones, B0, X, 0, 0, 0);
                TT = __builtin_amdgcn_mfma_f32_32x32x16_bf16(Tones, B1, TT, 0, 0, 0);
#pragma unroll
                for (int r = 0; r < 16; ++r) { p0[r] = __builtin_amdgcn_exp2f(p0[r] + (D0[r] + c)); p1[r] = __builtin_amdgcn_exp2f(p1[r] + (D1[r] + c)); }
                c += TT[0];
                pv(o, vb0 + sl * SLOTV, pk8(p0, 0), pk8(p0, 8), pk8(p1, 0), pk8(p1, 8));
            }
            { const bool done = __all(c < SB_EXIT); if (lane == 0) flags[(i & 1) * 8 + wid] = done ? 1u : 0u; }
            sl = (sl == 2) ? 0 : sl + 1; sl2 = (sl2 == 2) ? 0 : sl2 + 1;
        }
    }
    {
        ALAS bf16_t* stg = (ALAS bf16_t*)(shm + L_OST) + wid * 2048;
#pragma unroll
        for (int r = 0; r < 16; ++r) { const int orow = crow(r, hi);
#pragma unroll
            for (int d0 = 0; d0 < 2; ++d0) stg[orow * 64 + d0 * 32 + r32] = (bf16_t)(cvtpk(o[d0][r], 0.f) & 0xffffu); }
        asm volatile("s_waitcnt lgkmcnt(0)" ::: "memory");
#pragma unroll
        for (int i = 0; i < 4; ++i) { const int row = i * 8 + (lane >> 3), ch = lane & 7;
            const u32x4 v = *(ALAS const u32x4*)(stg + row * 64 + ch * 8);
            const long grow = rowbase + q0 + wid * 32 + row;
            const u32x4 g = *(const u32x4*)(T.U + grow * UP + gcol + ch * 8);
            float x[8] = {bflo(v.x), bfhi(v.x), bflo(v.y), bfhi(v.y), bflo(v.z), bfhi(v.z), bflo(v.w), bfhi(v.w)};
            const float gg[8] = {bflo(g.x), bfhi(g.x), bflo(g.y), bfhi(g.y), bflo(g.z), bfhi(g.z), bflo(g.w), bfhi(g.w)};
#pragma unroll
            for (int j = 0; j < 8; ++j) x[j] *= gg[j] / (1.0f + __expf(-gg[j]));
            u32x4 w; w.x = cvtpk(x[0], x[1]); w.y = cvtpk(x[2], x[3]); w.z = cvtpk(x[4], x[5]); w.w = cvtpk(x[6], x[7]);
            *(u32x4*)(T.Y + grow * 1024 + ycol + ch * 8) = w; }
    }
    asm volatile("s_waitcnt vmcnt(0) lgkmcnt(0)\n\ts_barrier" ::: "memory");
#undef DMA_TILE
#undef TILE_WAIT
}
#undef ASBAR
#undef AWAIT_BAR
}

constexpr int NWAVES = 8, NTHREADS = NWAVES * 64;
constexpr int BATCH = 8, SEQ = 4096, DM = 1024, DEPTH = 4, M = BATCH * SEQ, D_IN = 3424, NU = 3584;
constexpr float NORM_EPS = 1e-6f;
constexpr float LOG2E = 1.4426950408889634f;
constexpr float QSCALE_64 = 0.125f * LOG2E;
constexpr float QSCALE_96 = 0.10206207261596575f * LOG2E;
constexpr size_t MiB = 1u << 20;
constexpr size_t WS_CTL = 0, CTL_ZERO_BYTES = 1 * MiB;
constexpr size_t WS_WIN = 1 * MiB, WS_WOUT = 29 * MiB, WS_WQ2 = 37 * MiB, WS_WKV2 = 38 * MiB, WS_WPW = 39 * MiB;
constexpr size_t WS_ROPE = 39 * MiB + 512 * 1024, WS_BT = 40 * MiB, WS_KMEAN = 40 * MiB + 256 * 1024;
constexpr size_t WS_SSQQ = 41 * MiB, WS_SSQKV = 41 * MiB + 512 * 1024, WS_SSQO = 42 * MiB, WS_KR = 44 * MiB, WS_CONVH = 46 * MiB, WS_QA = 62 * MiB, WS_KVA = 86 * MiB;
constexpr size_t WS_HNY = 118 * MiB;
constexpr size_t WS_U = 182 * MiB;
constexpr size_t WS_END = 406 * MiB;
static_assert(WS_WIN + (size_t)DEPTH * NU * DM * 2 <= WS_WOUT && WS_WOUT + (size_t)DEPTH * DM * DM * 2 <= WS_WQ2 && WS_WPW + (size_t)DEPTH * 256 * 256 * 2 <= WS_ROPE, "ws map (weights)");
static_assert(WS_ROPE + 2 * SEQ * 16 * 4 <= WS_BT && WS_BT + 4 * 4352 * 4 <= WS_KMEAN && WS_KMEAN + BATCH * 16 * 256 * 4 <= WS_SSQQ && WS_SSQO + (size_t)M * 16 * 4 <= WS_KR, "ws map (tables)");
static_assert(WS_KR + (size_t)M * 32 * 2 <= WS_CONVH && WS_CONVH + (size_t)M * 256 * 2 <= WS_QA && WS_QA + (size_t)M * 384 * 2 <= WS_KVA && WS_KVA + (size_t)M * 512 * 2 <= WS_HNY &&
              WS_HNY + (size_t)M * DM * 2 <= WS_U && WS_U + (size_t)M * NU * 2 <= WS_END, "ws map (activations)");
constexpr int CW_BAR = 4096, CW_QUEUE = 8192;
constexpr int RING_OFF = 0, RING_BYTES = 131072, LDSCTL_OFF = RING_BYTES, MISC_OFF = LDSCTL_OFF + 320, LDS_BYTES = 147456;
#ifndef PH_MASK
#define PH_MASK 0xFFFF
#endif
#define PH_EN(k) ((PH_MASK >> (k)) & 1)
static_assert(att::L_END <= RING_BYTES, "attention LDS map");
#define GAS __attribute__((address_space(1)))
#define LAS __attribute__((address_space(3)))
typedef unsigned short bf16;
typedef unsigned v4u __attribute__((ext_vector_type(4)));
typedef float f32x4 __attribute__((ext_vector_type(4)));
typedef short bf16x8 __attribute__((ext_vector_type(8)));
typedef GAS unsigned gu32;
typedef GAS unsigned long long gu64;
#define RLX_AGENT __ATOMIC_RELAXED, __HIP_MEMORY_SCOPE_AGENT
#define LDS_WAIT() asm volatile("s_waitcnt lgkmcnt(0)" ::: "memory")
#define VM_WAIT() asm volatile("s_waitcnt vmcnt(0)" ::: "memory")
__device__ __forceinline__ unsigned long long rt() { return __builtin_amdgcn_s_memrealtime(); }
__device__ __forceinline__ unsigned f2bf(float f) { unsigned u = __builtin_bit_cast(unsigned, f); return (u + 0x7fffu + ((u >> 16) & 1u)) >> 16; }
__device__ __forceinline__ unsigned pk2(float lo, float hi) { return f2bf(lo) | (f2bf(hi) << 16); }
#define XB_TMO      128
#define XB_XCNT(j)  (256  + 64 * (j))
#define XB_XSUB(j)  (1280 + 64 * (j))
#define XB_XGEN(j)  (2304 + 64 * (j))
#define XB_TOP      3328
#define XB_TOPGEN   3392
#define XCD_BAR_WORDS 3456
#define XB_SPIN_CAP (1u << 18)

__device__ __forceinline__ unsigned xb_ld(unsigned* p)              { return __hip_atomic_load(p, __ATOMIC_RELAXED, __HIP_MEMORY_SCOPE_AGENT); }
__device__ __forceinline__ unsigned xb_add(unsigned* p, unsigned v) { return __hip_atomic_fetch_add(p, v, __ATOMIC_RELAXED, __HIP_MEMORY_SCOPE_AGENT); }
__device__ __forceinline__ unsigned xb_xcc_id() { return (unsigned)__builtin_amdgcn_s_getreg((3 << 11) | 20) & 0xFu; }
#define XB_SPIN(cond, bar) do { unsigned _sp = 0; while (cond) { __builtin_amdgcn_s_sleep(1); \
    if ((++_sp & 255u) == 0u) { if (xb_ld(&(bar)[XB_TMO])) break; if (_sp > XB_SPIN_CAP) { atomicAdd(&(bar)[XB_TMO], 1u); break; } } } } while (0)

struct XcdBarrier {
    unsigned* bar; unsigned x;
    volatile LAS unsigned* st;
};

__device__ __forceinline__ XcdBarrier xcd_barrier_post(unsigned* bar, volatile LAS unsigned* st) {
    XcdBarrier b; b.bar = bar; b.x = xb_xcc_id(); b.st = st;
    if (threadIdx.x == 0) (void)xb_add(&bar[XB_XCNT(b.x)], 1u);
    return b;
}
__device__ __forceinline__ void xcd_barrier_complete(unsigned* bar, unsigned x, unsigned& nloc, unsigned& nx) {
    const unsigned G = gridDim.x * gridDim.y * gridDim.z;
    unsigned sum, cnt, mine, sp = 0u;
    for (;;) {
        sum = 0u; cnt = 0u; mine = 0u;
#pragma unroll
        for (unsigned j = 0; j < 16; ++j) { const unsigned c = xb_ld(&bar[XB_XCNT(j)]); sum += c; cnt += (c > 0u) ? 1u : 0u; mine = (j == x) ? c : mine; }
        if (sum == G) break;
        __builtin_amdgcn_s_sleep(1);
        if ((++sp & 255u) == 0u) { if (xb_ld(&bar[XB_TMO])) break; if (sp > XB_SPIN_CAP) { atomicAdd(&bar[XB_TMO], 1u); break; } }
    }
    nloc = mine > 0u ? mine : 1u; nx = cnt > 0u ? cnt : 1u;
}

__device__ __forceinline__ void xcd_barrier(const XcdBarrier& b) {
    asm volatile("s_waitcnt vmcnt(0)" ::: "memory");
    __syncthreads();
    if (threadIdx.x == 0) {
        unsigned* bar = b.bar;
        __builtin_amdgcn_s_waitcnt(0);
        unsigned nloc = b.st[0], nx = b.st[1];
        if (nloc == 0u) { xcd_barrier_complete(bar, b.x, nloc, nx); b.st[0] = nloc; b.st[1] = nx; }
        const unsigned old = xb_add(&bar[XB_XSUB(b.x)], 1u);
        const unsigned gen = old / nloc;
        if (old + 1u == (gen + 1u) * nloc) {
            __builtin_amdgcn_fence(__ATOMIC_RELEASE, "agent");
            asm volatile("s_waitcnt vmcnt(0)" ::: "memory");
            const unsigned og = xb_add(&bar[XB_TOP], 1u);
            const unsigned tg = og / nx;
            if (og + 1u == (tg + 1u) * nx) xb_add(&bar[XB_TOPGEN], 1u);
            else XB_SPIN(xb_ld(&bar[XB_TOPGEN]) == tg, bar);
            __builtin_amdgcn_fence(__ATOMIC_ACQUIRE, "agent");
            xb_add(&bar[XB_XGEN(b.x)], 1u);
            asm volatile("s_waitcnt vmcnt(0)" ::: "memory");
        } else {
            XB_SPIN(xb_ld(&bar[XB_XGEN(b.x)]) == gen, bar);
            __builtin_amdgcn_fence(__ATOMIC_ACQUIRE, "agent");
            asm volatile("s_waitcnt vmcnt(0)" ::: "memory");
        }
    }
    __syncthreads();
}

struct Frame {
    LAS unsigned char* lds;
    volatile LAS unsigned* MISC;
    gu32* ctl;
    int tid, lane, wave, G, gw, NGW;
    const float* in[16];
    float* out; unsigned char* ws;
};
#define LOCAL_FRAME() Frame F = F0; { int t_ = threadIdx.x; asm volatile("" : "+v"(t_)); F.tid = t_; F.lane = t_ & 63; F.wave = __builtin_amdgcn_readfirstlane(t_ >> 6); \
    F.gw = blockIdx.x * NWAVES + F.wave; unsigned char* w_ = F0.ws; asm volatile("" : "+s"(w_)); F.ws = w_; }
__device__ __forceinline__ float wave_sum(float v) {
#pragma unroll
    for (int o = 1; o < 64; o <<= 1) v += __shfl_xor(v, o);
    return v;
}
__device__ __forceinline__ int ropemap(int j) { const int f = j >> 3, jj = j & 7; return jj < 4 ? 4 * f + jj : 16 + 4 * f + (jj - 4); }
__device__ __forceinline__ int src_in(int n) {
    const int t = n >> 8, c = n & 255;
    if (t == 0) return c < 192 ? c : -1;
    if (t == 1) return c < 128 ? 192 + c : (c < 160 ? 320 + ropemap(c - 128) : -1);
    return 352 + (t - 2) * 256 + c;
}
__device__ __forceinline__ int src_q(int n) {
    if (n < 256) return (n >> 6) * 96 + (n & 63);
    if (n < 384) { const int j = n - 256; return (j >> 5) * 96 + 64 + ropemap(j & 31); }
    return -1;
}
__device__ __forceinline__ int src_kv(int n) {
    if (n < 256) return (n >> 6) * 128 + (n & 63);
    const int j = n - 256; return (j >> 6) * 128 + 64 + (j & 63);
}
template <int MAP> __device__ __forceinline__ void cvt_weight(const float* W, const float* gv, bf16* Wt, int N, int K, int Ksrc, int Nsrc, int gt, int ngt) {
    const int items = N * (K / 8);
    for (int it = gt; it < items; it += ngt) {
        const int n = it % N, kc = it / N;
        const int sc = MAP == 0 ? src_in(n) : MAP == 1 ? src_q(n) : MAP == 2 ? src_kv(n) : n;
        float v[8];
#pragma unroll
        for (int i = 0; i < 8; ++i) { const int k = kc * 8 + i; v[i] = (sc >= 0 && k < Ksrc) ? W[(size_t)k * Nsrc + sc] * (gv ? gv[k] : 1.0f) : 0.0f; }
        v4u o; o.x = pk2(v[0], v[1]); o.y = pk2(v[2], v[3]); o.z = pk2(v[4], v[5]); o.w = pk2(v[6], v[7]);
        *(GAS v4u*)(Wt + (size_t)n * K + kc * 8) = o;
    }
}
__device__ __forceinline__ void rms_row_to_bf16(const f32x4 (&v)[4], const float* g, bf16* orow, int lane) {
    float s = 0.f;
#pragma unroll
    for (int j = 0; j < 4; ++j) s += (v[j][0] * v[j][0] + v[j][1] * v[j][1]) + (v[j][2] * v[j][2] + v[j][3] * v[j][3]);
    const float rstd = 1.0f / sqrtf(wave_sum(s) * (1.0f / 1024.0f) + NORM_EPS);
#pragma unroll
    for (int j = 0; j < 4; ++j) { const f32x4 gg = *(const f32x4*)(g + 4 * lane + 256 * j);
        *(GAS unsigned long long*)(orow + 4 * lane + 256 * j) = (unsigned long long)pk2(v[j][0] * rstd * gg[0], v[j][1] * rstd * gg[1]) | ((unsigned long long)pk2(v[j][2] * rstd * gg[2], v[j][3] * rstd * gg[3]) << 32); }
}

__device__ __forceinline__ void p_prologue(Frame& F0) {
    LOCAL_FRAME();
    const int gt = blockIdx.x * NTHREADS + F.tid, ngt = F.G * NTHREADS;
    for (int l = 0; l < DEPTH; ++l) {
        cvt_weight<0>(F.in[2] + (size_t)l * DM * D_IN, nullptr, (bf16*)(F.ws + WS_WIN) + (size_t)l * NU * DM, NU, DM, DM, D_IN, gt, ngt);
        cvt_weight<1>(F.in[4] + (size_t)l * 192 * 384, F.in[3] + l * 192, (bf16*)(F.ws + WS_WQ2) + (size_t)l * 512 * 256, 512, 256, 192, 384, gt, ngt);
        cvt_weight<2>(F.in[6] + (size_t)l * 128 * 512, F.in[5] + l * 128, (bf16*)(F.ws + WS_WKV2) + (size_t)l * 512 * 256, 512, 256, 128, 512, gt, ngt);
        cvt_weight<3>(F.in[12] + (size_t)l * 256 * 256, nullptr, (bf16*)(F.ws + WS_WPW) + (size_t)l * 256 * 256, 256, 256, 256, 256, gt, ngt);
        cvt_weight<3>(F.in[14] + (size_t)l * DM * DM, nullptr, (bf16*)(F.ws + WS_WOUT) + (size_t)l * DM * DM, DM, DM, DM, DM, gt, ngt);
    }
    float* cosT = (float*)(F.ws + WS_ROPE); float* sinT = cosT + SEQ * 16;
    for (int it = gt; it < SEQ * 16; it += ngt) { const int pos = it >> 4, i = it & 15;
        const float freq = powf(10000.0f, -(float)i / 16.0f); const float ang = (float)pos * freq;
        cosT[it] = cosf(ang); sinT[it] = sinf(ang); }
    float* BT = (float*)(F.ws + WS_BT);
    for (int it = gt; it < 4 * att::TBL_N; it += ngt) { const int h = it / att::TBL_N, idx = it % att::TBL_N; const int dist = idx - 256; const int n = dist > 0 ? dist : 0;
        int bucket;
        if (n < 16) bucket = n;
        else { bucket = 16 + (int)floor((log2((double)n) - 4.0) * (8.0 / 3.0) + 1e-9); if (bucket > 31) bucket = 31; }
        BT[it] = F.in[7][bucket * 4 + h] * 1.4426950408889634f; }
    const float* x = F.in[0]; bf16* HN = (bf16*)(F.ws + WS_HNY);
    for (int m = F.gw; m < M; m += F.NGW) { f32x4 v[4];
#pragma unroll
        for (int j = 0; j < 4; ++j) v[j] = *(const f32x4*)(x + (size_t)m * DM + 4 * F.lane + 256 * j);
        rms_row_to_bf16(v, F.in[1], HN + (size_t)m * DM, F.lane); }
}

__device__ __forceinline__ void conv_unit(Frame& F0, int l, int unit) {
    LOCAL_FRAME();
    const bf16* U = (const bf16*)(F.ws + WS_U); bf16* CH = (bf16*)(F.ws + WS_CONVH);
    LAS float* xg = (LAS float*)F.lds;
    const int r0 = unit * 64, s0 = r0 & (SEQ - 1);
    for (int it = F.tid; it < 94 * 32; it += NTHREADS) { const int rr = it >> 5, cg = it & 31; const int srow = r0 - 30 + rr;
        float o[8];
        if (s0 - 30 + rr >= 0) {
            const v4u a = *(const GAS v4u*)(U + (size_t)srow * NU + 2048 + cg * 8), g = *(const GAS v4u*)(U + (size_t)srow * NU + 2304 + cg * 8);
            const float av[8] = {pg8::bf_lo(a.x), pg8::bf_hi(a.x), pg8::bf_lo(a.y), pg8::bf_hi(a.y), pg8::bf_lo(a.z), pg8::bf_hi(a.z), pg8::bf_lo(a.w), pg8::bf_hi(a.w)};
            const float gv[8] = {pg8::bf_lo(g.x), pg8::bf_hi(g.x), pg8::bf_lo(g.y), pg8::bf_hi(g.y), pg8::bf_lo(g.z), pg8::bf_hi(g.z), pg8::bf_lo(g.w), pg8::bf_hi(g.w)};
#pragma unroll
            for (int j = 0; j < 8; ++j) o[j] = av[j] / (1.0f + __expf(-gv[j]));
        } else {
#pragma unroll
            for (int j = 0; j < 8; ++j) o[j] = 0.f;
        }
        *(LAS f32x4*)(xg + rr * 256 + cg * 8) = (f32x4){o[0], o[1], o[2], o[3]}; *(LAS f32x4*)(xg + rr * 256 + cg * 8 + 4) = (f32x4){o[4], o[5], o[6], o[7]}; }
    __syncthreads();
    const int c = F.tid & 255, rh = F.tid >> 8;
    float y[32];
    { float win[62], wt[31];
      const float* dw = F.in[8] + (size_t)l * 31 * 256 + c;
#pragma unroll
      for (int w = 0; w < 31; ++w) wt[w] = dw[w * 256];
#pragma unroll
      for (int i = 0; i < 62; ++i) win[i] = xg[(rh * 32 + i) * 256 + c];
      const float bias = F.in[9][l * 256 + c];
#pragma unroll
      for (int s = 0; s < 32; ++s) { float a = bias;
#pragma unroll
          for (int w = 0; w < 31; ++w) a += wt[w] * win[s + w];
          y[s] = a; } }
    __syncthreads();
#pragma unroll
    for (int s = 0; s < 32; ++s) xg[(rh * 32 + s) * 256 + c] = y[s];
    __syncthreads();
    const f32x4 lg = *(const f32x4*)(F.in[10] + l * 256 + 4 * F.lane), lb = *(const f32x4*)(F.in[11] + l * 256 + 4 * F.lane);
#pragma unroll
    for (int i = 0; i < 8; ++i) { const int row = 8 * F.wave + i;
        const f32x4 v = *(LAS f32x4*)(xg + row * 256 + 4 * F.lane);
        const float mean = wave_sum((v[0] + v[1]) + (v[2] + v[3])) * (1.0f / 256.0f);
        const f32x4 d = v - mean;
        const float var = wave_sum((d[0] * d[0] + d[1] * d[1]) + (d[2] * d[2] + d[3] * d[3])) * (1.0f / 256.0f);
        const float rstd = 1.0f / sqrtf(var + NORM_EPS);
        f32x4 o = d * rstd * lg + lb;
#pragma unroll
        for (int j = 0; j < 4; ++j) o[j] = o[j] / (1.0f + __expf(-o[j]));
        *(GAS unsigned long long*)(CH + (size_t)(r0 + row) * 256 + 4 * F.lane) = (unsigned long long)pk2(o[0], o[1]) | ((unsigned long long)pk2(o[2], o[3]) << 32); }
    __syncthreads();
}
__device__ __forceinline__ void kmean_unit(Frame& F0, int item) {
    LOCAL_FRAME();
    const bf16* U = (const bf16*)(F.ws + WS_U); float* KM = (float*)(F.ws + WS_KMEAN);
    LAS float* part = (LAS float*)F.lds;
    const int cg = F.tid & 31, rg = F.tid >> 5; const size_t base = (size_t)item * 256 + rg * 16;
    float a[8];
#pragma unroll
    for (int j = 0; j < 8; ++j) a[j] = 0.f;
#pragma unroll 4
    for (int i = 0; i < 16; ++i) { const v4u k = *(const GAS v4u*)(U + (base + i) * NU + 1536 + cg * 8);
        a[0] += pg8::bf_lo(k.x); a[1] += pg8::bf_hi(k.x); a[2] += pg8::bf_lo(k.y); a[3] += pg8::bf_hi(k.y); a[4] += pg8::bf_lo(k.z); a[5] += pg8::bf_hi(k.z); a[6] += pg8::bf_lo(k.w); a[7] += pg8::bf_hi(k.w); }
#pragma unroll
    for (int j = 0; j < 8; ++j) part[rg * 256 + cg * 8 + j] = a[j];
    __syncthreads();
    if (F.tid < 256) { float s = 0.f;
#pragma unroll
        for (int r = 0; r < 16; ++r) s += part[r * 256 + F.tid];
        KM[(size_t)item * 256 + F.tid] = s * (1.0f / 256.0f); }
    __syncthreads();
}
__device__ __forceinline__ void p_residual(Frame& F0, int l) {
    LOCAL_FRAME();
    const float* xs = (l == 0) ? F.in[0] : F.out;
    const bf16* T = (const bf16*)(F.ws + WS_U); const float* SS = (const float*)(F.ws + WS_SSQO); bf16* HN = (bf16*)(F.ws + WS_HNY);
    const float* gp = F.in[15] + l * DM;
    for (int m = F.gw; m < M; m += F.NGW) {
        const f32x4 s0 = *(const f32x4*)(SS + (size_t)m * 16), s1 = *(const f32x4*)(SS + (size_t)m * 16 + 4), s2 = *(const f32x4*)(SS + (size_t)m * 16 + 8), s3 = *(const f32x4*)(SS + (size_t)m * 16 + 12);
        const float ss = (((s0[0] + s0[1]) + (s0[2] + s0[3])) + ((s1[0] + s1[1]) + (s1[2] + s1[3]))) + (((s2[0] + s2[1]) + (s2[2] + s2[3])) + ((s3[0] + s3[1]) + (s3[2] + s3[3])));
        const float rstd = 1.0f / sqrtf(ss * (1.0f / 1024.0f) + NORM_EPS);
        f32x4 v[4];
#pragma unroll
        for (int j = 0; j < 4; ++j) { const int col = 4 * F.lane + 256 * j;
            const f32x4 xo = *(const f32x4*)(xs + (size_t)m * DM + col), g = *(const f32x4*)(gp + col);
            const unsigned long long tw = *(const GAS unsigned long long*)(T + (size_t)m * DM + col);
            const unsigned t0 = (unsigned)tw, t1 = (unsigned)(tw >> 32);
            const f32x4 tv = (f32x4){pg8::bf_lo(t0), pg8::bf_hi(t0), pg8::bf_lo(t1), pg8::bf_hi(t1)};
            v[j] = xo + tv * rstd * g;
            *(f32x4*)(F.out + (size_t)m * DM + col) = v[j]; }
        if (l + 1 < DEPTH) rms_row_to_bf16(v, F.in[1] + (l + 1) * DM, HN + (size_t)m * DM, F.lane);
    }
}

struct Args { const float* in[16]; float* out; unsigned char* ws; };
__global__ void __launch_bounds__(NTHREADS, 2) hymba_fwd(Args args) {
    extern __shared__ __attribute__((aligned(16))) unsigned char lds[];
    Frame F;
    F.lds = (LAS unsigned char*)lds;
    F.MISC = (volatile LAS unsigned*)(F.lds + MISC_OFF);
    F.tid = threadIdx.x; F.lane = F.tid & 63; F.wave = __builtin_amdgcn_readfirstlane(F.tid >> 6);
    F.G = gridDim.x; F.gw = blockIdx.x * NWAVES + F.wave; F.NGW = F.G * NWAVES;
#pragma unroll
    for (int i = 0; i < 16; ++i) F.in[i] = args.in[i];
    F.out = args.out; F.ws = args.ws; F.ctl = (gu32*)(args.ws + WS_CTL);
    for (int u = F.tid; u < (LDS_BYTES - LDSCTL_OFF) / 4; u += NTHREADS) ((LAS unsigned*)(F.lds + LDSCTL_OFF))[u] = 0u;
    __syncthreads();
    XcdBarrier bar = xcd_barrier_post((unsigned*)(F.ctl + CW_BAR), F.MISC + 8);
    const unsigned lds0 = (unsigned)(uintptr_t)lds;
#define GRID_BAR() do { XcdBarrier b_ = bar; asm volatile("" : "+s"(b_.x)); xcd_barrier(b_); } while (0)

#define PHASE_PTRS() unsigned char* ws_ = F.ws; asm volatile("" : "+s"(ws_)); \
    bf16* const HNY = (bf16*)(ws_ + WS_HNY); bf16* const UB = (bf16*)(ws_ + WS_U); \
    float* const SSQQ = (float*)(ws_ + WS_SSQQ); float* const SSQKV = (float*)(ws_ + WS_SSQKV); float* const SSQO = (float*)(ws_ + WS_SSQO); \
    bf16* const KRB = (bf16*)(ws_ + WS_KR); bf16* const QAB = (bf16*)(ws_ + WS_QA); bf16* const KVAB = (bf16*)(ws_ + WS_KVA); bf16* const CHB = (bf16*)(ws_ + WS_CONVH); \
    const float* const cosT = (const float*)(ws_ + WS_ROPE); const float* const sinT = cosT + SEQ * 16; \
    (void)HNY; (void)UB; (void)SSQQ; (void)SSQKV; (void)SSQO; (void)KRB; (void)QAB; (void)KVAB; (void)CHB; (void)cosT; (void)sinT

#if PH_EN(0)
    p_prologue(F);
#endif
    GRID_BAR();

    for (int l = 0; l < DEPTH; ++l) {
#if PH_EN(1)
        {
            PHASE_PTRS();
            pg8::Gemm g{HNY, (const bf16*)(ws_ + WS_WIN) + (size_t)l * NU * DM, M, NU, DM, DM}; pg8::StaticOrder S; S.init(M, NU, F.G, (int)blockIdx.x);
            pg8::EpiIn E{UB, SSQQ, SSQKV, KRB, cosT, sinT, QSCALE_64};
            pg8::gemm_phase<pg8::EpiIn, pg8::StaticOrder, true, true>(F.lds + RING_OFF, g, S, E);
        }
#endif
        GRID_BAR();
#if PH_EN(2)
        {
            PHASE_PTRS();
            pg8::Gemm g{UB, (const bf16*)(ws_ + WS_WQ2) + (size_t)l * 512 * 256, M, 512, 256, NU}; pg8::StaticOrder S; S.init(M, 512, F.G, (int)blockIdx.x);
            pg8::EpiQ E{QAB, SSQQ, cosT, sinT, QSCALE_96, NORM_EPS};
            pg8::gemm_phase<pg8::EpiQ, pg8::StaticOrder, true, true>(F.lds + RING_OFF, g, S, E);
        }
        __syncthreads();
#endif
#if PH_EN(8)
        {
            PHASE_PTRS();
            pg8::Gemm g{UB + 256, (const bf16*)(ws_ + WS_WKV2) + (size_t)l * 512 * 256, M, 512, 256, NU}; pg8::StaticOrder S; S.init(M, 512, F.G, (int)blockIdx.x);
            pg8::EpiKV E{KVAB, SSQKV, NORM_EPS};
            pg8::gemm_phase<pg8::EpiKV, pg8::StaticOrder, true, true>(F.lds + RING_OFF, g, S, E);
        }
        __syncthreads();
#endif
#if PH_EN(3)
        for (int u = blockIdx.x; u < M / 64; u += F.G) conv_unit(F, l, u);
        for (int it = blockIdx.x; it < BATCH * 16; it += F.G) kmean_unit(F, it);
#endif
        GRID_BAR();
#if PH_EN(4)
        {
            PHASE_PTRS();
            pg8::Gemm g{CHB, (const bf16*)(ws_ + WS_WPW) + (size_t)l * 256 * 256, M, 256, 256, 256}; pg8::StaticOrder S; S.init(M, 256, F.G, (int)blockIdx.x);
            pg8::EpiPW E{HNY, UB, F.in[13] + l * 256};
            pg8::gemm_phase<pg8::EpiPW, pg8::StaticOrder, true, true>(F.lds + RING_OFF, g, S, E);
        }
        __syncthreads();
#endif
#if PH_EN(5)
        {
            PHASE_PTRS();
            const att::Tensors AT{UB, QAB, KVAB, KRB, HNY, (const float*)(ws_ + WS_BT), (const float*)(ws_ + WS_KMEAN)};
            gu32* qctr = F.ctl + CW_QUEUE + 64 * l;
            for (;;) {
                if (F.tid == 0) F.MISC[16] = __hip_atomic_fetch_add(qctr, 1u, RLX_AGENT);
                __syncthreads();
                const int idx = (int)F.MISC[16];
                if (idx >= 1536) break;
                int type, qb, bh;
                if (idx < 1024) { qb = 15 - (idx >> 6); const int j = idx & 63; type = (j < 32) ? 0 : 2; bh = j & 31; }
                else { const int s = idx - 1024; type = 1; qb = 15 - (s >> 5); bh = s & 31; }
                const int b = bh >> 2, h = bh & 3;
                if (type == 0) att::attn_unit<0>(AT, b, h, qb, (LAS char*)(F.lds + RING_OFF), lds0 + RING_OFF);
                else if (type == 2) att::attn_unit<2>(AT, b, h, qb, (LAS char*)(F.lds + RING_OFF), lds0 + RING_OFF);
                else att::attn_unit<1>(AT, b, h, qb, (LAS char*)(F.lds + RING_OFF), lds0 + RING_OFF);
            }
        }
#endif
        GRID_BAR();
#if PH_EN(6)
        {
            PHASE_PTRS();
            pg8::Gemm g{HNY, (const bf16*)(ws_ + WS_WOUT) + (size_t)l * DM * DM, M, DM, DM, DM}; pg8::StaticOrder S; S.init(M, DM, F.G, (int)blockIdx.x);
            pg8::EpiOut E{UB, SSQO};
            pg8::gemm_phase<pg8::EpiOut, pg8::StaticOrder, true, true>(F.lds + RING_OFF, g, S, E);
        }
#endif
        GRID_BAR();
#if PH_EN(7)
        p_residual(F, l);
#endif
        if (l + 1 < DEPTH) GRID_BAR();
    }
}

extern "C" void kernel_launch(void* const* d_in, const int* in_sizes, int n_in, void* d_out, int out_size, void* d_ws, size_t ws_size, hipStream_t stream) {
    static int grid = 0;
    if (grid == 0) {
        if (n_in != 16 || in_sizes[0] != M * DM || out_size != M * DM || ws_size < WS_END) { fprintf(stderr, "kernel_launch: unexpected shapes (n_in %d, in0 %d, out %d, ws %zu < %zu); nothing launched\n", n_in, n_in > 0 ? in_sizes[0] : -1, out_size, ws_size, (size_t)WS_END); grid = -1; return; }
        int dev = 0, cus = 0, per_cu = 0;
        if (hipGetDevice(&dev) != hipSuccess || hipDeviceGetAttribute(&cus, hipDeviceAttributeMultiprocessorCount, dev) != hipSuccess) { grid = -1; return; }
        if (hipFuncSetAttribute((const void*)hymba_fwd, hipFuncAttributeMaxDynamicSharedMemorySize, LDS_BYTES) != hipSuccess) { fprintf(stderr, "kernel_launch: hipFuncSetAttribute failed\n"); grid = -1; return; }
        if (hipOccupancyMaxActiveBlocksPerMultiprocessor(&per_cu, (const void*)hymba_fwd, NTHREADS, LDS_BYTES) != hipSuccess || per_cu < 1) fprintf(stderr, "kernel_launch: occupancy query reports %d\n", per_cu);
        (void)hipGetLastError();
        grid = cus;
    }
    if (grid < 0) return;
    if (hipMemsetAsync((char*)d_ws + WS_CTL, 0, CTL_ZERO_BYTES, stream) != hipSuccess) return;
    Args a{};
    for (int i = 0; i < 16; ++i) a.in[i] = (const float*)d_in[i];
    a.out = (float*)d_out; a.ws = (unsigned char*)d_ws;
    hipLaunchKernelGGL(hymba_fwd, dim3(grid), dim3(NTHREADS), LDS_BYTES, stream, a);
}
```

```cpp
#include <hip/hip_runtime.h>
#include <hip/hip_bf16.h>
#include <cstdio>
#include <cstdint>
#include <cmath>
#define TUNED_MOBA 1
#define TUNED_MLA 1
#define SB_RES 1
namespace pg8 {
#define PG8_LAS __attribute__((address_space(3)))
typedef unsigned short bf16_t;
typedef short bf16x8 __attribute__((ext_vector_type(8)));
typedef float f32x4 __attribute__((ext_vector_type(4)));
typedef unsigned u32x4 __attribute__((ext_vector_type(4)));
constexpr int BM = 256, BK = 64, HALF = 128, HTB = HALF * BK * 2  , STAGE_BYTES = 8 * HTB, NXCD = 8, WGM = 8;

__host__ __device__ __forceinline__ int lds_byte(int r, int c) { const int st = (r >> 4) * 2 + (c >> 5), rr = r & 15, cc = c & 31, ob = rr * 64 + cc * 2; return st * 1024 + (ob ^ (((ob >> 9) & 1) << 5)); }
__host__ __device__ __forceinline__ void stage_rc(int b, int& R, int& C) { const int st = b / 1024, sb = b % 1024, swz = sb ^ (((sb >> 9) & 1) << 5); R = (st >> 1) * 16 + swz / 64; C = (st & 1) * 32 + (swz % 64) / 2; }
__host__ __device__ __forceinline__ int perm32(int rho) { const int n = rho >> 4, i = rho & 15; return 8 * (i >> 2) + 4 * n + (i & 3); }

struct Unit { int pm, pn; };
struct Gemm { const bf16_t* A; const bf16_t* Bt; int M, N, K, lda; };

struct StaticOrder {
    int nM, nN, nwg, G, c;
    __host__ __device__ void init(int M, int N, int G_, int c_) { nM = M / BM; nN = N / BM; nwg = nM * nN; G = G_; c = c_; }
    __host__ __device__ bool next(int i, Unit& u) const {
        const long L = (long)i * G + c; if (L >= nwg) return false;
        int wgid = (int)L; { const int q = nwg / NXCD, r = nwg % NXCD, xcd = wgid % NXCD, off = wgid / NXCD; wgid = (xcd < r ? xcd * (q + 1) : r * (q + 1) + (xcd - r) * q) + off; }
        const int nig = WGM * nN, gid = wgid / nig, fm = gid * WGM, gsz = (nM - fm) < WGM ? (nM - fm) : WGM;
        u.pm = fm + ((wgid % nig) % gsz); u.pn = (wgid % nig) / gsz; return true;
    }
    __device__ __forceinline__ void a_ready(const Unit&) const {}
    __device__ __forceinline__ void done(const Unit&) const {}
};

__device__ __forceinline__ unsigned cvt_pk_bf16(float lo, float hi) { unsigned r; asm volatile("v_cvt_pk_bf16_f32 %0, %1, %2" : "=v"(r) : "v"(lo), "v"(hi)); return r; }
typedef float f32x2 __attribute__((ext_vector_type(2)));
__device__ __forceinline__ u32x4 pack8(f32x4 a, f32x4 b) { u32x4 w; w.x = cvt_pk_bf16(a[0], a[1]); w.y = cvt_pk_bf16(a[2], a[3]); w.z = cvt_pk_bf16(b[0], b[1]); w.w = cvt_pk_bf16(b[2], b[3]); return w; }
__device__ __forceinline__ float bf_lo(unsigned w) { return __uint_as_float(w << 16); }
__device__ __forceinline__ float bf_hi(unsigned w) { return __uint_as_float(w & 0xffff0000u); }
__device__ __forceinline__ float silu_f(float g) { return g / (1.0f + __expf(-g)); }

struct EpiIn {
    static constexpr bool PERM = true, AFTER_DRAIN = false;
    bf16_t* U; float* ssq_q; float* ssq_kv; bf16_t* KR; const float* cosT; const float* sinT; float qscale; const float* rstd;
    __device__ __forceinline__ void operator()(const f32x4 (&acc0)[2][2][4][2], const Unit& u, int wr, int wc, int fr, int fq) const {
        const int pn = u.pn;
        f32x4 acc[2][2][4][2];
#pragma unroll
        for (int ai = 0; ai < 2; ++ai)
#pragma unroll
            for (int m = 0; m < 4; ++m) { const float rs = rstd[u.pm * BM + wr * 64 + fr + ai * HALF + m * 16];
#pragma unroll
                for (int bj = 0; bj < 2; ++bj)
#pragma unroll
                    for (int n = 0; n < 2; ++n) acc[ai][bj][m][n] = acc0[ai][bj][m][n] * rs; }
        const float sc = (pn == 2 || pn == 5) ? qscale : 1.0f;
        const int row0 = u.pm * BM + wr * 64 + fr, col0 = pn * BM + wc * 32 + 8 * fq;
#pragma unroll
        for (int ai = 0; ai < 2; ++ai)
#pragma unroll
            for (int m = 0; m < 4; ++m) { bf16_t* rowp = U + (size_t)(row0 + ai * HALF + m * 16) * 3584 + col0;
#pragma unroll
                for (int bj = 0; bj < 2; ++bj) *(u32x4*)(rowp + bj * HALF) = pack8(acc[ai][bj][m][0] * sc, acc[ai][bj][m][1] * sc); }
        if (pn <= 1) {
            float* ssq = pn == 0 ? ssq_q : ssq_kv;
#pragma unroll
            for (int ai = 0; ai < 2; ++ai)
#pragma unroll
                for (int m = 0; m < 4; ++m) {
                    float s = 0.f;
#pragma unroll
                    for (int n = 0; n < 2; ++n) { const f32x4 x = acc[ai][0][m][n]; s += (x[0] * x[0] + x[1] * x[1]) + (x[2] * x[2] + x[3] * x[3]); }
                    if (pn == 0) {
#pragma unroll
                        for (int n = 0; n < 2; ++n) { const f32x4 x = acc[ai][1][m][n]; s += (x[0] * x[0] + x[1] * x[1]) + (x[2] * x[2] + x[3] * x[3]); } }
                    s += __shfl_xor(s, 16); s += __shfl_xor(s, 32);
                    if (fq == 0) ssq[(size_t)(row0 + ai * HALF + m * 16) * 4 + wc] = s;
                }
        }
        if (pn == 1 && wc == 0) {
#pragma unroll
            for (int ai = 0; ai < 2; ++ai)
#pragma unroll
                for (int m = 0; m < 4; ++m) { const int row = row0 + ai * HALF + m * 16, pos = row & 4095;
                    const f32x4 c = *(const f32x4*)(cosT + pos * 16 + 4 * fq), s = *(const f32x4*)(sinT + pos * 16 + 4 * fq);
                    const f32x4 x1 = acc[ai][1][m][0], x2 = acc[ai][1][m][1];
                    *(u32x4*)(KR + (size_t)row * 32 + 8 * fq) = pack8(x1 * c - x2 * s, x1 * s + x2 * c);
                    asm volatile("" ::: "memory"); }
        }
    }
};
struct EpiQ {
    static constexpr bool PERM = true, AFTER_DRAIN = false;
    bf16_t* QA; const float* ssq_q; const float* cosT; const float* sinT; float scale; float eps;
    __device__ __forceinline__ void operator()(const f32x4 (&acc)[2][2][4][2], const Unit& u, int wr, int wc, int fr, int fq) const {
        const int row0 = u.pm * BM + wr * 64 + fr;
#pragma unroll
        for (int ai = 0; ai < 2; ++ai)
#pragma unroll
            for (int m = 0; m < 4; ++m) { const int row = row0 + ai * HALF + m * 16;
                const f32x4 s4 = *(const f32x4*)(ssq_q + (size_t)row * 4);
                const float rs = scale / sqrtf(((s4[0] + s4[1]) + (s4[2] + s4[3])) * (1.0f / 192.0f) + eps);
                if (u.pn == 0) {
#pragma unroll
                    for (int bj = 0; bj < 2; ++bj) *(u32x4*)(QA + (size_t)row * 384 + bj * HALF + wc * 32 + 8 * fq) = pack8(acc[ai][bj][m][0] * rs, acc[ai][bj][m][1] * rs);
                } else {
                    const int pos = row & 4095;
                    const f32x4 c = *(const f32x4*)(cosT + pos * 16 + 4 * fq), s = *(const f32x4*)(sinT + pos * 16 + 4 * fq);
                    const f32x4 x1 = acc[ai][0][m][0] * rs, x2 = acc[ai][0][m][1] * rs;
                    *(u32x4*)(QA + (size_t)row * 384 + 256 + wc * 32 + 8 * fq) = pack8(x1 * c - x2 * s, x1 * s + x2 * c);
                }
                asm volatile("" ::: "memory"); }
    }
};
struct EpiKV {
    static constexpr bool PERM = true, AFTER_DRAIN = false;
    bf16_t* KVA; const float* ssq_kv; float eps;
    __device__ __forceinline__ void operator()(const f32x4 (&acc)[2][2][4][2], const Unit& u, int wr, int wc, int fr, int fq) const {
        const int row0 = u.pm * BM + wr * 64 + fr;
#pragma unroll
        for (int ai = 0; ai < 2; ++ai)
#pragma unroll
            for (int m = 0; m < 4; ++m) { const int row = row0 + ai * HALF + m * 16;
                const f32x4 s4 = *(const f32x4*)(ssq_kv + (size_t)row * 4);
                const float rs = 1.0f / sqrtf(((s4[0] + s4[1]) + (s4[2] + s4[3])) * (1.0f / 128.0f) + eps);
#pragma unroll
                for (int bj = 0; bj < 2; ++bj) *(u32x4*)(KVA + (size_t)row * 512 + u.pn * BM + bj * HALF + wc * 32 + 8 * fq) = pack8(acc[ai][bj][m][0] * rs, acc[ai][bj][m][1] * rs);
                asm volatile("" ::: "memory"); }
    }
};
struct EpiPW {
    static constexpr bool PERM = true, AFTER_DRAIN = false;
    bf16_t* Y; const bf16_t* U; const float* pwb;
    __device__ __forceinline__ void operator()(const f32x4 (&acc)[2][2][4][2], const Unit& u, int wr, int wc, int fr, int fq) const {
        const int row0 = u.pm * BM + wr * 64 + fr, c0 = wc * 32 + 8 * fq;
#pragma unroll
        for (int ai = 0; ai < 2; ++ai)
#pragma unroll
            for (int m = 0; m < 4; ++m) { const int row = row0 + ai * HALF + m * 16;
#pragma unroll
                for (int bj = 0; bj < 2; ++bj) { const int c = c0 + bj * HALF;
                    const f32x4 b0 = *(const f32x4*)(pwb + c), b1 = *(const f32x4*)(pwb + c + 4);
                    const u32x4 g = *(const u32x4*)(U + (size_t)row * 3584 + 2560 + 768 + c);
                    f32x4 v0 = acc[ai][bj][m][0] + b0, v1 = acc[ai][bj][m][1] + b1;
                    v0[0] *= silu_f(bf_lo(g.x)); v0[1] *= silu_f(bf_hi(g.x)); v0[2] *= silu_f(bf_lo(g.y)); v0[3] *= silu_f(bf_hi(g.y));
                    v1[0] *= silu_f(bf_lo(g.z)); v1[1] *= silu_f(bf_hi(g.z)); v1[2] *= silu_f(bf_lo(g.w)); v1[3] *= silu_f(bf_hi(g.w));
                    *(u32x4*)(Y + (size_t)row * 1024 + 768 + c) = pack8(v0, v1);
                    asm volatile("" ::: "memory"); } }
    }
};
struct EpiOut {
    static constexpr bool PERM = true, AFTER_DRAIN = false;
    bf16_t* T; float* ssq_o;
    __device__ __forceinline__ void operator()(const f32x4 (&acc)[2][2][4][2], const Unit& u, int wr, int wc, int fr, int fq) const {
        const int row0 = u.pm * BM + wr * 64 + fr, col0 = u.pn * BM + wc * 32 + 8 * fq;
#pragma unroll
        for (int ai = 0; ai < 2; ++ai)
#pragma unroll
            for (int m = 0; m < 4; ++m) { const int row = row0 + ai * HALF + m * 16; float s = 0.f;
#pragma unroll
                for (int bj = 0; bj < 2; ++bj) { *(u32x4*)(T + (size_t)row * 1024 + col0 + bj * HALF) = pack8(acc[ai][bj][m][0], acc[ai][bj][m][1]);
#pragma unroll
                    for (int n = 0; n < 2; ++n) { const f32x4 x = acc[ai][bj][m][n]; s += (x[0] * x[0] + x[1] * x[1]) + (x[2] * x[2] + x[3] * x[3]); } }
                s += __shfl_xor(s, 16); s += __shfl_xor(s, 32);
                if (fq == 0) ssq_o[(size_t)row * 16 + u.pn * 4 + wc] = s; }
    }
};
template <class Epi, class Sched, bool ALIGN_EPI = false, bool SP2 = false>
__device__ __forceinline__ void gemm_phase(PG8_LAS unsigned char* lds, const Gemm g, const Sched& S, const Epi& E) {
    int tid_ = threadIdx.x; asm volatile("" : "+v"(tid_));
    const int tid = tid_, wid = __builtin_amdgcn_readfirstlane(tid >> 6), lane = tid & 63, wr = wid >> 2, wc = wid & 3, fr = lane & 15, fq = lane >> 4;
    const int K = g.K, nt = K / BK;
    unsigned voffA[2], voffB[2];
#pragma unroll
    for (int i = 0; i < 2; ++i) { int R, C; stage_rc(tid * 16 + i * 8192, R, C); const int Rb = Epi::PERM ? ((R & ~31) + perm32(R & 31)) : R;
        voffA[i] = (unsigned)(R * g.lda + C) * 2u; voffB[i] = (unsigned)(Rb * K + C) * 2u; }
    const size_t kstep = (size_t)(BK * 2);
    const size_t hstepA = (size_t)HALF * g.lda * 2, hstepB = (size_t)HALF * K * 2;
    const size_t tstepA = 2 * hstepA, tstepB = 2 * hstepB;
    const unsigned ldsw = (unsigned)wid * 1024u;
    const int aoff = lds_byte(wr * 64 + fr, fq * 8), boff = lds_byte(wc * 32 + fr, fq * 8);
#define PG8_SA(b, h) (((b) * 2 + (h)) * HTB)
#define PG8_SB(b, h) ((4 + (b) * 2 + (h)) * HTB)
#define PG8_STAGE(bufoff, gbase, voff) do { _Pragma("unroll") for (int _i = 0; _i < 2; ++_i) \
        __builtin_amdgcn_global_load_lds((const unsigned*)((const char*)(gbase) + (voff)[_i]), (PG8_LAS unsigned*)(lds + (bufoff) + ldsw + _i * 8192), 16, 0, 0); } while (0)
#define PG8_LDA(dst, b, h) do { _Pragma("unroll") for (int m = 0; m < 4; ++m) _Pragma("unroll") for (int k = 0; k < 2; ++k) dst[m][k] = *(const PG8_LAS bf16x8*)(lds + PG8_SA(b, h) + aoff + m * 2048 + k * 1024); } while (0)
#define PG8_LDB(dst, b, h) do { _Pragma("unroll") for (int n = 0; n < 2; ++n) _Pragma("unroll") for (int k = 0; k < 2; ++k) dst[n][k] = *(const PG8_LAS bf16x8*)(lds + PG8_SB(b, h) + boff + n * 2048 + k * 1024); } while (0)
#define PG8_MMA(ai, bj, At, Bt) do { __builtin_amdgcn_s_setprio(1); _Pragma("unroll") for (int m = 0; m < 4; ++m) _Pragma("unroll") for (int n = 0; n < 2; ++n) _Pragma("unroll") for (int k = 0; k < 2; ++k) \
        acc[ai][bj][m][n] = __builtin_amdgcn_mfma_f32_16x16x32_bf16(Bt[n][k], At[m][k], acc[ai][bj][m][n], 0, 0, 0); __builtin_amdgcn_s_setprio(0); } while (0)
#define PG8_WAIT_V(n) asm volatile("s_waitcnt vmcnt(" #n ")" ::: "memory")
#define PG8_WAIT_L(n) asm volatile("s_waitcnt lgkmcnt(" #n ")" ::: "memory")
#define PG8_BAR __builtin_amdgcn_s_barrier()
#define PG8_SCHED __builtin_amdgcn_sched_barrier(0)
    Unit cur, nxt; int ui = 0;
    if (!S.next(0, cur)) return;
    f32x4 acc[2][2][4][2];
#pragma unroll
    for (int a = 0; a < 2; ++a)
#pragma unroll
        for (int b = 0; b < 2; ++b)
#pragma unroll
            for (int m = 0; m < 4; ++m)
#pragma unroll
                for (int n = 0; n < 2; ++n) acc[a][b][m][n] = (f32x4){0.f, 0.f, 0.f, 0.f};
    bf16x8 At[4][2], B0[2][2], B1[2][2];
    const char* cA = (const char*)g.A + (size_t)cur.pm * tstepA; const char* cB = (const char*)g.Bt + (size_t)cur.pn * tstepB;
    S.a_ready(cur);
    if constexpr (SP2) {
        PG8_STAGE(PG8_SB(0, 0), cB, voffB); PG8_STAGE(PG8_SB(0, 1), cB + hstepB, voffB); PG8_STAGE(PG8_SA(0, 0), cA, voffA); PG8_STAGE(PG8_SA(0, 1), cA + hstepA, voffA);
        if (wr == 1) PG8_BAR;
        PG8_WAIT_V(2); PG8_BAR;
        PG8_STAGE(PG8_SB(1, 0), cB + kstep, voffB); PG8_STAGE(PG8_SA(1, 0), cA + kstep, voffA); PG8_STAGE(PG8_SB(1, 1), cB + hstepB + kstep, voffB);
        PG8_WAIT_V(6); PG8_BAR;
    } else {
        PG8_STAGE(PG8_SB(0, 0), cB, voffB); PG8_STAGE(PG8_SA(0, 0), cA, voffA); PG8_STAGE(PG8_SB(0, 1), cB + hstepB, voffB); PG8_STAGE(PG8_SA(0, 1), cA + hstepA, voffA);
        if (wr == 1) PG8_BAR;
        PG8_WAIT_V(4); PG8_BAR;
        PG8_STAGE(PG8_SB(1, 0), cB + kstep, voffB); PG8_STAGE(PG8_SA(1, 0), cA + kstep, voffA); PG8_STAGE(PG8_SB(1, 1), cB + hstepB + kstep, voffB);
        PG8_WAIT_V(6); PG8_BAR;
    }
    for (;;) {
        const bool has_next = S.next(ui + 1, nxt);
        const char* nA = has_next ? (const char*)g.A + (size_t)nxt.pm * tstepA : cA; const char* nB = has_next ? (const char*)g.Bt + (size_t)nxt.pn * tstepB : cB;
#pragma nounroll
        for (int t = 0; t < nt; t += 2) {
            const bool last = (t == nt - 2);
            const char* a1 = cA + (size_t)(t + 1) * kstep;
            const char* a2 = last ? nA : cA + (size_t)(t + 2) * kstep; const char* b2 = last ? nB : cB + (size_t)(t + 2) * kstep;
            const char* a3 = a2 + kstep; const char* b3 = b2 + kstep;
            if (last && has_next) S.a_ready(nxt);
            if constexpr (SP2) {
            PG8_LDB(B0, 0, 0); PG8_LDB(B1, 0, 1); PG8_SCHED; PG8_LDA(At, 0, 0); PG8_STAGE(PG8_SA(1, 1), a1 + hstepA, voffA);
            PG8_WAIT_V(8); PG8_WAIT_L(0); PG8_BAR; PG8_MMA(0, 0, At, B0); PG8_MMA(0, 1, At, B1); PG8_BAR; PG8_SCHED;
            PG8_LDA(At, 0, 1); PG8_STAGE(PG8_SB(0, 0), b2, voffB); PG8_STAGE(PG8_SB(0, 1), b2 + hstepB, voffB); PG8_STAGE(PG8_SA(0, 0), a2, voffA);
            PG8_WAIT_V(8); PG8_WAIT_L(0); PG8_BAR; PG8_MMA(1, 0, At, B0); PG8_MMA(1, 1, At, B1); PG8_BAR; PG8_SCHED;
            PG8_LDB(B0, 1, 0); PG8_LDB(B1, 1, 1); PG8_SCHED; PG8_LDA(At, 1, 0); PG8_STAGE(PG8_SA(0, 1), a2 + hstepA, voffA);
            PG8_WAIT_V(8); PG8_WAIT_L(0); PG8_BAR; PG8_MMA(0, 0, At, B0); PG8_MMA(0, 1, At, B1); PG8_BAR; PG8_SCHED;
            PG8_LDA(At, 1, 1); PG8_STAGE(PG8_SB(1, 0), b3, voffB); PG8_STAGE(PG8_SB(1, 1), b3 + hstepB, voffB); PG8_STAGE(PG8_SA(1, 0), a3, voffA);
            PG8_WAIT_V(8); PG8_WAIT_L(0); PG8_BAR; PG8_MMA(1, 0, At, B0); PG8_MMA(1, 1, At, B1); PG8_BAR; PG8_SCHED;
            } else {
            PG8_LDB(B0, 0, 0); PG8_SCHED; PG8_LDA(At, 0, 0); PG8_STAGE(PG8_SA(1, 1), a1 + hstepA, voffA);
            PG8_WAIT_L(8); PG8_BAR; PG8_WAIT_L(0); PG8_MMA(0, 0, At, B0); PG8_BAR; PG8_SCHED;
            PG8_LDB(B1, 0, 1); PG8_STAGE(PG8_SB(0, 0), b2, voffB);
            PG8_BAR; PG8_WAIT_L(0); PG8_MMA(0, 1, At, B1); PG8_BAR;
            PG8_LDA(At, 0, 1); PG8_STAGE(PG8_SA(0, 0), a2, voffA);
            PG8_BAR; PG8_WAIT_L(0); PG8_MMA(1, 0, At, B0); PG8_BAR; PG8_SCHED;
            PG8_STAGE(PG8_SB(0, 1), b2 + hstepB, voffB);
            PG8_WAIT_V(6); PG8_BAR; PG8_MMA(1, 1, At, B1); PG8_BAR;
            PG8_LDB(B0, 1, 0); PG8_SCHED; PG8_LDA(At, 1, 0); PG8_STAGE(PG8_SA(0, 1), a2 + hstepA, voffA);
            PG8_WAIT_L(8); PG8_BAR; PG8_WAIT_L(0); PG8_MMA(0, 0, At, B0); PG8_BAR; PG8_SCHED;
            PG8_LDB(B1, 1, 1); PG8_STAGE(PG8_SB(1, 0), b3, voffB);
            PG8_BAR; PG8_WAIT_L(0); PG8_MMA(0, 1, At, B1); PG8_BAR;
            PG8_LDA(At, 1, 1); PG8_STAGE(PG8_SA(1, 0), a3, voffA);
            PG8_BAR; PG8_WAIT_L(0); PG8_MMA(1, 0, At, B0); PG8_BAR; PG8_SCHED;
            PG8_STAGE(PG8_SB(1, 1), b3 + hstepB, voffB);
            PG8_WAIT_V(6); PG8_BAR; PG8_MMA(1, 1, At, B1); PG8_BAR;
            }
        }
        if constexpr (ALIGN_EPI) { if (wr == 0) PG8_BAR; }
        if constexpr (!Epi::AFTER_DRAIN) { E(acc, cur, wr, wc, fr, fq); S.done(cur); }
        if (!has_next) break;
#pragma unroll
        for (int a = 0; a < 2; ++a)
#pragma unroll
            for (int b = 0; b < 2; ++b)
#pragma unroll
                for (int m = 0; m < 4; ++m)
#pragma unroll
                    for (int n = 0; n < 2; ++n) acc[a][b][m][n] = (f32x4){0.f, 0.f, 0.f, 0.f};
        cur = nxt; cA = nA; cB = nB; ++ui;
        if constexpr (ALIGN_EPI) { if (wr == 1) PG8_BAR; }
    }
    PG8_WAIT_V(0);
    if constexpr (!ALIGN_EPI) { if (wr == 0) PG8_BAR; }
    PG8_BAR;
    if constexpr (Epi::AFTER_DRAIN) { E.fused(acc, cur, wr, wc, fr, fq, lds, wid, lane); S.done(cur); }
#undef PG8_SA
#undef PG8_SB
#undef PG8_STAGE
#undef PG8_LDA
#undef PG8_LDB
#undef PG8_MMA
#undef PG8_WAIT_V
#undef PG8_WAIT_L
#undef PG8_BAR
#undef PG8_SCHED
}
}
namespace att {
typedef __hip_bfloat16 hbf16;
typedef short bf16x8 __attribute__((ext_vector_type(8)));
typedef short s16x4 __attribute__((ext_vector_type(4)));
typedef float f32x16 __attribute__((ext_vector_type(16)));
typedef float f32x4 __attribute__((ext_vector_type(4)));
typedef unsigned u32x4 __attribute__((ext_vector_type(4)));
typedef unsigned short bf16_t;
#define ALAS __attribute__((address_space(3)))
typedef ALAS const char* lds_cptr;
constexpr int SEQ = 4096, QB = 256, KVBLK = 64;
constexpr int SLOTK = 12288, SLOTV = 8192, NSLOT = 3;
constexpr int L_K = 0, L_V = NSLOT * SLOTK, L_WS = L_V + NSLOT * SLOTV, L_OST = L_WS + 8 * 256, L_TBL = L_OST + 8 * 4096, TBL_N = 256 + 4096, L_NINF = L_TBL + TBL_N * 4,
              L_KM = L_NINF + 256, L_FLAG = L_KM + 4096, L_END = L_FLAG + 64;
constexpr int UP = 3584;
constexpr float SB_EXIT = -64.0f;
#define ASBAR() __builtin_amdgcn_sched_barrier(0)
#define AWAIT_BAR(N) asm volatile("s_waitcnt vmcnt(" #N ") lgkmcnt(0)\n\ts_barrier" ::: "memory")
__device__ __forceinline__ int crow(int r, int hi) { return (r & 3) + 8 * (r >> 2) + 4 * hi; }
__device__ __forceinline__ void glds16(const void* gsrc, unsigned lds_dst) { unsigned keep;
    asm volatile("s_mov_b32 %0, m0\n\ts_mov_b32 m0, %2\n\ts_nop 0\n\tglobal_load_lds_dwordx4 %1, off\n\ts_mov_b32 m0, %0" : "=&s"(keep) : "v"(gsrc), "s"(lds_dst) : "memory"); }
typedef float f32x2_t __attribute__((ext_vector_type(2))); typedef __bf16 bf16x2_t __attribute__((ext_vector_type(2)));
__device__ __forceinline__ unsigned cvtpk(float lo, float hi) { f32x2_t v = {lo, hi}; bf16x2_t b = __builtin_convertvector(v, bf16x2_t); return __builtin_bit_cast(unsigned, b); }
__device__ __forceinline__ float bflo(unsigned w) { return __uint_as_float(w << 16); }
__device__ __forceinline__ float bfhi(unsigned w) { return __uint_as_float(w & 0xffff0000u); }
__device__ __forceinline__ float max3f(float a, float b, float c) { float r; asm("v_max3_f32 %0, %1, %2, %3" : "=v"(r) : "v"(a), "v"(b), "v"(c)); return r; }
__device__ __forceinline__ float rowmax32(const f32x16& p0, const f32x16& p1) {
    float a = max3f(p0[0], p0[1], p0[2]), b = max3f(p0[3], p0[4], p0[5]), c = max3f(p1[0], p1[1], p1[2]), d = max3f(p1[3], p1[4], p1[5]);
    a = max3f(a, p0[6], p0[7]); b = max3f(b, p0[8], p0[9]); c = max3f(c, p1[6], p1[7]); d = max3f(d, p1[8], p1[9]);
    a = max3f(a, p0[10], p0[11]); b = max3f(b, p0[12], p0[13]); c = max3f(c, p1[10], p1[11]); d = max3f(d, p1[12], p1[13]);
    a = max3f(a, p0[14], p0[15]); c = max3f(c, p1[14], p1[15]);
    a = max3f(a, b, c); return max3f(a, d, d);
}
__device__ __forceinline__ float swap_max(float m) { auto rr = __builtin_amdgcn_permlane32_swap(__float_as_uint(m), __float_as_uint(m), false, false); return fmaxf(__uint_as_float(rr[0]), __uint_as_float(rr[1])); }
__device__ __forceinline__ float swap_add(float m) { auto rr = __builtin_amdgcn_permlane32_swap(__float_as_uint(m), __float_as_uint(m), false, false); return __uint_as_float(rr[0]) + __uint_as_float(rr[1]); }

template <int ND> __device__ __forceinline__ void qkt(f32x16& p0, f32x16& p1, lds_cptr kslot, const bf16x8* qr, const f32x16& cinit, int r32, int hi) {
    const lds_cptr kb = kslot + hi * 1024 + r32 * 16;
    bf16x8 kf[2 * ND];
#pragma unroll
    for (int d0 = 0; d0 < ND; ++d0) { kf[2 * d0] = *(const ALAS bf16x8*)(kb + d0 * 2048); kf[2 * d0 + 1] = *(const ALAS bf16x8*)(kb + d0 * 2048 + 512); }
    ASBAR();
#pragma unroll
    for (int d0 = 0; d0 < ND; ++d0) {
        if (d0 == 0) { p0 = __builtin_amdgcn_mfma_f32_32x32x16_bf16(kf[0], qr[0], cinit, 0, 0, 0); p1 = __builtin_amdgcn_mfma_f32_32x32x16_bf16(kf[1], qr[0], cinit, 0, 0, 0); }
        else { p0 = __builtin_amdgcn_mfma_f32_32x32x16_bf16(kf[2 * d0], qr[d0], p0, 0, 0, 0); p1 = __builtin_amdgcn_mfma_f32_32x32x16_bf16(kf[2 * d0 + 1], qr[d0], p1, 0, 0, 0); }
    }
}
__device__ __forceinline__ void pv(f32x16* o, int vb, bf16x8 pa0, bf16x8 pa1, bf16x8 pa2, bf16x8 pa3) {
#pragma unroll
    for (int d0 = 0; d0 < 2; ++d0) { s16x4 lo[4], hi[4];
#pragma unroll
        for (int ks = 0; ks < 4; ++ks) {
            asm volatile("ds_read_b64_tr_b16 %0,%1 offset:%c2" : "=&v"(lo[ks]) : "v"(vb), "i"(d0 * 4096 + ks * 1024) : "memory");
            asm volatile("ds_read_b64_tr_b16 %0,%1 offset:%c2" : "=&v"(hi[ks]) : "v"(vb), "i"(d0 * 4096 + ks * 1024 + 512) : "memory"); }
        asm volatile("s_waitcnt lgkmcnt(0)" ::: "memory"); ASBAR();
#define APK(k) (bf16x8){lo[k][0], lo[k][1], lo[k][2], lo[k][3], hi[k][0], hi[k][1], hi[k][2], hi[k][3]}
        o[d0] = __builtin_amdgcn_mfma_f32_32x32x16_bf16(pa0, APK(0), o[d0], 0, 0, 0);
        o[d0] = __builtin_amdgcn_mfma_f32_32x32x16_bf16(pa1, APK(1), o[d0], 0, 0, 0);
        o[d0] = __builtin_amdgcn_mfma_f32_32x32x16_bf16(pa2, APK(2), o[d0], 0, 0, 0);
        o[d0] = __builtin_amdgcn_mfma_f32_32x32x16_bf16(pa3, APK(3), o[d0], 0, 0, 0);
#undef APK
    }
}
__device__ __forceinline__ bf16x8 pk8(const f32x16& p, int b) { u32x4 w; w.x = cvtpk(p[b], p[b + 1]); w.y = cvtpk(p[b + 2], p[b + 3]); w.z = cvtpk(p[b + 4], p[b + 5]); w.w = cvtpk(p[b + 6], p[b + 7]); return __builtin_bit_cast(bf16x8, w); }

struct Tensors { const bf16_t* U; const bf16_t* QA; const bf16_t* KVA; const bf16_t* KR; bf16_t* Y; const float* BT; const float* KMEAN; int ypitch, ysub; };

template <int TYPE, int KNOB = 0> __device__ __forceinline__ void attn_unit(const Tensors& T, int b, int h, int qb, ALAS char* shm, unsigned lds0, int half) {
    constexpr int ND = (TYPE == 0) ? 6 : 4;
    int tid_ = threadIdx.x; asm volatile("" : "+v"(tid_));
    const int tid = tid_, lane = tid & 63, r32 = lane & 31, hi = lane >> 5; const int wid = __builtin_amdgcn_readfirstlane(tid >> 6);
    const long rowbase = (long)b * SEQ; const int q0 = qb * QB;
    const int NT = (q0 + QB) / KVBLK;
    const bf16_t *Qp, *Kp, *Vp; int pitchQ, pitchK, pitchV, gcol, ycol;
    if (TYPE == 0) { Qp = T.QA + h * 64; pitchQ = 384; Kp = T.KVA + h * 64; pitchK = 512; Vp = T.KVA + 256 + h * 64; pitchV = 512; }
    else { const int base = (TYPE == 1 ? 512 : 1280) + h * 64; Qp = T.U + base; Kp = T.U + base + 256; Vp = T.U + base + 512; pitchQ = pitchK = pitchV = UP; }
    gcol = 2560 + TYPE * 256 + h * 64; ycol = TYPE * 256 + h * 64;
    ALAS float* wsf = (ALAS float*)(shm + L_WS) + wid * 64;
    const long qrow = rowbase + q0 + wid * 32 + r32;
    bf16x8 qr[ND];
#pragma unroll
    for (int d0 = 0; d0 < 4; ++d0) qr[d0] = *(const bf16x8*)(Qp + qrow * pitchQ + d0 * 16 + hi * 8);
    if (TYPE == 0) {
#pragma unroll
        for (int d0 = 4; d0 < ND; ++d0) qr[d0] = *(const bf16x8*)(T.QA + qrow * 384 + 256 + h * 32 + (d0 - 4) * 16 + hi * 8);
    }
#pragma unroll
    for (int d0 = 0; d0 < ND; ++d0) asm volatile("" : "+v"(qr[d0]));
    const bf16_t* ksrc = Kp + (rowbase + lane) * pitchK + wid * 8;
    const bf16_t* vsrc = Vp + (rowbase + 16 * (wid & 3) + (lane >> 2)) * pitchV + (wid >> 2) * 32 + (lane & 3) * 8;
    const bf16_t* krsrc = T.KR + (rowbase + lane) * 32 + (wid & 3) * 8;
    const unsigned kdst = lds0 + L_K + wid * 1024, vdst = lds0 + L_V + wid * 1024, krdst = lds0 + L_K + (8 + (wid & 3)) * 1024;
#define DMA_TILE(t, s) do { if (KNOB == 1 && dma_skip) break; glds16(ksrc + (long)(t) * KVBLK * pitchK, (unsigned)__builtin_amdgcn_readfirstlane(kdst + (s) * SLOTK)); \
        if (TYPE == 0) glds16(krsrc + (long)(t) * KVBLK * 32, (unsigned)__builtin_amdgcn_readfirstlane(krdst + (s) * SLOTK)); \
        glds16(vsrc + (long)(t) * KVBLK * pitchV, (unsigned)__builtin_amdgcn_readfirstlane(vdst + (s) * SLOTV)); } while (0)
#define TILE_WAIT(more) do { if (KNOB == 5) break; if (more) { if (TYPE == 0) AWAIT_BAR(3); else AWAIT_BAR(2); } else AWAIT_BAR(0); } while (0)
#define EVEN_BAR() do { if (KNOB != 5) asm volatile("s_waitcnt lgkmcnt(0)\n\ts_barrier" ::: "memory"); } while (0)
    bool dma_skip = false; (void)dma_skip;
    const int vb0 = (int)(lds0 + L_V) + ((lane >> 4) & 1) * 32 + (lane & 3) * 8 + (4 * hi + ((lane & 15) >> 2)) * 64;
    const lds_cptr kbase = (lds_cptr)shm + L_K;
    const int qrel = wid * 32 + r32;
    f32x16 o[2]; o[0] = f32x16{}; o[1] = f32x16{};
    f32x16 p0, p1;

    if (TYPE != 1) {
        unsigned selmask = 0u;
        ALAS const float* tbl = (ALAS const float*)(shm + L_TBL);
        ALAS const float* ninf = (ALAS const float*)(shm + L_NINF);
        if (TYPE == 2) {
            const float* bt = T.BT + (size_t)h * TBL_N;
            const int nfill = 256 + q0 + 256;
            for (int i = tid; i < nfill; i += 512) ((ALAS float*)(shm + L_TBL))[i] = bt[i];
            if (tid < 64) ((ALAS float*)(shm + L_NINF))[tid] = -INFINITY;
            for (int i = tid; i < 16 * 64; i += 512) ((ALAS float*)(shm + L_KM))[i] = T.KMEAN[((size_t)b * 16 + (i >> 6)) * 256 + h * 64 + (i & 63)];
            asm volatile("s_waitcnt vmcnt(0) lgkmcnt(0)\n\ts_barrier" ::: "memory");
            float qf[32];
#pragma unroll
            for (int d0 = 0; d0 < 4; ++d0) { const u32x4 w = __builtin_bit_cast(u32x4, qr[d0]);
                qf[d0 * 8 + 0] = bflo(w.x); qf[d0 * 8 + 1] = bfhi(w.x); qf[d0 * 8 + 2] = bflo(w.y); qf[d0 * 8 + 3] = bfhi(w.y);
                qf[d0 * 8 + 4] = bflo(w.z); qf[d0 * 8 + 5] = bfhi(w.z); qf[d0 * 8 + 6] = bflo(w.w); qf[d0 * 8 + 7] = bfhi(w.w); }
            float v1 = -INFINITY, v2 = -INFINITY, v3 = -INFINITY; int i1 = -1, i2 = -1, i3 = -1;
            for (int j = 0; j < qb; ++j) {
                ALAS const float* km = (ALAS const float*)(shm + L_KM) + j * 64 + hi * 8;
                float g = 0.f;
#pragma unroll
                for (int d0 = 0; d0 < 4; ++d0) { const f32x4 a = *(ALAS const f32x4*)(km + d0 * 16), c = *(ALAS const f32x4*)(km + d0 * 16 + 4);
                    g += qf[d0 * 8 + 0] * a[0] + qf[d0 * 8 + 1] * a[1] + qf[d0 * 8 + 2] * a[2] + qf[d0 * 8 + 3] * a[3];
                    g += qf[d0 * 8 + 4] * c[0] + qf[d0 * 8 + 5] * c[1] + qf[d0 * 8 + 6] * c[2] + qf[d0 * 8 + 7] * c[3]; }
                g = swap_add(g);
                if (g > v1) { v3 = v2; i3 = i2; v2 = v1; i2 = i1; v1 = g; i1 = j; }
                else if (g > v2) { v3 = v2; i3 = i2; v2 = g; i2 = j; }
                else if (g > v3) { v3 = g; i3 = j; }
            }
            if (i1 >= 0) selmask |= 1u << i1;
            if (i2 >= 0) selmask |= 1u << i2;
            if (i3 >= 0) selmask |= 1u << i3;
        }
        constexpr float THR = 6.0f;
        float mref = 0.f, l_run = 0.f; bool started = false;
        f32x16 negm = f32x16{};
        DMA_TILE(0, 0); DMA_TILE(1, 1); dma_skip = true;
        if (half) TILE_WAIT(true);
        int sl = 0, sl2 = 2;
        for (int t = 0; t < NT; ++t) {
            if (half == 0) TILE_WAIT(t + 1 < NT); else { EVEN_BAR(); if (t + 2 < NT) DMA_TILE(t + 2, sl2); }
            const int jb = t - (NT - 4);
            const bool wave_active = (jb < 0) || (64 * jb <= wid * 32 + 31);
            bool sel = true;
            if (TYPE == 2 && jb < 0) sel = (selmask >> (t >> 2)) & 1u;
            const bool act = wave_active && (TYPE != 2 || __any(sel));
            if (act) {
                if (KNOB == 3 || KNOB == 7) { p0 = negm; p1 = negm; asm volatile("" : "+v"(p0), "+v"(p1)); } else qkt<ND>(p0, p1, kbase + sl * SLOTK, qr, negm, r32, hi);
                if (TYPE == 2) {
                    ALAS const float* pb = sel ? tbl + (q0 + qrel - 64 * t - 4 * hi + 197) : ninf;
#pragma unroll
                    for (int r = 0; r < 16; ++r) { const int ko = (r & 3) + 8 * (r >> 2); p0[r] += pb[59 - ko]; p1[r] += pb[27 - ko]; }
                }
                if (jb >= 0) {
#pragma unroll
                    for (int r = 0; r < 16; ++r) { const int kv = 64 * jb + 4 * hi + (r & 3) + 8 * (r >> 2); if (kv > qrel) p0[r] = -INFINITY; if (kv + 32 > qrel) p1[r] = -INFINITY; }
                }
                float mx = rowmax32(p0, p1);
                mx = swap_max(mx);
                float dl = 0.f;
                if (!started) { if (mx > -INFINITY) dl = mx; } else if (mx > THR) dl = mx;
                if (__any(dl != 0.f)) {
                    const float f = started ? __builtin_amdgcn_exp2f(-dl) : 1.0f;
                    mref += dl; l_run *= f;
#pragma unroll
                    for (int r = 0; r < 16; ++r) { p0[r] -= dl; p1[r] -= dl; negm[r] = -mref; }
                    if (hi == 0) wsf[r32] = f;
                    asm volatile("s_waitcnt lgkmcnt(0)" ::: "memory");
#pragma unroll
                    for (int r = 0; r < 16; ++r) { const float g = wsf[crow(r, hi)]; o[0][r] *= g; o[1][r] *= g; }
                    asm volatile("s_waitcnt lgkmcnt(0)" ::: "memory");
                }
                if (mx > -INFINITY) started = true;
#pragma unroll
                for (int r = 0; r < 16; ++r) { if (KNOB != 2) p0[r] = __builtin_amdgcn_exp2f(p0[r]); }
            }
            if (half == 0) { EVEN_BAR(); if (t + 2 < NT) DMA_TILE(t + 2, sl2); } else TILE_WAIT(t + 2 < NT);
            if (act) {
#pragma unroll
                for (int r = 0; r < 16; ++r) { if (KNOB != 2) p1[r] = __builtin_amdgcn_exp2f(p1[r]); }
                { const f32x16 sv = p0 + p1;
                  const float s0 = (sv[0] + sv[1]) + (sv[2] + sv[3]), s1 = (sv[4] + sv[5]) + (sv[6] + sv[7]), s2 = (sv[8] + sv[9]) + (sv[10] + sv[11]), s3 = (sv[12] + sv[13]) + (sv[14] + sv[15]);
                  l_run += (s0 + s1) + (s2 + s3); }
                if (KNOB == 4 || KNOB == 7) { bf16x8 a_ = pk8(p0, 0), b_ = pk8(p0, 8), c_ = pk8(p1, 0), d_ = pk8(p1, 8); asm volatile("" :: "v"(a_), "v"(b_), "v"(c_), "v"(d_)); } else
                pv(o, vb0 + sl * SLOTV, pk8(p0, 0), pk8(p0, 8), pk8(p1, 0), pk8(p1, 8));
            }
            sl = (sl == 2) ? 0 : sl + 1; sl2 = (sl2 == 2) ? 0 : sl2 + 1;
        }
        if (half == 0) EVEN_BAR();
        l_run = swap_add(l_run);
        if (hi == 0) wsf[32 + r32] = l_run;
        asm volatile("s_waitcnt lgkmcnt(0)" ::: "memory");
#pragma unroll
        for (int r = 0; r < 16; ++r) { const float f = __builtin_amdgcn_rcpf(wsf[32 + crow(r, hi)]); o[0][r] *= f; o[1][r] *= f; }
    } else {
        bf16x8 Ta, Tb, Tones;
        { short ta[8], tb[8];
#pragma unroll
          for (int j = 0; j < 8; ++j) { const int kk = 8 * (j >> 2) + 4 * hi + (j & 3); ta[j] = (kk > r32) ? (short)0x3F80 : (short)0; tb[j] = (16 + kk > r32) ? (short)0x3F80 : (short)0; }
          Ta = (bf16x8){ta[0], ta[1], ta[2], ta[3], ta[4], ta[5], ta[6], ta[7]}; Tb = (bf16x8){tb[0], tb[1], tb[2], tb[3], tb[4], tb[5], tb[6], tb[7]};
          Tones = (bf16x8){(short)0x3F80, (short)0x3F80, (short)0x3F80, (short)0x3F80, (short)0x3F80, (short)0x3F80, (short)0x3F80, (short)0x3F80}; }
        float c = 0.f;
        ALAS unsigned* flags = (ALAS unsigned*)(shm + L_FLAG);
        DMA_TILE(NT - 1, 0); DMA_TILE(NT - 2, 1);
        if (half) TILE_WAIT(true);
        int sl = 0, sl2 = 2; bool ran_out = true;
        const f32x16 zero16 = f32x16{};
        for (int i = 0; i < NT; ++i) {
            const int t = NT - 1 - i;
            if (half == 0) {
                TILE_WAIT(i + 1 < NT);
                if (i > 0) { const ALAS unsigned* fl = flags + ((i - 1) & 1) * 8; const unsigned all = fl[0] & fl[1] & fl[2] & fl[3] & fl[4] & fl[5] & fl[6] & fl[7];
                             if (__builtin_amdgcn_readfirstlane(all) != 0u) { ran_out = false; break; } }
            } else { EVEN_BAR(); if (i + 2 < NT) DMA_TILE(t - 2, sl2); }
            const int jb = t - (NT - 4);
            const bool wave_active = (jb < 0) || (64 * jb < wid * 32 + 31);
            f32x16 D0, D1;
            if (wave_active) {
                qkt<ND>(p0, p1, kbase + sl * SLOTK, qr, zero16, r32, hi);
                f32x16 L0, L1;
#pragma unroll
                for (int r = 0; r < 16; ++r) {
                    { const float z = p0[r]; const float e = __builtin_amdgcn_exp2f(-fabsf(z)); const float sp = fmaxf(z, 0.f) + __builtin_amdgcn_logf(1.0f + e); p0[r] = z - sp; L0[r] = -sp; }
                    { const float z = p1[r]; const float e = __builtin_amdgcn_exp2f(-fabsf(z)); const float sp = fmaxf(z, 0.f) + __builtin_amdgcn_logf(1.0f + e); p1[r] = z - sp; L1[r] = -sp; }
                }
                if (jb >= 0) {
#pragma unroll
                    for (int r = 0; r < 16; ++r) { const int kv = 64 * jb + 4 * hi + (r & 3) + 8 * (r >> 2);
                        if (kv >= qrel) { p0[r] = -INFINITY; L0[r] = 0.f; } if (kv + 32 >= qrel) { p1[r] = -INFINITY; L1[r] = 0.f; } }
                }
                const bf16x8 B0 = pk8(L0, 0), B1 = pk8(L0, 8), B2 = pk8(L1, 0), B3 = pk8(L1, 8);
                f32x16 X = __builtin_amdgcn_mfma_f32_32x32x16_bf16(Tones, B2, zero16, 0, 0, 0);
                X = __builtin_amdgcn_mfma_f32_32x32x16_bf16(Tones, B3, X, 0, 0, 0);
                D0 = __builtin_amdgcn_mfma_f32_32x32x16_bf16(Ta, B0, X, 0, 0, 0);
                D0 = __builtin_amdgcn_mfma_f32_32x32x16_bf16(Tb, B1, D0, 0, 0, 0);
                D1 = __builtin_amdgcn_mfma_f32_32x32x16_bf16(Ta, B2, zero16, 0, 0, 0);
                D1 = __builtin_amdgcn_mfma_f32_32x32x16_bf16(Tb, B3, D1, 0, 0, 0);
                f32x16 TT = __builtin_amdgcn_mfma_f32_32x32x16_bf16(Tones, B0, X, 0, 0, 0);
                TT = __builtin_amdgcn_mfma_f32_32x32x16_bf16(Tones, B1, TT, 0, 0, 0);
#pragma unroll
                for (int r = 0; r < 16; ++r) { p0[r] += D0[r] + c; p1[r] += D1[r] + c; }
                c += TT[0];
            }
            { const bool done = __all(c < SB_EXIT); if (lane == 0) flags[(i & 1) * 8 + wid] = done ? 1u : 0u; }
            bool stop_after = false;
            if (half == 0) { EVEN_BAR(); if (i + 2 < NT) DMA_TILE(t - 2, sl2); }
            else { TILE_WAIT(i + 2 < NT);
                   const ALAS unsigned* fl = flags + (i & 1) * 8; const unsigned all = fl[0] & fl[1] & fl[2] & fl[3] & fl[4] & fl[5] & fl[6] & fl[7];
                   stop_after = __builtin_amdgcn_readfirstlane(all) != 0u; }
            if (wave_active) {
#pragma unroll
                for (int r = 0; r < 16; ++r) { p0[r] = __builtin_amdgcn_exp2f(p0[r]); p1[r] = __builtin_amdgcn_exp2f(p1[r]); }
                pv(o, vb0 + sl * SLOTV, pk8(p0, 0), pk8(p0, 8), pk8(p1, 0), pk8(p1, 8));
            }
            if (stop_after) { ran_out = false; break; }
            sl = (sl == 2) ? 0 : sl + 1; sl2 = (sl2 == 2) ? 0 : sl2 + 1;
        }
        if (half == 0 && ran_out) EVEN_BAR();
    }
    {
        ALAS bf16_t* stg = (ALAS bf16_t*)(shm + L_OST) + wid * 2048;
#pragma unroll
        for (int r = 0; r < 16; ++r) { const int orow = crow(r, hi);
#pragma unroll
            for (int d0 = 0; d0 < 2; ++d0) stg[orow * 64 + d0 * 32 + r32] = (bf16_t)(cvtpk(o[d0][r], 0.f) & 0xffffu); }
        asm volatile("s_waitcnt lgkmcnt(0)" ::: "memory");
#pragma unroll
        for (int i = 0; i < 4; ++i) { const int row = i * 8 + (lane >> 3), ch = lane & 7;
            const u32x4 v = *(ALAS const u32x4*)(stg + row * 64 + ch * 8);
            const long grow = rowbase + q0 + wid * 32 + row;
            const u32x4 g = *(const u32x4*)(T.U + grow * UP + gcol + ch * 8);
            float x[8] = {bflo(v.x), bfhi(v.x), bflo(v.y), bfhi(v.y), bflo(v.z), bfhi(v.z), bflo(v.w), bfhi(v.w)};
            const float gg[8] = {bflo(g.x), bfhi(g.x), bflo(g.y), bfhi(g.y), bflo(g.z), bfhi(g.z), bflo(g.w), bfhi(g.w)};
#pragma unroll
            for (int j = 0; j < 8; ++j) x[j] *= gg[j] / (1.0f + __expf(-gg[j]));
            u32x4 w; w.x = cvtpk(x[0], x[1]); w.y = cvtpk(x[2], x[3]); w.z = cvtpk(x[4], x[5]); w.w = cvtpk(x[6], x[7]);
            if (KNOB == 0) *(u32x4*)(T.Y + grow * T.ypitch + (ycol - T.ysub) + ch * 8) = w; else if (w.x == 0x12345678u && w.y == 0x9abcdef0u) *(u32x4*)(T.Y + grow * 1024 + ycol + ch * 8) = w; }
    }
    asm volatile("s_waitcnt vmcnt(0) lgkmcnt(0)\n\ts_barrier" ::: "memory");
#undef DMA_TILE
#undef TILE_WAIT
#undef EVEN_BAR
}
#undef ASBAR
#undef AWAIT_BAR
}
namespace att {
#define SBAR() __builtin_amdgcn_sched_barrier(0)
#ifdef CONSERVATIVE_BAR
#define WAIT_BAR(N) asm volatile("s_waitcnt vmcnt(0) lgkmcnt(0)\n\ts_barrier\n\ts_barrier" ::: "memory")
#else
#define WAIT_BAR(N) asm volatile("s_waitcnt vmcnt(" #N ") lgkmcnt(0)\n\ts_barrier" ::: "memory")
#endif
typedef short v4i16_t __attribute__((ext_vector_type(4)));
__device__ __forceinline__ void kload8(bf16x8* kf, lds_cptr kp) {
    kf[0] = *(const ALAS bf16x8*)(kp);        kf[1] = *(const ALAS bf16x8*)(kp + 512);
    kf[2] = *(const ALAS bf16x8*)(kp + 2048); kf[3] = *(const ALAS bf16x8*)(kp + 2560);
    kf[4] = *(const ALAS bf16x8*)(kp + 4096); kf[5] = *(const ALAS bf16x8*)(kp + 4608);
    kf[6] = *(const ALAS bf16x8*)(kp + 6144); kf[7] = *(const ALAS bf16x8*)(kp + 6656);
}
__device__ __forceinline__ void kload2(bf16x8* kf, lds_cptr kp, int j) { kf[2 * j] = *(const ALAS bf16x8*)(kp + j * 2048); kf[2 * j + 1] = *(const ALAS bf16x8*)(kp + j * 2048 + 512); }
__device__ __forceinline__ s16x4 vtr(lds_cptr p) { return __builtin_bit_cast(s16x4, __builtin_amdgcn_ds_read_tr16_b64_v4i16((ALAS v4i16_t*)p)); }
__device__ __forceinline__ void cmask(f32x16& p0, f32x16& p1, int jb, int qrel, int hi) {
    const float NEG = -INFINITY; const int kb = 64 * jb + 4 * hi;
#pragma unroll
    for (int r = 0; r < 16; ++r) { const int kv = kb + (r & 3) + 8 * (r >> 2); if (kv > qrel) p0[r] = NEG; if (kv + 32 > qrel) p1[r] = NEG; }
}

__device__ __forceinline__ float rowmax_cv(const f32x16& p0, const f32x16& p1) {
    float a = __builtin_fmaxf(__builtin_fmaxf(p0[0], p0[1]), p1[0]), b = __builtin_fmaxf(__builtin_fmaxf(p0[2], p0[3]), p1[1]); a = __builtin_fmaxf(__builtin_fmaxf(a, p1[2]), p1[3]);
#pragma unroll
    for (int r = 4; r < 16; r += 4) { a = __builtin_fmaxf(__builtin_fmaxf(a, p0[r]), p0[r + 1]); b = __builtin_fmaxf(__builtin_fmaxf(b, p0[r + 2]), p0[r + 3]); a = __builtin_fmaxf(__builtin_fmaxf(a, p1[r]), p1[r + 1]); b = __builtin_fmaxf(__builtin_fmaxf(b, p1[r + 2]), p1[r + 3]); }
    return __builtin_fmaxf(a, b);
}
#ifndef TUNED_THR
#define TUNED_THR 6.0f
#endif
__device__ __forceinline__ void moba_unit_tuned(const Tensors& T, int b, int h, int qb, ALAS char* shm, unsigned lds0) {
    int tid_ = threadIdx.x; asm volatile("" : "+v"(tid_));
    const int tid = tid_, lane = tid & 63, r32 = lane & 31, hi = lane >> 5; const int wid = __builtin_amdgcn_readfirstlane(tid >> 6);
    const long rowbase = (long)b * SEQ; const int q0 = qb * QB;
    const int NT = (q0 + QB) / KVBLK;
    const bf16_t* Qp = T.U + 1280 + h * 64; const bf16_t* Kp = T.U + 1536 + h * 64; const bf16_t* Vp = T.U + 1792 + h * 64;
    const int gcol = 2560 + 512 + h * 64, ycol = 512 + h * 64;
    ALAS float* wsf = (ALAS float*)(shm + L_WS) + wid * 64;
    const long qrow = rowbase + q0 + wid * 32 + r32;
    const bf16_t* ksrc = Kp + (rowbase + lane) * UP + wid * 8;
    const bf16_t* vsrc = Vp + (rowbase + 16 * (wid & 3) + (lane >> 2)) * UP + (wid >> 2) * 32 + (lane & 3) * 8;
    const unsigned kdst = lds0 + L_K + wid * 1024, vdst = lds0 + L_V + wid * 1024;
#define DMA_K(t, si) glds16(ksrc + (long)(t) * KVBLK * UP, (unsigned)__builtin_amdgcn_readfirstlane(kdst + (si) * SLOTK))
#define DMA_V(t, si) glds16(vsrc + (long)(t) * KVBLK * UP, (unsigned)__builtin_amdgcn_readfirstlane(vdst + (si) * SLOTV))
    const int vb0 = (int)(lds0 + L_V) + ((lane >> 4) & 1) * 32 + (lane & 3) * 8 + (4 * hi + ((lane & 15) >> 2)) * 64;
    const lds_cptr shm3 = (lds_cptr)shm; const lds_cptr kp0 = shm3 + L_K + hi * 1024 + r32 * 16;
    const lds_cptr vp0 = shm3 + L_V + ((lane >> 4) & 1) * 32 + (lane & 3) * 8 + (4 * hi + ((lane & 15) >> 2)) * 64;
    const int qrel = wid * 32 + r32;
    ALAS const float* tbl = (ALAS const float*)(shm + L_TBL);
    ALAS const float* ninf = (ALAS const float*)(shm + L_NINF);
    bf16x8 qr[4];
#pragma unroll
    for (int d0 = 0; d0 < 4; ++d0) qr[d0] = *(const bf16x8*)(Qp + qrow * UP + d0 * 16 + hi * 8);
    unsigned selmask = 0u;
    {
        const float* bt = T.BT + (size_t)h * TBL_N;
        const int nfill = (256 + q0 + 256) < 1408 ? (256 + q0 + 256) : 1408;
        for (int i = tid; i < nfill; i += 512) ((ALAS float*)(shm + L_TBL))[i] = bt[i];
        if (tid < 64) ((ALAS float*)(shm + L_NINF))[tid] = -INFINITY;
        if (tid == 64) ((ALAS float*)(shm + L_TBL))[256 + 1024] = bt[256 + 1024];
        for (int i = tid; i < 16 * 64; i += 512) ((ALAS float*)(shm + L_KM))[i] = T.KMEAN[((size_t)b * 16 + (i >> 6)) * 256 + h * 64 + (i & 63)];
        asm volatile("s_waitcnt vmcnt(0) lgkmcnt(0)\n\ts_barrier" ::: "memory");
        float qf[32];
#pragma unroll
        for (int d0 = 0; d0 < 4; ++d0) { const u32x4 w = __builtin_bit_cast(u32x4, qr[d0]);
            qf[d0 * 8 + 0] = bflo(w.x); qf[d0 * 8 + 1] = bfhi(w.x); qf[d0 * 8 + 2] = bflo(w.y); qf[d0 * 8 + 3] = bfhi(w.y);
            qf[d0 * 8 + 4] = bflo(w.z); qf[d0 * 8 + 5] = bfhi(w.z); qf[d0 * 8 + 6] = bflo(w.w); qf[d0 * 8 + 7] = bfhi(w.w); }
        float v1 = -INFINITY, v2 = -INFINITY, v3 = -INFINITY; int i1 = -1, i2 = -1, i3 = -1;
        for (int j = 0; j < qb; ++j) {
            ALAS const float* km = (ALAS const float*)(shm + L_KM) + j * 64 + hi * 8;
            float g = 0.f;
#pragma unroll
            for (int d0 = 0; d0 < 4; ++d0) { const f32x4 a = *(ALAS const f32x4*)(km + d0 * 16), c = *(ALAS const f32x4*)(km + d0 * 16 + 4);
                g += qf[d0 * 8 + 0] * a[0] + qf[d0 * 8 + 1] * a[1] + qf[d0 * 8 + 2] * a[2] + qf[d0 * 8 + 3] * a[3];
                g += qf[d0 * 8 + 4] * c[0] + qf[d0 * 8 + 5] * c[1] + qf[d0 * 8 + 6] * c[2] + qf[d0 * 8 + 7] * c[3]; }
            g = swap_add(g);
            if (g > v1) { v3 = v2; i3 = i2; v2 = v1; i2 = i1; v1 = g; i1 = j; }
            else if (g > v2) { v3 = v2; i3 = i2; v2 = g; i2 = j; }
            else if (g > v3) { v3 = g; i3 = j; }
        }
        if (i1 >= 0) selmask |= 1u << i1;
        if (i2 >= 0) selmask |= 1u << i2;
        if (i3 >= 0) selmask |= 1u << i3;
        selmask |= 1u << qb;
    }
#pragma unroll
    for (int d0 = 0; d0 < 4; ++d0) asm volatile("" : "+v"(qr[d0]));
    float c31 = tbl[256 + 1024]; asm volatile("s_waitcnt lgkmcnt(0)" : "+v"(c31) :: "memory");
    const int tfar = (q0 + 32 * wid - 853) >= 0 ? (q0 + 32 * wid - 853) / 64 : -1;
    DMA_K(0, 0); DMA_V(0, 0); DMA_K(1, 1);
    bf16x8 kf[8];
    float mhat = 0.f, l_reg = 0.f; f32x16 o[2]; o[0] = f32x16{}; o[1] = f32x16{}; f32x16 negm = f32x16{}; asm volatile("" : "+v"(negm));
    bool resc = false; bool started = false;
#if defined(NO_BIAS_PROBE)
#define BIAS(P0, P1, t) do { const bool sel_ = (selmask >> ((t) >> 2)) & 1u; const float add_ = sel_ ? 0.f : -INFINITY; _Pragma("unroll") for (int r = 0; r < 16; ++r) { P0[r] += add_; P1[r] += add_; } } while (0)
#else
#define BIAS8(P, base, r0) do { typedef float f32x8_ __attribute__((ext_vector_type(8))); f32x8_ bv_; \
        _Pragma("unroll") for (int r = 0; r < 8; ++r) { const int ko = ((r0 + r) & 3) + 8 * ((r0 + r) >> 2); bv_[r] = pb_[(base) - ko]; } \
        asm volatile("s_waitcnt lgkmcnt(0)" : "+v"(bv_) :: "memory"); \
        _Pragma("unroll") for (int r = 0; r < 8; ++r) P[r0 + r] += bv_[r]; } while (0)
#define BIAS(P0, P1, t) do { const bool sel_ = (selmask >> ((t) >> 2)) & 1u; \
        if ((t) <= tfar) { const float add_ = sel_ ? c31 : -INFINITY;          \
            _Pragma("unroll") for (int r = 0; r < 16; ++r) { P0[r] += add_; P1[r] += add_; } } \
        else { ALAS const float* pb_ = sel_ ? tbl + (q0 + qrel - 64 * (t) - 4 * hi + 197) : ninf; \
            BIAS8(P0, 59, 0); BIAS8(P0, 59, 8); BIAS8(P1, 27, 0); BIAS8(P1, 27, 8); } } while (0)
#endif
#define CMASK(P0, P1, t) do { int jb_ = (t) - (NT - 4); if (jb_ >= 0) cmask(P0, P1, jb_, qrel, hi); } while (0)
#define DECIDE(C0, C1, rm) do { resc = false; float dl = 0.f; \
        if (!started) { if (rm > -INFINITY) dl = rm; } else if (rm > TUNED_THR) dl = rm; \
        if (__builtin_expect(__any(dl != 0.f), 0)) { const float f = started ? __builtin_amdgcn_exp2f(-dl) : 1.0f; mhat += dl; \
            _Pragma("unroll") for (int r = 0; r < 16; ++r) { C0[r] -= dl; C1[r] -= dl; } \
            _Pragma("unroll") for (int r = 0; r < 16; ++r) negm[r] = -mhat; asm volatile("" : "+v"(negm)); \
            l_reg *= f; if (hi == 0) wsf[r32] = f; resc = true; } \
        if (rm > -INFINITY) started = true; } while (0)
#define RESC() do { if (resc) { asm volatile("s_waitcnt lgkmcnt(0)" ::: "memory"); \
        _Pragma("unroll") for (int d_ = 0; d_ < 2; ++d_) _Pragma("unroll") for (int r = 0; r < 16; ++r) o[d_][r] *= wsf[crow(r, hi)]; } } while (0)
    f32x16 pA0, pA1, pB0, pB1;
    int ip = 0, ic = 0, in_ = 1;
#define ROT() do { ip = ic; ic = in_; in_ = (in_ == NSLOT - 1) ? 0 : in_ + 1; } while (0)
    DMA_K(2, 2);
    WAIT_BAR(3);
    qkt<4>(pA0, pA1, shm3 + L_K, qr, negm, r32, hi);
    BIAS(pA0, pA1, 0); CMASK(pA0, pA1, 0);
    { float rm = rowmax_cv(pA0, pA1); rm = swap_max(rm); DECIDE(pA0, pA1, rm); }
#pragma unroll
    for (int r = 0; r < 16; ++r) { pA0[r] = __builtin_amdgcn_exp2f(pA0[r]); pA1[r] = __builtin_amdgcn_exp2f(pA1[r]); }
    WAIT_BAR(0);
    RESC();
    DMA_K(3, 0); DMA_V(1, 1);
    ROT();
    kload8(kf, kp0 + ic * SLOTK);
    WAIT_BAR(2);
    s16x4 vlo[8], vhi[8]; u32x4 pw0, pw1, pw2, pw3;
#define PKW(P, B) cvtpk(P[B], P[B + 1])
#define PAF(k) __builtin_bit_cast(bf16x8, pw##k)
#define VFR(i) (bf16x8){vlo[i][0], vlo[i][1], vlo[i][2], vlo[i][3], vhi[i][0], vhi[i][1], vhi[i][2], vhi[i][3]}
#define PIN(x) asm volatile("" : "+v"(x))
#define GAPA(MF, A0, A1, A2, A3, W0, W1, PW) do { MF; sacc += A0; sacc += A1; sacc += A2; sacc += A3; PIN(sacc); W0; W1; PIN(PW); SBAR(); } while (0)
#define EX(v) __builtin_amdgcn_exp2f(v)
#define GAPB(MF, X, B) do { MF; X[B] = EX(X[B]); X[B + 1] = EX(X[B + 1]); X[B + 2] = EX(X[B + 2]); X[B + 3] = EX(X[B + 3]); PIN(X); SBAR(); } while (0)
#define VRD(i) do { vlo[i] = vtr(vp_ + (((i) >> 2) * 4096 + ((i) & 3) * 1024)); vhi[i] = vtr(vp_ + (((i) >> 2) * 4096 + ((i) & 3) * 1024 + 512)); } while (0)
#define KRD(G, j) do { if (G) { kload2(kf, kp0 + in_ * SLOTK, j); SBAR(); } } while (0)
#define MFQ(c, a, b_) __builtin_amdgcn_mfma_f32_32x32x16_bf16(a, b_, c, 0, 0, 0)
#define STEP(C0, C1, P0, P1, t, GK, GV, GL) do { SBAR(); \
    const lds_cptr vp_ = vp0 + ip * SLOTV; \
    VRD(0); SBAR(); float sacc = (P0[0] + P0[1]); \
    GAPA(C0 = MFQ(negm, kf[0], qr[0]), P0[2], P0[3], P0[4], P0[5],     pw0[0] = PKW(P0, 0), pw0[1] = PKW(P0, 2), pw0); \
    VRD(4); SBAR(); GAPA(C1 = MFQ(negm, kf[1], qr[0]), P0[6], P0[7], P0[8], P0[9],     pw0[2] = PKW(P0, 4), pw0[3] = PKW(P0, 6), pw0); \
    VRD(1); SBAR(); GAPA(C0 = MFQ(C0, kf[2], qr[1]),   P0[10], P0[11], P0[12], P0[13], pw1[0] = PKW(P0, 8), pw1[1] = PKW(P0, 10), pw1); \
    VRD(5); SBAR(); GAPA(C1 = MFQ(C1, kf[3], qr[1]),   P0[14], P0[15], P1[0], P1[1],   pw1[2] = PKW(P0, 12), pw1[3] = PKW(P0, 14), pw1); \
    VRD(2); SBAR(); GAPA(C0 = MFQ(C0, kf[4], qr[2]),   P1[2], P1[3], P1[4], P1[5],     pw2[0] = PKW(P1, 0), pw2[1] = PKW(P1, 2), pw2); \
    VRD(6); SBAR(); GAPA(C1 = MFQ(C1, kf[5], qr[2]),   P1[6], P1[7], P1[8], P1[9],     pw2[2] = PKW(P1, 4), pw2[3] = PKW(P1, 6), pw2); \
    VRD(3); SBAR(); GAPA(C0 = MFQ(C0, kf[6], qr[3]),   P1[10], P1[11], P1[12], P1[13], pw3[0] = PKW(P1, 8), pw3[1] = PKW(P1, 10), pw3); \
    VRD(7); SBAR(); GAPA(C1 = MFQ(C1, kf[7], qr[3]),   P1[14], P1[15], 0.f, 0.f,       pw3[2] = PKW(P1, 12), pw3[3] = PKW(P1, 14), pw3); \
    l_reg += sacc; \
    if (GK) { DMA_K((t) + 3, ic); } if (GV) { DMA_V((t) + 1, in_); } \
    BIAS(C0, C1, t); CMASK(C0, C1, t); \
    { float rm = rowmax_cv(C0, C1); rm = swap_max(rm); DECIDE(C0, C1, rm); } \
    SBAR(); \
    GAPB(o[0] = MFQ(o[0], PAF(0), VFR(0)), C0, 0); \
    GAPB(o[1] = MFQ(o[1], PAF(0), VFR(4)), C0, 4); \
    KRD(GL, 0); GAPB(o[0] = MFQ(o[0], PAF(1), VFR(1)), C0, 8); \
    KRD(GL, 1); GAPB(o[1] = MFQ(o[1], PAF(1), VFR(5)), C0, 12); \
    KRD(GL, 2); GAPB(o[0] = MFQ(o[0], PAF(2), VFR(2)), C1, 0); \
    KRD(GL, 3); GAPB(o[1] = MFQ(o[1], PAF(2), VFR(6)), C1, 4); \
    GAPB(o[0] = MFQ(o[0], PAF(3), VFR(3)), C1, 8); \
    GAPB(o[1] = MFQ(o[1], PAF(3), VFR(7)), C1, 12); \
    } while (0)
    int t = 1;
#undef CMASK
#define CMASK(P0, P1, t) do {} while (0)
    for (; t + 5 < NT; t += 2) {
        STEP(pB0, pB1, pA0, pA1, t, true, true, true);     WAIT_BAR(2); RESC(); ROT();
        STEP(pA0, pA1, pB0, pB1, t + 1, true, true, true); WAIT_BAR(2); RESC(); ROT();
    }
#undef CMASK
#define CMASK(P0, P1, t) do { int jb_ = (t) - (NT - 4); if (jb_ >= 0) cmask(P0, P1, jb_, qrel, hi); } while (0)
#define ENDW(tt) do { if ((tt) + 3 < NT) { WAIT_BAR(2); } else if ((tt) + 2 < NT) { WAIT_BAR(1); } else { WAIT_BAR(0); } } while (0)
    for (; t + 1 < NT; t += 2) {
        STEP(pB0, pB1, pA0, pA1, t, (t + 3 < NT), (t + 1 < NT), (t + 1 < NT));         ENDW(t);     RESC(); ROT();
        STEP(pA0, pA1, pB0, pB1, t + 1, (t + 4 < NT), (t + 2 < NT), (t + 2 < NT));     ENDW(t + 1); RESC(); ROT();
    }
    u32x4 gq[4];
#pragma unroll
    for (int i = 0; i < 4; ++i) gq[i] = *(const u32x4*)(T.U + (rowbase + q0 + wid * 32 + i * 8 + (lane >> 3)) * UP + gcol + (lane & 7) * 8);
    STEP(pB0, pB1, pA0, pA1, NT - 1, false, false, false); RESC();
    { float sacc = pB0[0] + pB0[1];
#pragma unroll
      for (int r = 2; r < 16; ++r) sacc += pB0[r];
#pragma unroll
      for (int r = 0; r < 16; ++r) sacc += pB1[r];
      l_reg += sacc;
      SBAR(); pv(o, vb0 + ic * SLOTV, pk8(pB0, 0), pk8(pB0, 8), pk8(pB1, 0), pk8(pB1, 8)); }
    l_reg = swap_add(l_reg);
    if (hi == 0) wsf[32 + r32] = l_reg;
    asm volatile("s_waitcnt lgkmcnt(0)" ::: "memory");
#pragma unroll
    for (int r = 0; r < 16; ++r) { const float f = __builtin_amdgcn_rcpf(wsf[32 + crow(r, hi)]); o[0][r] *= f; o[1][r] *= f; }
    {
        ALAS bf16_t* stg = (ALAS bf16_t*)(shm + L_OST) + wid * 2048;
#pragma unroll
        for (int r = 0; r < 16; ++r) { const int orow = crow(r, hi);
#pragma unroll
            for (int d0 = 0; d0 < 2; ++d0) stg[orow * 64 + d0 * 32 + r32] = (bf16_t)(cvtpk(o[d0][r], 0.f) & 0xffffu); }
        asm volatile("s_waitcnt lgkmcnt(0)" ::: "memory");
#pragma unroll
        for (int i = 0; i < 4; ++i) asm volatile("" : "+v"(gq[i]));
#pragma unroll
        for (int i = 0; i < 4; ++i) { const int row = i * 8 + (lane >> 3), ch = lane & 7;
            const u32x4 v = *(ALAS const u32x4*)(stg + row * 64 + ch * 8);
            const long grow = rowbase + q0 + wid * 32 + row;
            const u32x4 g = gq[i];
            float x[8] = {bflo(v.x), bfhi(v.x), bflo(v.y), bfhi(v.y), bflo(v.z), bfhi(v.z), bflo(v.w), bfhi(v.w)};
            const float gg[8] = {bflo(g.x), bfhi(g.x), bflo(g.y), bfhi(g.y), bflo(g.z), bfhi(g.z), bflo(g.w), bfhi(g.w)};
#pragma unroll
            for (int j = 0; j < 8; ++j) x[j] *= gg[j] / (1.0f + __expf(-gg[j]));
            u32x4 w; w.x = cvtpk(x[0], x[1]); w.y = cvtpk(x[2], x[3]); w.z = cvtpk(x[4], x[5]); w.w = cvtpk(x[6], x[7]);
            *(u32x4*)(T.Y + grow * T.ypitch + (ycol - T.ysub) + ch * 8) = w; }
    }
    asm volatile("s_waitcnt vmcnt(0) lgkmcnt(0)\n\ts_barrier" ::: "memory");
#undef DMA_K
#undef DMA_V
#undef BIAS
#undef BIAS8
#undef CMASK
#undef DECIDE
#undef RESC
#undef ROT
#undef PKW
#undef PAF
#undef VFR
#undef PIN
#undef GAPA
#undef EX
#undef GAPB
#undef VRD
#undef KRD
#undef MFQ
#undef STEP
#undef ENDW
}

__device__ __forceinline__ void kload12(bf16x8* kf, lds_cptr kp) {
#pragma unroll
    for (int j = 0; j < 6; ++j) { kf[2 * j] = *(const ALAS bf16x8*)(kp + j * 2048); kf[2 * j + 1] = *(const ALAS bf16x8*)(kp + j * 2048 + 512); }
}
__device__ __forceinline__ void mla_unit_tuned(const Tensors& T, int b, int h, int qb, ALAS char* shm, unsigned lds0) {
    int tid_ = threadIdx.x; asm volatile("" : "+v"(tid_));
    const int tid = tid_, lane = tid & 63, r32 = lane & 31, hi = lane >> 5; const int wid = __builtin_amdgcn_readfirstlane(tid >> 6);
    const long rowbase = (long)b * SEQ; const int q0 = qb * QB;
    const int NT = (q0 + QB) / KVBLK;
    const bf16_t* Kp = T.KVA + h * 64; const bf16_t* Vp = T.KVA + 256 + h * 64;
    const int gcol = 2560 + h * 64, ycol = h * 64;
    ALAS float* wsf = (ALAS float*)(shm + L_WS) + wid * 64;
    const long qrow = rowbase + q0 + wid * 32 + r32;
    bf16x8 qr[6];
#pragma unroll
    for (int d0 = 0; d0 < 4; ++d0) qr[d0] = *(const bf16x8*)(T.QA + qrow * 384 + h * 64 + d0 * 16 + hi * 8);
#pragma unroll
    for (int d0 = 4; d0 < 6; ++d0) qr[d0] = *(const bf16x8*)(T.QA + qrow * 384 + 256 + h * 32 + (d0 - 4) * 16 + hi * 8);
#pragma unroll
    for (int d0 = 0; d0 < 6; ++d0) asm volatile("" : "+v"(qr[d0]));
    const bf16_t* ksrc = Kp + (rowbase + lane) * 512 + wid * 8;
    const bf16_t* krsrc = T.KR + (rowbase + lane) * 32 + (wid & 3) * 8;
    const bf16_t* vsrc = Vp + (rowbase + 16 * (wid & 3) + (lane >> 2)) * 512 + (wid >> 2) * 32 + (lane & 3) * 8;
    const unsigned kdst = lds0 + L_K + wid * 1024, krdst = lds0 + L_K + (8 + (wid & 3)) * 1024, vdst = lds0 + L_V + wid * 1024;
#define DMA_K(t, si) do { glds16(ksrc + (long)(t) * KVBLK * 512, (unsigned)__builtin_amdgcn_readfirstlane(kdst + (si) * SLOTK)); \
                          glds16(krsrc + (long)(t) * KVBLK * 32, (unsigned)__builtin_amdgcn_readfirstlane(krdst + (si) * SLOTK)); } while (0)
#define DMA_V(t, si) glds16(vsrc + (long)(t) * KVBLK * 512, (unsigned)__builtin_amdgcn_readfirstlane(vdst + (si) * SLOTV))
    const int vb0 = (int)(lds0 + L_V) + ((lane >> 4) & 1) * 32 + (lane & 3) * 8 + (4 * hi + ((lane & 15) >> 2)) * 64;
    const lds_cptr shm3 = (lds_cptr)shm; const lds_cptr kp0 = shm3 + L_K + hi * 1024 + r32 * 16;
    const lds_cptr vp0 = shm3 + L_V + ((lane >> 4) & 1) * 32 + (lane & 3) * 8 + (4 * hi + ((lane & 15) >> 2)) * 64;
    const int qrel = wid * 32 + r32;
    DMA_K(0, 0); DMA_V(0, 0); DMA_K(1, 1);
    bf16x8 kf[12];
    float mhat = 0.f, l_reg = 0.f; f32x16 o[2]; o[0] = f32x16{}; o[1] = f32x16{};
    const f32x16 zero16 = f32x16{};
    bool resc = false;
#define CMASK(P0, P1, t) do { int jb_ = (t) - (NT - 4); if (jb_ >= 0) cmask(P0, P1, jb_, qrel, hi); } while (0)
#define DECIDE(C0, C1, rmraw) do { resc = false; const float rel_ = (rmraw) - mhat; const float dl = (rel_ > 6.0f) ? rel_ : 0.f; \
        if (__builtin_expect(__any(dl != 0.f), 0)) { const float f = __builtin_amdgcn_exp2f(-dl); mhat += dl; l_reg *= f; if (hi == 0) wsf[r32] = f; resc = true; } \
        _Pragma("unroll") for (int r = 0; r < 16; ++r) { C0[r] -= mhat; C1[r] -= mhat; } } while (0)
#define RESC() do { if (resc) { asm volatile("s_waitcnt lgkmcnt(0)" ::: "memory"); \
        _Pragma("unroll") for (int d_ = 0; d_ < 2; ++d_) _Pragma("unroll") for (int r = 0; r < 16; ++r) o[d_][r] *= wsf[crow(r, hi)]; } } while (0)
    f32x16 pA0, pA1, pB0, pB1;
    int ip = 0, ic = 0, in_ = 1;
#define ROT() do { ip = ic; ic = in_; in_ = (in_ == NSLOT - 1) ? 0 : in_ + 1; } while (0)
    DMA_K(2, 2);
    WAIT_BAR(5);
    qkt<6>(pA0, pA1, shm3 + L_K, qr, zero16, r32, hi);
    CMASK(pA0, pA1, 0);
    { float rm = rowmax_cv(pA0, pA1); rm = swap_max(rm); mhat = rm;
#pragma unroll
      for (int r = 0; r < 16; ++r) { pA0[r] = __builtin_amdgcn_exp2f(pA0[r] - mhat); pA1[r] = __builtin_amdgcn_exp2f(pA1[r] - mhat); } }
    WAIT_BAR(0);
    DMA_K(3, 0); DMA_V(1, 1);
    ROT();
    kload12(kf, kp0 + ic * SLOTK);
    WAIT_BAR(3);
    s16x4 vlo[8], vhi[8]; u32x4 pw0, pw1, pw2, pw3;
#define PKW(P, B) cvtpk(P[B], P[B + 1])
#define PAF(k) __builtin_bit_cast(bf16x8, pw##k)
#define VFR(i) (bf16x8){vlo[i][0], vlo[i][1], vlo[i][2], vlo[i][3], vhi[i][0], vhi[i][1], vhi[i][2], vhi[i][3]}
#define PIN(x) asm volatile("" : "+v"(x))
#define GAPA(MF, A0, A1, A2, A3, W0, W1, PW) do { MF; sacc += A0; sacc += A1; sacc += A2; sacc += A3; PIN(sacc); W0; W1; PIN(PW); SBAR(); } while (0)
#define EX(v) __builtin_amdgcn_exp2f(v)
#define GAPB(MF, X, B) do { MF; X[B] = EX(X[B]); X[B + 1] = EX(X[B + 1]); X[B + 2] = EX(X[B + 2]); X[B + 3] = EX(X[B + 3]); PIN(X); SBAR(); } while (0)
#define VRD(i) do { vlo[i] = vtr(vp_ + (((i) >> 2) * 4096 + ((i) & 3) * 1024)); vhi[i] = vtr(vp_ + (((i) >> 2) * 4096 + ((i) & 3) * 1024 + 512)); } while (0)
#define KRD(G, j) do { if (G) { kload2(kf, kp0 + in_ * SLOTK, j); SBAR(); } } while (0)
#define MFQ(c, a, b_) __builtin_amdgcn_mfma_f32_32x32x16_bf16(a, b_, c, 0, 0, 0)
#define STEP(C0, C1, P0, P1, t, GK, GV, GL) do { SBAR(); \
    const lds_cptr vp_ = vp0 + ip * SLOTV; \
    VRD(0); SBAR(); float sacc = (P0[0] + P0[1]); \
    GAPA(C0 = MFQ(zero16, kf[0], qr[0]), P0[2], P0[3], P0[4], P0[5],     pw0[0] = PKW(P0, 0), pw0[1] = PKW(P0, 2), pw0); \
    VRD(4); SBAR(); GAPA(C1 = MFQ(zero16, kf[1], qr[0]), P0[6], P0[7], P0[8], P0[9],     pw0[2] = PKW(P0, 4), pw0[3] = PKW(P0, 6), pw0); \
    VRD(1); SBAR(); GAPA(C0 = MFQ(C0, kf[2], qr[1]),   P0[10], P0[11], P0[12], P0[13], pw1[0] = PKW(P0, 8), pw1[1] = PKW(P0, 10), pw1); \
    VRD(5); SBAR(); GAPA(C1 = MFQ(C1, kf[3], qr[1]),   P0[14], P0[15], P1[0], P1[1],   pw1[2] = PKW(P0, 12), pw1[3] = PKW(P0, 14), pw1); \
    VRD(2); SBAR(); GAPA(C0 = MFQ(C0, kf[4], qr[2]),   P1[2], P1[3], P1[4], P1[5],     pw2[0] = PKW(P1, 0), pw2[1] = PKW(P1, 2), pw2); \
    VRD(6); SBAR(); GAPA(C1 = MFQ(C1, kf[5], qr[2]),   P1[6], P1[7], P1[8], P1[9],     pw2[2] = PKW(P1, 4), pw2[3] = PKW(P1, 6), pw2); \
    VRD(3); SBAR(); GAPA(C0 = MFQ(C0, kf[6], qr[3]),   P1[10], P1[11], P1[12], P1[13], pw3[0] = PKW(P1, 8), pw3[1] = PKW(P1, 10), pw3); \
    VRD(7); SBAR(); GAPA(C1 = MFQ(C1, kf[7], qr[3]),   P1[14], P1[15], 0.f, 0.f,       pw3[2] = PKW(P1, 12), pw3[3] = PKW(P1, 14), pw3); \
    C0 = MFQ(C0, kf[8], qr[4]); C1 = MFQ(C1, kf[9], qr[4]); C0 = MFQ(C0, kf[10], qr[5]); C1 = MFQ(C1, kf[11], qr[5]); SBAR(); \
    l_reg += sacc; \
    if (GK) { DMA_K((t) + 3, ic); } if (GV) { DMA_V((t) + 1, in_); } \
    CMASK(C0, C1, t); \
    { float rm = rowmax_cv(C0, C1); rm = swap_max(rm); DECIDE(C0, C1, rm); } \
    SBAR(); \
    GAPB(o[0] = MFQ(o[0], PAF(0), VFR(0)), C0, 0); \
    KRD(GL, 0); GAPB(o[1] = MFQ(o[1], PAF(0), VFR(4)), C0, 4); \
    KRD(GL, 1); GAPB(o[0] = MFQ(o[0], PAF(1), VFR(1)), C0, 8); \
    KRD(GL, 2); GAPB(o[1] = MFQ(o[1], PAF(1), VFR(5)), C0, 12); \
    KRD(GL, 3); GAPB(o[0] = MFQ(o[0], PAF(2), VFR(2)), C1, 0); \
    KRD(GL, 4); GAPB(o[1] = MFQ(o[1], PAF(2), VFR(6)), C1, 4); \
    KRD(GL, 5); GAPB(o[0] = MFQ(o[0], PAF(3), VFR(3)), C1, 8); \
    GAPB(o[1] = MFQ(o[1], PAF(3), VFR(7)), C1, 12); \
    } while (0)
    int t = 1;
#undef CMASK
#define CMASK(P0, P1, t) do {} while (0)
    for (; t + 5 < NT; t += 2) {
        STEP(pB0, pB1, pA0, pA1, t, true, true, true);     WAIT_BAR(3); RESC(); ROT();
        STEP(pA0, pA1, pB0, pB1, t + 1, true, true, true); WAIT_BAR(3); RESC(); ROT();
    }
#undef CMASK
#define CMASK(P0, P1, t) do { int jb_ = (t) - (NT - 4); if (jb_ >= 0) cmask(P0, P1, jb_, qrel, hi); } while (0)
#define ENDW(tt) do { if ((tt) + 3 < NT) { WAIT_BAR(3); } else if ((tt) + 2 < NT) { WAIT_BAR(1); } else { WAIT_BAR(0); } } while (0)
    for (; t + 1 < NT; t += 2) {
        STEP(pB0, pB1, pA0, pA1, t, (t + 3 < NT), (t + 1 < NT), (t + 1 < NT));         ENDW(t);     RESC(); ROT();
        STEP(pA0, pA1, pB0, pB1, t + 1, (t + 4 < NT), (t + 2 < NT), (t + 2 < NT));     ENDW(t + 1); RESC(); ROT();
    }
    u32x4 gq[4];
#pragma unroll
    for (int i = 0; i < 4; ++i) gq[i] = *(const u32x4*)(T.U + (rowbase + q0 + wid * 32 + i * 8 + (lane >> 3)) * UP + gcol + (lane & 7) * 8);
    STEP(pB0, pB1, pA0, pA1, NT - 1, false, false, false); RESC();
    { float sacc = pB0[0] + pB0[1];
#pragma unroll
      for (int r = 2; r < 16; ++r) sacc += pB0[r];
#pragma unroll
      for (int r = 0; r < 16; ++r) sacc += pB1[r];
      l_reg += sacc;
      SBAR(); pv(o, vb0 + ic * SLOTV, pk8(pB0, 0), pk8(pB0, 8), pk8(pB1, 0), pk8(pB1, 8)); }
    l_reg = swap_add(l_reg);
    if (hi == 0) wsf[32 + r32] = l_reg;
    asm volatile("s_waitcnt lgkmcnt(0)" ::: "memory");
#pragma unroll
    for (int r = 0; r < 16; ++r) { const float f = __builtin_amdgcn_rcpf(wsf[32 + crow(r, hi)]); o[0][r] *= f; o[1][r] *= f; }
    {
        ALAS bf16_t* stg = (ALAS bf16_t*)(shm + L_OST) + wid * 2048;
#pragma unroll
        for (int r = 0; r < 16; ++r) { const int orow = crow(r, hi);
#pragma unroll
            for (int d0 = 0; d0 < 2; ++d0) stg[orow * 64 + d0 * 32 + r32] = (bf16_t)(cvtpk(o[d0][r], 0.f) & 0xffffu); }
        asm volatile("s_waitcnt lgkmcnt(0)" ::: "memory");
#pragma unroll
        for (int i = 0; i < 4; ++i) asm volatile("" : "+v"(gq[i]));
#pragma unroll
        for (int i = 0; i < 4; ++i) { const int row = i * 8 + (lane >> 3), ch = lane & 7;
            const u32x4 v = *(ALAS const u32x4*)(stg + row * 64 + ch * 8);
            const long grow = rowbase + q0 + wid * 32 + row;
            const u32x4 g = gq[i];
            float x[8] = {bflo(v.x), bfhi(v.x), bflo(v.y), bfhi(v.y), bflo(v.z), bfhi(v.z), bflo(v.w), bfhi(v.w)};
            const float gg[8] = {bflo(g.x), bfhi(g.x), bflo(g.y), bfhi(g.y), bflo(g.z), bfhi(g.z), bflo(g.w), bfhi(g.w)};
#pragma unroll
            for (int j = 0; j < 8; ++j) x[j] *= gg[j] / (1.0f + __expf(-gg[j]));
            u32x4 w; w.x = cvtpk(x[0], x[1]); w.y = cvtpk(x[2], x[3]); w.z = cvtpk(x[4], x[5]); w.w = cvtpk(x[6], x[7]);
            *(u32x4*)(T.Y + grow * T.ypitch + (ycol - T.ysub) + ch * 8) = w; }
    }
    asm volatile("s_waitcnt vmcnt(0) lgkmcnt(0)\n\ts_barrier" ::: "memory");
#undef DMA_K
#undef DMA_V
#undef CMASK
#undef DECIDE
#undef RESC
#undef ROT
#undef PKW
#undef PAF
#undef VFR
#undef PIN
#undef GAPA
#undef EX
#undef GAPB
#undef VRD
#undef KRD
#undef MFQ
#undef STEP
#undef ENDW
}
#undef SBAR
#undef WAIT_BAR
}
namespace att {
constexpr int SBW = 6, SB_K = 0, SB_V = SBW * 8192, SB_STG = 2 * SBW * 8192, SB_END = SB_STG + 8 * 4096;
__device__ __forceinline__ void sb_unit_res(const Tensors& T, int b, int h, int qb, ALAS char* shm, unsigned lds0, ALAS unsigned* flags) {
    int tid_ = threadIdx.x; asm volatile("" : "+v"(tid_));
    const int tid = tid_, lane = tid & 63, r32 = lane & 31, hi = lane >> 5; const int wid = __builtin_amdgcn_readfirstlane(tid >> 6);
    const long rowbase = (long)b * SEQ; const int q0 = qb * QB;
    const int NT = (q0 + QB) / KVBLK;
    const bf16_t* Qp = T.U + 512 + h * 64; const bf16_t* Kp = Qp + 256; const bf16_t* Vp = Qp + 512;
    const int gcol = 2560 + 256 + h * 64, ycol = 256 + h * 64;
    const bf16_t* ksrc = Kp + (rowbase + lane) * UP + wid * 8;
    const bf16_t* vsrc = Vp + (rowbase + 16 * (wid & 3) + (lane >> 2)) * UP + (wid >> 2) * 32 + (lane & 3) * 8;
    const unsigned kdst = lds0 + SB_K + wid * 1024, vdst = lds0 + SB_V + wid * 1024;
    const int vb0 = (int)(lds0 + SB_V) + ((lane >> 4) & 1) * 32 + (lane & 3) * 8 + (4 * hi + ((lane & 15) >> 2)) * 64;
    const lds_cptr kbase = (lds_cptr)shm + SB_K;
    const int qrel = wid * 32 + r32;
    int base = NT - 1, nW = (base + 1 < SBW) ? base + 1 : SBW;
#define DMA_WIN() do { for (int s_ = 0; s_ < nW; ++s_) { glds16(ksrc + (long)(base - s_) * KVBLK * UP, (unsigned)__builtin_amdgcn_readfirstlane(kdst + s_ * 8192)); \
                                                          glds16(vsrc + (long)(base - s_) * KVBLK * UP, (unsigned)__builtin_amdgcn_readfirstlane(vdst + s_ * 8192)); } } while (0)
    DMA_WIN();
    const long qrow = rowbase + q0 + wid * 32 + r32;
    bf16x8 qr[4];
#pragma unroll
    for (int d0 = 0; d0 < 4; ++d0) qr[d0] = *(const bf16x8*)(Qp + qrow * UP + d0 * 16 + hi * 8);
    bf16x8 Ta, Tb, Tones;
    { short ta[8], tb[8];
#pragma unroll
      for (int j = 0; j < 8; ++j) { const int kk = 8 * (j >> 2) + 4 * hi + (j & 3); ta[j] = (kk > r32) ? (short)0x3F80 : (short)0; tb[j] = (16 + kk > r32) ? (short)0x3F80 : (short)0; }
      Ta = (bf16x8){ta[0], ta[1], ta[2], ta[3], ta[4], ta[5], ta[6], ta[7]}; Tb = (bf16x8){tb[0], tb[1], tb[2], tb[3], tb[4], tb[5], tb[6], tb[7]};
      Tones = (bf16x8){(short)0x3F80, (short)0x3F80, (short)0x3F80, (short)0x3F80, (short)0x3F80, (short)0x3F80, (short)0x3F80, (short)0x3F80}; }
    u32x4 gt[4];
#pragma unroll
    for (int i = 0; i < 4; ++i) gt[i] = *(const u32x4*)(T.U + (rowbase + q0 + wid * 32 + i * 8 + (lane >> 3)) * UP + gcol + (lane & 7) * 8);
#pragma unroll
    for (int d0 = 0; d0 < 4; ++d0) asm volatile("" : "+v"(qr[d0]));
#pragma unroll
    for (int i = 0; i < 4; ++i) asm volatile("" : "+v"(gt[i]));
    float c = 0.f; f32x16 o[2]; o[0] = f32x16{}; o[1] = f32x16{};
    const f32x16 zero16 = f32x16{};
    bool mydone = false;
    for (;;) {
        asm volatile("s_waitcnt vmcnt(0) lgkmcnt(0)\n\ts_barrier" ::: "memory");
        if (!mydone) {
            for (int s = 0; s < nW; ++s) {
                const int t = base - s, jb = t - (NT - 4);
                const bool wave_active = (jb < 0) || (64 * jb < wid * 32 + 31);
                if (wave_active) {
                    f32x16 p0, p1, D0, D1;
                    qkt<4>(p0, p1, kbase + s * 8192, qr, zero16, r32, hi);
                    f32x16 L0, L1;
#pragma unroll
                    for (int r = 0; r < 16; ++r) {
                        { const float z = p0[r]; const float e = __builtin_amdgcn_exp2f(-fabsf(z)); const float sp = fmaxf(z, 0.f) + __builtin_amdgcn_logf(1.0f + e); p0[r] = z - sp; L0[r] = -sp; }
                        { const float z = p1[r]; const float e = __builtin_amdgcn_exp2f(-fabsf(z)); const float sp = fmaxf(z, 0.f) + __builtin_amdgcn_logf(1.0f + e); p1[r] = z - sp; L1[r] = -sp; }
                    }
                    if (jb >= 0) {
#pragma unroll
                        for (int r = 0; r < 16; ++r) { const int kv = 64 * jb + 4 * hi + (r & 3) + 8 * (r >> 2);
                            if (kv >= qrel) { p0[r] = -INFINITY; L0[r] = 0.f; } if (kv + 32 >= qrel) { p1[r] = -INFINITY; L1[r] = 0.f; } }
                    }
                    const bf16x8 B0 = pk8(L0, 0), B1 = pk8(L0, 8), B2 = pk8(L1, 0), B3 = pk8(L1, 8);
                    f32x16 X = __builtin_amdgcn_mfma_f32_32x32x16_bf16(Tones, B2, zero16, 0, 0, 0);
                    X = __builtin_amdgcn_mfma_f32_32x32x16_bf16(Tones, B3, X, 0, 0, 0);
                    D0 = __builtin_amdgcn_mfma_f32_32x32x16_bf16(Ta, B0, X, 0, 0, 0);
                    D0 = __builtin_amdgcn_mfma_f32_32x32x16_bf16(Tb, B1, D0, 0, 0, 0);
                    D1 = __builtin_amdgcn_mfma_f32_32x32x16_bf16(Ta, B2, zero16, 0, 0, 0);
                    D1 = __builtin_amdgcn_mfma_f32_32x32x16_bf16(Tb, B3, D1, 0, 0, 0);
                    f32x16 TT = __builtin_amdgcn_mfma_f32_32x32x16_bf16(Tones, B0, X, 0, 0, 0);
                    TT = __builtin_amdgcn_mfma_f32_32x32x16_bf16(Tones, B1, TT, 0, 0, 0);
#pragma unroll
                    for (int r = 0; r < 16; ++r) { p0[r] += D0[r] + c; p1[r] += D1[r] + c; }
                    c += TT[0];
#pragma unroll
                    for (int r = 0; r < 16; ++r) { p0[r] = __builtin_amdgcn_exp2f(p0[r]); p1[r] = __builtin_amdgcn_exp2f(p1[r]); }
                    pv(o, vb0 + s * 8192, pk8(p0, 0), pk8(p0, 8), pk8(p1, 0), pk8(p1, 8));
                }
                if (__all(c < SB_EXIT)) { mydone = true; break; }
            }
        }
        base -= nW;
        if (base < 0) break;
        if (lane == 0) flags[wid] = mydone ? 1u : 0u;
        asm volatile("s_waitcnt lgkmcnt(0)\n\ts_barrier" ::: "memory");
        { const unsigned all = flags[0] & flags[1] & flags[2] & flags[3] & flags[4] & flags[5] & flags[6] & flags[7];
          if (__builtin_amdgcn_readfirstlane(all) != 0u) break; }
        nW = (base + 1 < SBW) ? base + 1 : SBW;
        DMA_WIN();
    }
    {
        ALAS bf16_t* stg = (ALAS bf16_t*)(shm + SB_STG) + wid * 2048;
#pragma unroll
        for (int r = 0; r < 16; ++r) { const int orow = crow(r, hi);
#pragma unroll
            for (int d0 = 0; d0 < 2; ++d0) stg[orow * 64 + d0 * 32 + r32] = (bf16_t)(cvtpk(o[d0][r], 0.f) & 0xffffu); }
        asm volatile("s_waitcnt lgkmcnt(0)" ::: "memory");
#pragma unroll
        for (int i = 0; i < 4; ++i) { const int row = i * 8 + (lane >> 3), ch = lane & 7;
            const u32x4 v = *(ALAS const u32x4*)(stg + row * 64 + ch * 8);
            const long grow = rowbase + q0 + wid * 32 + row;
            const u32x4 g = gt[i];
            float x[8] = {bflo(v.x), bfhi(v.x), bflo(v.y), bfhi(v.y), bflo(v.z), bfhi(v.z), bflo(v.w), bfhi(v.w)};
            const float gg[8] = {bflo(g.x), bfhi(g.x), bflo(g.y), bfhi(g.y), bflo(g.z), bfhi(g.z), bflo(g.w), bfhi(g.w)};
#pragma unroll
            for (int j = 0; j < 8; ++j) x[j] *= gg[j] / (1.0f + __expf(-gg[j]));
            u32x4 w; w.x = cvtpk(x[0], x[1]); w.y = cvtpk(x[2], x[3]); w.z = cvtpk(x[4], x[5]); w.w = cvtpk(x[6], x[7]);
            *(u32x4*)(T.Y + grow * T.ypitch + (ycol - T.ysub) + ch * 8) = w; }
    }
    asm volatile("s_waitcnt vmcnt(0) lgkmcnt(0)\n\ts_barrier" ::: "memory");
#undef DMA_WIN
}
}

constexpr int NWAVES = 8, NTHREADS = NWAVES * 64;
constexpr int BATCH = 8, SEQ = 4096, DM = 1024, DEPTH = 4, M = BATCH * SEQ, D_IN = 3424, NU = 3584;
constexpr float NORM_EPS = 1e-6f;
constexpr float LOG2E = 1.4426950408889634f;
constexpr float QSCALE_64 = 0.125f * LOG2E;
constexpr float QSCALE_96 = 0.10206207261596575f * LOG2E;
constexpr size_t MiB = 1u << 20;
constexpr size_t WS_CTL = 0, CTL_ZERO_BYTES = 1 * MiB;
constexpr size_t WS_WIN = 1 * MiB, WS_WOUT = 29 * MiB, WS_WQ2 = 37 * MiB, WS_WKV2 = 38 * MiB, WS_WPW = 39 * MiB;
constexpr size_t WS_ROPE = 39 * MiB + 512 * 1024, WS_BT = 40 * MiB, WS_KMEAN = 40 * MiB + 256 * 1024;
constexpr size_t WS_SSQQ = 41 * MiB, WS_SSQKV = 41 * MiB + 512 * 1024, WS_SSQO = 42 * MiB, WS_KR = 44 * MiB, WS_CONVH = 46 * MiB, WS_QA = 62 * MiB, WS_KVA = 86 * MiB;
constexpr size_t WS_HNY = 118 * MiB;
constexpr size_t WS_U = 182 * MiB;
constexpr size_t WS_XB = 406 * MiB;
constexpr size_t WS_RSTD = 40 * MiB + 384 * 1024;
constexpr size_t WS_END = 470 * MiB;
static_assert(WS_WIN + (size_t)DEPTH * NU * DM * 2 <= WS_WOUT && WS_WOUT + (size_t)DEPTH * DM * DM * 2 <= WS_WQ2 && WS_WPW + (size_t)DEPTH * 256 * 256 * 2 <= WS_ROPE, "ws map (weights)");
static_assert(WS_ROPE + 2 * SEQ * 16 * 4 <= WS_BT && WS_BT + 4 * 4352 * 4 <= WS_KMEAN && WS_KMEAN + BATCH * 16 * 256 * 4 <= WS_SSQQ && WS_SSQO + (size_t)M * 16 * 4 <= WS_KR, "ws map (tables)");
static_assert(WS_KR + (size_t)M * 32 * 2 <= WS_CONVH && WS_CONVH + (size_t)M * 256 * 2 <= WS_QA && WS_QA + (size_t)M * 384 * 2 <= WS_KVA && WS_KVA + (size_t)M * 512 * 2 <= WS_HNY &&
              WS_HNY + (size_t)M * DM * 2 <= WS_U && WS_U + (size_t)M * NU * 2 <= WS_XB && WS_XB + (size_t)M * DM * 2 <= WS_END && WS_RSTD + (size_t)M * 4 <= WS_SSQQ, "ws map (activations)");
constexpr int CW_BAR = 4096, CW_QUEUE = 8192;
constexpr int RING_OFF = 0, RING_BYTES = 131072, LDSCTL_OFF = RING_BYTES, MISC_OFF = LDSCTL_OFF + 320, LDS_BYTES = 147456;
#ifndef PH_MASK
#define PH_MASK 0xFFFF
#endif
#define PH_EN(k) ((PH_MASK >> (k)) & 1)
static_assert(att::L_END <= RING_BYTES, "attention LDS map");
static_assert(att::SB_END <= RING_BYTES, "stick-breaking LDS map");
#define GAS __attribute__((address_space(1)))
#define LAS __attribute__((address_space(3)))
typedef unsigned short bf16;
typedef unsigned v4u __attribute__((ext_vector_type(4)));
typedef float f32x4 __attribute__((ext_vector_type(4)));
typedef short bf16x8 __attribute__((ext_vector_type(8)));
typedef GAS unsigned gu32;
typedef GAS unsigned long long gu64;
#define RLX_AGENT __ATOMIC_RELAXED, __HIP_MEMORY_SCOPE_AGENT
#define LDS_WAIT() asm volatile("s_waitcnt lgkmcnt(0)" ::: "memory")
#define VM_WAIT() asm volatile("s_waitcnt vmcnt(0)" ::: "memory")
__device__ __forceinline__ unsigned long long rt() { return __builtin_amdgcn_s_memrealtime(); }
__device__ __forceinline__ unsigned f2bf(float f) { unsigned u = __builtin_bit_cast(unsigned, f); return (u + 0x7fffu + ((u >> 16) & 1u)) >> 16; }
__device__ __forceinline__ unsigned pk2(float lo, float hi) { return f2bf(lo) | (f2bf(hi) << 16); }
#define XB_TMO      128
#define XB_XCNT(j)  (256  + 64 * (j))
#define XB_XSUB(j)  (1280 + 64 * (j))
#define XB_XGEN(j)  (2304 + 64 * (j))
#define XB_TOP      3328
#define XB_TOPGEN   3392
#define XCD_BAR_WORDS 3456
#define XB_SPIN_CAP (1u << 18)

__device__ __forceinline__ unsigned xb_ld(unsigned* p)              { return __hip_atomic_load(p, __ATOMIC_RELAXED, __HIP_MEMORY_SCOPE_AGENT); }
__device__ __forceinline__ unsigned xb_add(unsigned* p, unsigned v) { return __hip_atomic_fetch_add(p, v, __ATOMIC_RELAXED, __HIP_MEMORY_SCOPE_AGENT); }
__device__ __forceinline__ unsigned xb_xcc_id() { return (unsigned)__builtin_amdgcn_s_getreg((3 << 11) | 20) & 0xFu; }
#define XB_SPIN(cond, bar) do { unsigned _sp = 0; while (cond) { __builtin_amdgcn_s_sleep(1); \
    if ((++_sp & 255u) == 0u) { if (xb_ld(&(bar)[XB_TMO])) break; if (_sp > XB_SPIN_CAP) { atomicAdd(&(bar)[XB_TMO], 1u); break; } } } } while (0)

struct XcdBarrier {
    unsigned* bar; unsigned x;
    volatile LAS unsigned* st;
};

__device__ __forceinline__ XcdBarrier xcd_barrier_post(unsigned* bar, volatile LAS unsigned* st) {
    XcdBarrier b; b.bar = bar; b.x = xb_xcc_id(); b.st = st;
    if (threadIdx.x == 0) (void)xb_add(&bar[XB_XCNT(b.x)], 1u);
    return b;
}
__device__ __forceinline__ void xcd_barrier_complete(unsigned* bar, unsigned x, unsigned& nloc, unsigned& nx) {
    const unsigned G = gridDim.x * gridDim.y * gridDim.z;
    unsigned sum, cnt, mine, sp = 0u;
    for (;;) {
        sum = 0u; cnt = 0u; mine = 0u;
#pragma unroll
        for (unsigned j = 0; j < 16; ++j) { const unsigned c = xb_ld(&bar[XB_XCNT(j)]); sum += c; cnt += (c > 0u) ? 1u : 0u; mine = (j == x) ? c : mine; }
        if (sum == G) break;
        __builtin_amdgcn_s_sleep(1);
        if ((++sp & 255u) == 0u) { if (xb_ld(&bar[XB_TMO])) break; if (sp > XB_SPIN_CAP) { atomicAdd(&bar[XB_TMO], 1u); break; } }
    }
    nloc = mine > 0u ? mine : 1u; nx = cnt > 0u ? cnt : 1u;
}

__device__ __forceinline__ void xcd_barrier(const XcdBarrier& b) {
    asm volatile("s_waitcnt vmcnt(0)" ::: "memory");
    __syncthreads();
    if (threadIdx.x == 0) {
        unsigned* bar = b.bar;
        __builtin_amdgcn_s_waitcnt(0);
        unsigned nloc = b.st[0], nx = b.st[1];
        if (nloc == 0u) { xcd_barrier_complete(bar, b.x, nloc, nx); b.st[0] = nloc; b.st[1] = nx; }
        const unsigned old = xb_add(&bar[XB_XSUB(b.x)], 1u);
        const unsigned gen = old / nloc;
        if (old + 1u == (gen + 1u) * nloc) {
            __builtin_amdgcn_fence(__ATOMIC_RELEASE, "agent");
            asm volatile("s_waitcnt vmcnt(0)" ::: "memory");
            const unsigned og = xb_add(&bar[XB_TOP], 1u);
            const unsigned tg = og / nx;
            if (og + 1u == (tg + 1u) * nx) xb_add(&bar[XB_TOPGEN], 1u);
            else XB_SPIN(xb_ld(&bar[XB_TOPGEN]) == tg, bar);
            __builtin_amdgcn_fence(__ATOMIC_ACQUIRE, "agent");
            xb_add(&bar[XB_XGEN(b.x)], 1u);
            asm volatile("s_waitcnt vmcnt(0)" ::: "memory");
        } else {
            XB_SPIN(xb_ld(&bar[XB_XGEN(b.x)]) == gen, bar);
            __builtin_amdgcn_fence(__ATOMIC_ACQUIRE, "agent");
            asm volatile("s_waitcnt vmcnt(0)" ::: "memory");
        }
    }
    __syncthreads();
}

struct Frame {
    LAS unsigned char* lds;
    volatile LAS unsigned* MISC;
    gu32* ctl;
    int tid, lane, wave, G, gw, NGW;
    const float* in[16];
    float* out; unsigned char* ws;
};
#define LOCAL_FRAME() Frame F = F0; { int t_ = threadIdx.x; asm volatile("" : "+v"(t_)); F.tid = t_; F.lane = t_ & 63; F.wave = __builtin_amdgcn_readfirstlane(t_ >> 6); \
    F.gw = blockIdx.x * NWAVES + F.wave; unsigned char* w_ = F0.ws; asm volatile("" : "+s"(w_)); F.ws = w_; }
__device__ __forceinline__ float wave_sum(float v) {
#pragma unroll
    for (int o = 1; o < 64; o <<= 1) v += __shfl_xor(v, o);
    return v;
}
__device__ __forceinline__ int ropemap(int j) { const int f = j >> 3, jj = j & 7; return jj < 4 ? 4 * f + jj : 16 + 4 * f + (jj - 4); }
__device__ __forceinline__ int src_in(int n) {
    const int t = n >> 8, c = n & 255;
    if (t == 0) return c < 192 ? c : -1;
    if (t == 1) return c < 128 ? 192 + c : (c < 160 ? 320 + ropemap(c - 128) : -1);
    return 352 + (t - 2) * 256 + c;
}
__device__ __forceinline__ int src_q(int n) {
    if (n < 256) return (n >> 6) * 96 + (n & 63);
    if (n < 384) { const int j = n - 256; return (j >> 5) * 96 + 64 + ropemap(j & 31); }
    return -1;
}
__device__ __forceinline__ int src_kv(int n) {
    if (n < 256) return (n >> 6) * 128 + (n & 63);
    const int j = n - 256; return (j >> 6) * 128 + 64 + (j & 63);
}
template <int MAP> __device__ __forceinline__ void cvt_weight(const float* W, const float* gv, bf16* Wt, int N, int K, int Ksrc, int Nsrc, int gt, int ngt) {
    const int items = N * (K / 8);
    for (int it = gt; it < items; it += ngt) {
        const int n = it % N, kc = it / N;
        const int sc = MAP == 0 ? src_in(n) : MAP == 1 ? src_q(n) : MAP == 2 ? src_kv(n) : n;
        float v[8];
#pragma unroll
        for (int i = 0; i < 8; ++i) { const int k = kc * 8 + i; v[i] = (sc >= 0 && k < Ksrc) ? W[(size_t)k * Nsrc + sc] * (gv ? gv[k] : 1.0f) : 0.0f; }
        v4u o; o.x = pk2(v[0], v[1]); o.y = pk2(v[2], v[3]); o.z = pk2(v[4], v[5]); o.w = pk2(v[6], v[7]);
        *(GAS v4u*)(Wt + (size_t)n * K + kc * 8) = o;
    }
}
__device__ __forceinline__ void row_to_bf16_rstd(const f32x4 (&v)[4], bf16* orow, float* rstd, int lane) {
    float s = 0.f;
#pragma unroll
    for (int j = 0; j < 4; ++j) s += (v[j][0] * v[j][0] + v[j][1] * v[j][1]) + (v[j][2] * v[j][2] + v[j][3] * v[j][3]);
    const float r = 1.0f / sqrtf(wave_sum(s) * (1.0f / 1024.0f) + NORM_EPS);
    if (lane == 0) *rstd = r;
#pragma unroll
    for (int j = 0; j < 4; ++j) *(GAS unsigned long long*)(orow + 4 * lane + 256 * j) = (unsigned long long)pk2(v[j][0], v[j][1]) | ((unsigned long long)pk2(v[j][2], v[j][3]) << 32);
}

__device__ __forceinline__ void p_prologue(Frame& F0) {
    LOCAL_FRAME();
    const int gt = blockIdx.x * NTHREADS + F.tid, ngt = F.G * NTHREADS;
    for (int l = 0; l < DEPTH; ++l) {
        cvt_weight<0>(F.in[2] + (size_t)l * DM * D_IN, F.in[1] + l * DM, (bf16*)(F.ws + WS_WIN) + (size_t)l * NU * DM, NU, DM, DM, D_IN, gt, ngt);
        cvt_weight<1>(F.in[4] + (size_t)l * 192 * 384, F.in[3] + l * 192, (bf16*)(F.ws + WS_WQ2) + (size_t)l * 512 * 256, 512, 256, 192, 384, gt, ngt);
        cvt_weight<2>(F.in[6] + (size_t)l * 128 * 512, F.in[5] + l * 128, (bf16*)(F.ws + WS_WKV2) + (size_t)l * 512 * 256, 512, 256, 128, 512, gt, ngt);
        cvt_weight<3>(F.in[12] + (size_t)l * 256 * 256, nullptr, (bf16*)(F.ws + WS_WPW) + (size_t)l * 256 * 256, 256, 256, 256, 256, gt, ngt);
        cvt_weight<3>(F.in[14] + (size_t)l * DM * DM, nullptr, (bf16*)(F.ws + WS_WOUT) + (size_t)l * DM * DM, DM, DM, DM, DM, gt, ngt);
    }
    float* cosT = (float*)(F.ws + WS_ROPE); float* sinT = cosT + SEQ * 16;
    for (int it = gt; it < SEQ * 16; it += ngt) { const int pos = it >> 4, i = it & 15;
        const float freq = powf(10000.0f, -(float)i / 16.0f); const float ang = (float)pos * freq;
        cosT[it] = cosf(ang); sinT[it] = sinf(ang); }
    float* BT = (float*)(F.ws + WS_BT);
    for (int it = gt; it < 4 * att::TBL_N; it += ngt) { const int h = it / att::TBL_N, idx = it % att::TBL_N; const int dist = idx - 256; const int n = dist > 0 ? dist : 0;
        int bucket;
        if (n < 16) bucket = n;
        else { bucket = 16 + (int)floor((log2((double)n) - 4.0) * (8.0 / 3.0) + 1e-9); if (bucket > 31) bucket = 31; }
        BT[it] = F.in[7][bucket * 4 + h] * 1.4426950408889634f; }
    const float* x = F.in[0]; bf16* XB = (bf16*)(F.ws + WS_XB); float* RS = (float*)(F.ws + WS_RSTD);
    for (int m0 = F.gw * 4; m0 < M; m0 += F.NGW * 4) { f32x4 v[4][4];
#pragma unroll
        for (int r = 0; r < 4; ++r)
#pragma unroll
            for (int j = 0; j < 4; ++j) v[r][j] = *(const f32x4*)(x + (size_t)(m0 + r) * DM + 4 * F.lane + 256 * j);
#pragma unroll
        for (int r = 0; r < 4; ++r) row_to_bf16_rstd(v[r], XB + (size_t)(m0 + r) * DM, RS + m0 + r, F.lane); }
}

__device__ __forceinline__ void conv_unit(Frame& F0, int l, int unit) {
    LOCAL_FRAME();
    const bf16* U = (const bf16*)(F.ws + WS_U); bf16* CH = (bf16*)(F.ws + WS_CONVH);
    LAS float* xg = (LAS float*)F.lds;
    const int r0 = unit * 64, s0 = r0 & (SEQ - 1);
    {
        v4u av[6], gv[6];
#pragma unroll
        for (int k = 0; k < 6; ++k) { const int it = F.tid + k * NTHREADS; const int rr = it >> 5, cg = it & 31; const int srow = r0 - 30 + rr;
            if (it < 94 * 32 && s0 - 30 + rr >= 0) { av[k] = *(const GAS v4u*)(U + (size_t)srow * NU + 2048 + cg * 8); gv[k] = *(const GAS v4u*)(U + (size_t)srow * NU + 2304 + cg * 8); }
            else { av[k] = (v4u){0u, 0u, 0u, 0u}; gv[k] = (v4u){0u, 0u, 0u, 0u}; } }
#pragma unroll
        for (int k = 0; k < 6; ++k) { const int it = F.tid + k * NTHREADS; const int rr = it >> 5, cg = it & 31;
            if (it < 94 * 32) {
                const float a8[8] = {pg8::bf_lo(av[k].x), pg8::bf_hi(av[k].x), pg8::bf_lo(av[k].y), pg8::bf_hi(av[k].y), pg8::bf_lo(av[k].z), pg8::bf_hi(av[k].z), pg8::bf_lo(av[k].w), pg8::bf_hi(av[k].w)};
                const float g8[8] = {pg8::bf_lo(gv[k].x), pg8::bf_hi(gv[k].x), pg8::bf_lo(gv[k].y), pg8::bf_hi(gv[k].y), pg8::bf_lo(gv[k].z), pg8::bf_hi(gv[k].z), pg8::bf_lo(gv[k].w), pg8::bf_hi(gv[k].w)};
                float o[8];
#pragma unroll
                for (int j = 0; j < 8; ++j) o[j] = a8[j] / (1.0f + __expf(-g8[j]));
                *(LAS f32x4*)(xg + rr * 256 + cg * 8) = (f32x4){o[0], o[1], o[2], o[3]}; *(LAS f32x4*)(xg + rr * 256 + cg * 8 + 4) = (f32x4){o[4], o[5], o[6], o[7]}; } }
    }
    __syncthreads();
    const int c = F.tid & 255, rh = F.tid >> 8;
    float y[32];
    { float win[62], wt[31];
      const float* dw = F.in[8] + (size_t)l * 31 * 256 + c;
#pragma unroll
      for (int w = 0; w < 31; ++w) wt[w] = dw[w * 256];
#pragma unroll
      for (int i = 0; i < 62; ++i) win[i] = xg[(rh * 32 + i) * 256 + c];
      const float bias = F.in[9][l * 256 + c];
#pragma unroll
      for (int s = 0; s < 32; ++s) { float a = bias;
#pragma unroll
          for (int w = 0; w < 31; ++w) a += wt[w] * win[s + w];
          y[s] = a; } }
    __syncthreads();
#pragma unroll
    for (int s = 0; s < 32; ++s) xg[(rh * 32 + s) * 256 + c] = y[s];
    __syncthreads();
    const f32x4 lg = *(const f32x4*)(F.in[10] + l * 256 + 4 * F.lane), lb = *(const f32x4*)(F.in[11] + l * 256 + 4 * F.lane);
#pragma unroll
    for (int i = 0; i < 8; ++i) { const int row = 8 * F.wave + i;
        const f32x4 v = *(LAS f32x4*)(xg + row * 256 + 4 * F.lane);
        const float mean = wave_sum((v[0] + v[1]) + (v[2] + v[3])) * (1.0f / 256.0f);
        const f32x4 d = v - mean;
        const float var = wave_sum((d[0] * d[0] + d[1] * d[1]) + (d[2] * d[2] + d[3] * d[3])) * (1.0f / 256.0f);
        const float rstd = 1.0f / sqrtf(var + NORM_EPS);
        f32x4 o = d * rstd * lg + lb;
#pragma unroll
        for (int j = 0; j < 4; ++j) o[j] = o[j] / (1.0f + __expf(-o[j]));
        *(GAS unsigned long long*)(CH + (size_t)(r0 + row) * 256 + 4 * F.lane) = (unsigned long long)pk2(o[0], o[1]) | ((unsigned long long)pk2(o[2], o[3]) << 32); }
    __syncthreads();
}
__device__ __forceinline__ void kmean_unit(Frame& F0, int item) {
    LOCAL_FRAME();
    const bf16* U = (const bf16*)(F.ws + WS_U); float* KM = (float*)(F.ws + WS_KMEAN);
    LAS float* part = (LAS float*)F.lds;
    const int cg = F.tid & 31, rg = F.tid >> 5; const size_t base = (size_t)item * 256 + rg * 16;
    float a[8];
#pragma unroll
    for (int j = 0; j < 8; ++j) a[j] = 0.f;
#pragma unroll
    for (int i = 0; i < 16; ++i) { const v4u k = *(const GAS v4u*)(U + (base + i) * NU + 1536 + cg * 8);
        a[0] += pg8::bf_lo(k.x); a[1] += pg8::bf_hi(k.x); a[2] += pg8::bf_lo(k.y); a[3] += pg8::bf_hi(k.y); a[4] += pg8::bf_lo(k.z); a[5] += pg8::bf_hi(k.z); a[6] += pg8::bf_lo(k.w); a[7] += pg8::bf_hi(k.w); }
#pragma unroll
    for (int j = 0; j < 8; ++j) part[rg * 256 + cg * 8 + j] = a[j];
    __syncthreads();
    if (F.tid < 256) { float s = 0.f;
#pragma unroll
        for (int r = 0; r < 16; ++r) s += part[r * 256 + F.tid];
        KM[(size_t)item * 256 + F.tid] = s * (1.0f / 256.0f); }
    __syncthreads();
}
__device__ __forceinline__ void p_residual(Frame& F0, int l) {
    LOCAL_FRAME();
    bf16* XB = (bf16*)(F.ws + WS_XB); float* RS = (float*)(F.ws + WS_RSTD);
    const bf16* T = (const bf16*)(F.ws + WS_U); const float* SS = (const float*)(F.ws + WS_SSQO);
    const float* gp = F.in[15] + l * DM;
    f32x4 g[2][2];
#pragma unroll
    for (int j = 0; j < 2; ++j) { g[j][0] = *(const f32x4*)(gp + 8 * F.lane + 512 * j); g[j][1] = *(const f32x4*)(gp + 8 * F.lane + 512 * j + 4); }
    constexpr int R = 4;
    for (int m0 = F.gw * R; m0 < M; m0 += F.NGW * R) {
        v4u xw[R][2], tw[R][2]; f32x4 sq[R][4];
#pragma unroll
        for (int r = 0; r < R; ++r) { const size_t m = (size_t)(m0 + r);
#pragma unroll
            for (int j = 0; j < 2; ++j) { xw[r][j] = *(const GAS v4u*)(XB + m * DM + 8 * F.lane + 512 * j); tw[r][j] = *(const GAS v4u*)(T + m * DM + 8 * F.lane + 512 * j); }
#pragma unroll
            for (int q = 0; q < 4; ++q) sq[r][q] = *(const f32x4*)(SS + m * 16 + 4 * q); }
#pragma unroll
        for (int r = 0; r < R; ++r) { const size_t m = (size_t)(m0 + r);
            const float ss = (((sq[r][0][0] + sq[r][0][1]) + (sq[r][0][2] + sq[r][0][3])) + ((sq[r][1][0] + sq[r][1][1]) + (sq[r][1][2] + sq[r][1][3]))) + (((sq[r][2][0] + sq[r][2][1]) + (sq[r][2][2] + sq[r][2][3])) + ((sq[r][3][0] + sq[r][3][1]) + (sq[r][3][2] + sq[r][3][3])));
            const float rstd = 1.0f / sqrtf(ss * (1.0f / 1024.0f) + NORM_EPS);
            f32x4 v[2][2]; float s2 = 0.f;
#pragma unroll
            for (int j = 0; j < 2; ++j) {
                const f32x4 xa = (f32x4){pg8::bf_lo(xw[r][j].x), pg8::bf_hi(xw[r][j].x), pg8::bf_lo(xw[r][j].y), pg8::bf_hi(xw[r][j].y)}, xb = (f32x4){pg8::bf_lo(xw[r][j].z), pg8::bf_hi(xw[r][j].z), pg8::bf_lo(xw[r][j].w), pg8::bf_hi(xw[r][j].w)};
                const f32x4 ta = (f32x4){pg8::bf_lo(tw[r][j].x), pg8::bf_hi(tw[r][j].x), pg8::bf_lo(tw[r][j].y), pg8::bf_hi(tw[r][j].y)}, tb = (f32x4){pg8::bf_lo(tw[r][j].z), pg8::bf_hi(tw[r][j].z), pg8::bf_lo(tw[r][j].w), pg8::bf_hi(tw[r][j].w)};
                v[j][0] = xa + ta * rstd * g[j][0]; v[j][1] = xb + tb * rstd * g[j][1];
#pragma unroll
                for (int h = 0; h < 2; ++h) s2 += (v[j][h][0] * v[j][h][0] + v[j][h][1] * v[j][h][1]) + (v[j][h][2] * v[j][h][2] + v[j][h][3] * v[j][h][3]); }
            if (l + 1 < DEPTH) {
                const float rn = 1.0f / sqrtf(wave_sum(s2) * (1.0f / 1024.0f) + NORM_EPS);
                if (F.lane == 0) RS[m] = rn;
#pragma unroll
                for (int j = 0; j < 2; ++j) { v4u o; o.x = pk2(v[j][0][0], v[j][0][1]); o.y = pk2(v[j][0][2], v[j][0][3]); o.z = pk2(v[j][1][0], v[j][1][1]); o.w = pk2(v[j][1][2], v[j][1][3]);
                    *(GAS v4u*)(XB + m * DM + 8 * F.lane + 512 * j) = o; }
            } else {
#pragma unroll
                for (int j = 0; j < 2; ++j) { *(f32x4*)(F.out + m * DM + 8 * F.lane + 512 * j) = v[j][0]; *(f32x4*)(F.out + m * DM + 8 * F.lane + 512 * j + 4) = v[j][1]; }
            }
        }
    }
}


#if defined(DBG_SEL)
#ifndef DBG_LAYER
#define DBG_LAYER 0
#endif
#ifndef DBG_AMP
#define DBG_AMP 4.0f
#endif
constexpr int CW_DBG = 12288;
__device__ __forceinline__ float blk_sum(float v, LAS float* red, int tid) {
    v = wave_sum(v);
    __syncthreads();
    if ((tid & 63) == 0) red[tid >> 6] = v;
    __syncthreads();
    float s = 0.f;
#pragma unroll
    for (int i = 0; i < 8; ++i) s += red[i];
    __syncthreads();
    return s;
}
__device__ __forceinline__ float blk_max(float v, LAS float* red, int tid) {
#pragma unroll
    for (int o = 1; o < 64; o <<= 1) v = fmaxf(v, __shfl_xor(v, o));
    __syncthreads();
    if ((tid & 63) == 0) red[tid >> 6] = v;
    __syncthreads();
    float s = red[0];
#pragma unroll
    for (int i = 1; i < 8; ++i) s = fmaxf(s, red[i]);
    __syncthreads();
    return s;
}
__device__ __forceinline__ float bfv(const bf16* p) { return __uint_as_float(((unsigned)*p) << 16); }
__device__ __forceinline__ int dbg_bucket(int dist) { const int n = dist > 0 ? dist : 0; if (n < 16) return n; int b = 16 + (int)(log((double)n / 16.0) / log(64.0) * 16.0 + 1e-9); return b > 31 ? 31 : b; }
__device__ __forceinline__ void dbg_report(Frame& F, float num, float den, int tid) {
    if (tid == 0) { float e = sqrtf(num) / fmaxf(sqrtf(den), 1e-20f); if (!(e == e)) e = 100.f; atomicMax((unsigned*)(F.ctl + CW_DBG), __float_as_uint(e)); }
}
__device__ __forceinline__ void dbg_task(Frame& F, int l, int mixer, int b, int t, int h) {
    const int tid = threadIdx.x;
    const bf16* U = (const bf16*)(F.ws + WS_U); const bf16* Y = (const bf16*)(F.ws + WS_HNY);
    LAS float* sc = (LAS float*)F.lds;
    LAS float* aux = sc + 4096;
    LAS float* qv = aux + 4096;
    LAS float* vec = qv + 128;
    LAS float* red = vec + 256;
    LAS int* sel = (LAS int*)(red + 16);
    const size_t row = (size_t)b * SEQ + t; const size_t rb = (size_t)b * SEQ;
    float yn = 0.f, ycmp = 0.f; int ycol = 0;
    __syncthreads();
    if (mixer == 0) {
        const float* guq = F.in[3] + l * 192; const float* wuq = F.in[4] + (size_t)l * 192 * 384;
        const float* gkv = F.in[5] + l * 128; const float* wukv = F.in[6] + (size_t)l * 128 * 512;
        float ssq = 0.f;
        for (int r = 0; r < 192; ++r) { const float c = bfv(U + row * NU + r); ssq += c * c; }
        const float rq = 1.0f / sqrtf(ssq / 192.0f + NORM_EPS);
        if (tid < 96) { float a = 0.f; for (int r = 0; r < 192; ++r) a += bfv(U + row * NU + r) * rq * guq[r] * wuq[r * 384 + h * 96 + tid]; qv[tid] = a; }
        __syncthreads();
        if (tid < 16) { const float fr = powf(10000.0f, -(float)tid / 16.0f), ang = (float)t * fr, c = cosf(ang), s = sinf(ang); const float x1 = qv[64 + tid], x2 = qv[80 + tid]; qv[64 + tid] = x1 * c - x2 * s; qv[80 + tid] = x1 * s + x2 * c; }
        __syncthreads();
        if (tid < 128) { float a = 0.f; for (int d = 0; d < 64; ++d) a += wukv[tid * 512 + h * 128 + d] * qv[d]; vec[tid] = a * gkv[tid]; }
        __syncthreads();
        const float scale = 0.10206207261596575f;
        for (int s = tid; s <= t; s += NTHREADS) {
            const bf16* ur = U + (rb + s) * NU + 256;
            float ss = 0.f, dn = 0.f;
            for (int r = 0; r < 128; ++r) { const float c = bfv(ur + r); ss += c * c; dn += c * vec[r]; }
            const float rk = 1.0f / sqrtf(ss / 128.0f + NORM_EPS);
            aux[s] = rk;
            float dr = 0.f;
            for (int i = 0; i < 16; ++i) {
                const int f = i >> 2, jj = i & 3; const float x1 = bfv(ur + 128 + 8 * f + jj), x2 = bfv(ur + 128 + 8 * f + 4 + jj);
                const float fr = powf(10000.0f, -(float)i / 16.0f), ang = (float)s * fr, c = cosf(ang), sn = sinf(ang);
                dr += (x1 * c - x2 * sn) * qv[64 + i] + (x1 * sn + x2 * c) * qv[80 + i]; }
            sc[s] = (dn * rk + dr) * scale;
        }
        __syncthreads();
        float mx = -INFINITY; for (int s = tid; s <= t; s += NTHREADS) mx = fmaxf(mx, sc[s]);
        mx = blk_max(mx, red, tid);
        float sm = 0.f; for (int s = tid; s <= t; s += NTHREADS) { const float p = expf(sc[s] - mx); sc[s] = p; sm += p; }
        sm = blk_sum(sm, red, tid);
        { const int r = tid & 127, q4 = tid >> 7; float a = 0.f;
          for (int s = q4; s <= t; s += 4) a += sc[s] * bfv(U + (rb + s) * NU + 256 + r) * aux[s];
          __syncthreads(); ((LAS float*)F.lds)[8192 + 512 + tid] = a; __syncthreads();
          if (tid < 128) vec[128 + tid] = (((LAS float*)F.lds)[8192 + 512 + tid] + ((LAS float*)F.lds)[8192 + 512 + 128 + tid] + ((LAS float*)F.lds)[8192 + 512 + 256 + tid] + ((LAS float*)F.lds)[8192 + 512 + 384 + tid]) * gkv[tid] / sm; }
        __syncthreads();
        if (tid < 64) { float o = 0.f; for (int r = 0; r < 128; ++r) o += vec[128 + r] * wukv[r * 512 + h * 128 + 64 + tid]; yn = o; }
        ycol = h * 64;
    } else if (mixer == 1) {
        const bf16* qp = U + row * NU + 512 + h * 64;
        if (tid < 64) qv[tid] = bfv(qp + tid) / LOG2E;
        __syncthreads();
        for (int s = tid; s < t; s += NTHREADS) { const bf16* kp = U + (rb + s) * NU + 768 + h * 64; float z = 0.f; for (int d = 0; d < 64; ++d) z += qv[d] * bfv(kp + d);
            const float sp = fmaxf(z, 0.f) + log1pf(expf(-fabsf(z)));
            sc[s] = z - sp;
            aux[s] = -sp; }
        __syncthreads();
        if (tid == 0) { float run = 0.f; for (int s = t - 1; s >= 0; --s) { const float a = expf(sc[s] + run); run += aux[s]; sc[s] = a; } }
        __syncthreads();
        if (tid < 64) { float o = 0.f; for (int s = 0; s < t; ++s) { const float a = sc[s]; if (a != 0.f) o += a * bfv(U + (rb + s) * NU + 1024 + h * 64 + tid); } yn = o; }
        ycol = 256 + h * 64;
    } else {
        const bf16* qp = U + row * NU + 1280 + h * 64;
        if (tid < 64) qv[tid] = bfv(qp + tid) / LOG2E;
        __syncthreads();
        const int own = t >> 8;
        { const int j = tid >> 5, dg = tid & 31; float g = 0.f;
          if (j < own) { float m0 = 0.f, m1 = 0.f; for (int s = 0; s < 256; ++s) { const bf16* kp = U + (rb + j * 256 + s) * NU + 1536 + h * 64 + 2 * dg; m0 += bfv(kp); m1 += bfv(kp + 1); }
              g = (m0 * qv[2 * dg] + m1 * qv[2 * dg + 1]) * (1.0f / 256.0f); }
#pragma unroll
          for (int o = 1; o < 32; o <<= 1) g += __shfl_xor(g, o);
          if (dg == 0) vec[j] = (j < own) ? g : -INFINITY; }
        __syncthreads();
        if (tid == 0) { float v1 = -INFINITY, v2 = -INFINITY, v3 = -INFINITY; int i1 = -1, i2 = -1, i3 = -1;
            for (int j = 0; j < own; ++j) { const float g = vec[j];
                if (g > v1) { v3 = v2; i3 = i2; v2 = v1; i2 = i1; v1 = g; i1 = j; } else if (g > v2) { v3 = v2; i3 = i2; v2 = g; i2 = j; } else if (g > v3) { v3 = g; i3 = j; } }
            sel[0] = i1; sel[1] = i2; sel[2] = i3; }
        __syncthreads();
        const int s0 = sel[0], s1 = sel[1], s2 = sel[2];
        const float* rb_ = F.in[7];
        for (int s = tid; s <= t; s += NTHREADS) { const int blk = s >> 8; const bool ok = (blk == own) || blk == s0 || blk == s1 || blk == s2;
            float z = -INFINITY;
            if (ok) { const bf16* kp = U + (rb + s) * NU + 1536 + h * 64; z = 0.f; for (int d = 0; d < 64; ++d) z += qv[d] * bfv(kp + d); z += rb_[dbg_bucket(t - s) * 4 + h]; }
            sc[s] = z; }
        __syncthreads();
        float mx = -INFINITY; for (int s = tid; s <= t; s += NTHREADS) mx = fmaxf(mx, sc[s]);
        mx = blk_max(mx, red, tid);
        float sm = 0.f; for (int s = tid; s <= t; s += NTHREADS) { const float p = expf(sc[s] - mx); sc[s] = p; sm += p; }
        sm = blk_sum(sm, red, tid);
        if (tid < 64) { float o = 0.f; for (int s = 0; s <= t; ++s) { const float p = sc[s]; if (p != 0.f) o += p * bfv(U + (rb + s) * NU + 1792 + h * 64 + tid); } yn = o / sm; }
        ycol = 512 + h * 64;
    }
    float num = 0.f, den = 0.f;
    if (tid < 64) { const float g = bfv(U + row * NU + 2560 + ycol + tid); yn *= g / (1.0f + expf(-g)); ycmp = bfv(Y + row * DM + ycol + tid); num = (ycmp - yn) * (ycmp - yn); den = yn * yn; }
    num = blk_sum(num, red, tid); den = blk_sum(den, red, tid);
    dbg_report(F, num, den, tid);
    __syncthreads();
}
__device__ __forceinline__ void dbg_check(Frame& F, int l) {
    constexpr int ts[24] = {0, 1, 2, 5, 17, 31, 32, 33, 63, 64, 100, 255, 256, 257, 300, 511, 512, 1000, 1023, 1024, 2047, 2048, 3000, 4095};
    for (int task = blockIdx.x; task < 576; task += F.G) {
        const int h = task & 3, ti = (task >> 2) % 24, bb = (task / 96) & 1, mixer = task / 192;
        if (!((DBG_SEL >> mixer) & 1)) continue;
        int t = 0;
#pragma unroll
        for (int i = 0; i < 24; ++i) if (i == ti) t = ts[i];
        dbg_task(F, l, mixer, bb ? 7 : 0, t, h);
    }
}
__device__ __forceinline__ void dbg_check_u(Frame& F, int l) {
    if (blockIdx.x != 0) return;
    const bf16* U = (const bf16*)(F.ws + WS_U); const bf16* HN = (const bf16*)(F.ws + WS_XB); const float* W = F.in[2] + (size_t)l * DM * D_IN;
    const int tid = threadIdx.x;
    const int rsel = tid >> 7, cs = tid & 127;
    const size_t row = rsel == 0 ? 0 : rsel == 1 ? 4097 : rsel == 2 ? 20000 : 32767;
    int ucol, src;
    if (cs < 32) { ucol = 256 + 128 + cs; src = 320 + ropemap(cs); }
    else if (cs < 64) { const int c = 6 * (cs - 32); ucol = c; src = c; }
    else if (cs < 96) { const int c = 4 * (cs - 64); ucol = 256 + c; src = 192 + c; }
    else { const int k = cs - 96; const int tile = 2 + (k % 12), c = (k * 37) & 255; ucol = tile * 256 + c; src = 352 + (tile - 2) * 256 + c; }
    float a = 0.f;
    for (int k = 0; k < DM; ++k) a += bfv(HN + row * DM + k) * F.in[1][l * DM + k] * W[(size_t)k * D_IN + src];
    a *= ((const float*)(F.ws + WS_RSTD))[row];
    if (ucol >= 512 && ucol < 768) a *= QSCALE_64;
    if (ucol >= 1280 && ucol < 1536) a *= QSCALE_64;
    const float u = bfv(U + row * NU + ucol);
    float e = fabsf(u - a) / (fabsf(a) + 0.05f); if (!(e == e)) e = 100.f;
    atomicMax((unsigned*)(F.ctl + CW_DBG), __float_as_uint(e));
}
#endif
struct Args { const float* in[16]; float* out; unsigned char* ws; int mode, pad; };
__global__ void __launch_bounds__(NTHREADS, 2) hymba_fwd(Args args) {
    extern __shared__ __attribute__((aligned(16))) unsigned char lds[];
    Frame F;
    F.lds = (LAS unsigned char*)lds;
    F.MISC = (volatile LAS unsigned*)(F.lds + MISC_OFF);
    F.tid = threadIdx.x; F.lane = F.tid & 63; F.wave = __builtin_amdgcn_readfirstlane(F.tid >> 6);
    F.G = gridDim.x; F.gw = blockIdx.x * NWAVES + F.wave; F.NGW = F.G * NWAVES;
#pragma unroll
    for (int i = 0; i < 16; ++i) F.in[i] = args.in[i];
    F.out = args.out; F.ws = args.ws; F.ctl = (gu32*)(args.ws + WS_CTL);
#if defined(ZERO_ALL_LDS)
    for (int u = F.tid; u < LDS_BYTES / 4; u += NTHREADS) ((LAS unsigned*)(F.lds))[u] = 0u;
#endif
    for (int u = F.tid; u < (LDS_BYTES - LDSCTL_OFF) / 4; u += NTHREADS) ((LAS unsigned*)(F.lds + LDSCTL_OFF))[u] = 0u;
    __syncthreads();
    { const unsigned simd = (unsigned)__builtin_amdgcn_s_getreg((1 << 11) | (4 << 6) | 4) & 3u; if (F.lane == 0) F.MISC[32 + F.wave] = simd; }
    __syncthreads();
    int whalf = 0;
    { const unsigned me = F.MISC[32 + F.wave]; int rank = 0;
#pragma unroll
      for (int j = 0; j < NWAVES; ++j) rank += (j < F.wave && F.MISC[32 + j] == me) ? 1 : 0;
#if defined(ANTI_HALF)
      whalf = __builtin_amdgcn_readfirstlane((int)(me & 1u)); }
#else
      whalf = __builtin_amdgcn_readfirstlane(rank & 1); }
#endif
    XcdBarrier bar = xcd_barrier_post((unsigned*)(F.ctl + CW_BAR), F.MISC + 8);
    const unsigned lds0 = (unsigned)(uintptr_t)lds;
#ifndef DUP_PHASE
#define DUP_PHASE 0
#endif
#if DUP_PHASE
#define DUP_BEGIN(k) _Pragma("nounroll") for (int rep_ = 0; rep_ < ((DUP_PHASE == (k)) ? 2 : 1); ++rep_) { if (rep_) GRID_BAR();
#define DUP_END(k) }
#define DUP_REP rep_
#else
#define DUP_BEGIN(k) { const int rep_ = 0; (void)rep_;
#define DUP_END(k) }
#define DUP_REP 0
#endif
#define GRID_BAR() do { XcdBarrier b_ = bar; asm volatile("" : "+s"(b_.x)); xcd_barrier(b_); } while (0)

#define PHASE_PTRS() unsigned char* ws_ = F.ws; asm volatile("" : "+s"(ws_)); \
    bf16* const HNY = (bf16*)(ws_ + WS_HNY); bf16* const UB = (bf16*)(ws_ + WS_U); \
    float* const SSQQ = (float*)(ws_ + WS_SSQQ); float* const SSQKV = (float*)(ws_ + WS_SSQKV); float* const SSQO = (float*)(ws_ + WS_SSQO); \
    bf16* const KRB = (bf16*)(ws_ + WS_KR); bf16* const QAB = (bf16*)(ws_ + WS_QA); bf16* const KVAB = (bf16*)(ws_ + WS_KVA); bf16* const CHB = (bf16*)(ws_ + WS_CONVH); \
    const float* const cosT = (const float*)(ws_ + WS_ROPE); const float* const sinT = cosT + SEQ * 16; \
    (void)HNY; (void)UB; (void)SSQQ; (void)SSQKV; (void)SSQO; (void)KRB; (void)QAB; (void)KVAB; (void)CHB; (void)cosT; (void)sinT

#if PH_EN(0)
    p_prologue(F);
#if DUP_PHASE == 9
    GRID_BAR(); p_prologue(F);
#endif
#endif
    GRID_BAR();

    for (int l = 0; l < DEPTH; ++l) {
#if PH_EN(1)
        DUP_BEGIN(1)
        {
            PHASE_PTRS();
            pg8::Gemm g{(const bf16*)(ws_ + WS_XB), (const bf16*)(ws_ + WS_WIN) + (size_t)l * NU * DM, M, NU, DM, DM}; pg8::StaticOrder S; S.init(M, NU, F.G, (int)blockIdx.x);
            pg8::EpiIn E{UB, SSQQ, SSQKV, KRB, cosT, sinT, QSCALE_64, (const float*)(ws_ + WS_RSTD)};
            pg8::gemm_phase<pg8::EpiIn, pg8::StaticOrder, true, true>(F.lds + RING_OFF, g, S, E);
        }
        DUP_END(1)
#endif
        GRID_BAR();
        if (args.mode == 2) return;
        DUP_BEGIN(2)
#if PH_EN(2)
        {
            PHASE_PTRS();
            pg8::Gemm g{UB, (const bf16*)(ws_ + WS_WQ2) + (size_t)l * 512 * 256, M, 512, 256, NU}; pg8::StaticOrder S; S.init(M, 512, F.G, (int)blockIdx.x);
            pg8::EpiQ E{QAB, SSQQ, cosT, sinT, QSCALE_96, NORM_EPS};
            pg8::gemm_phase<pg8::EpiQ, pg8::StaticOrder, true, true>(F.lds + RING_OFF, g, S, E);
        }
        __syncthreads();
#endif
#if PH_EN(8)
        {
            PHASE_PTRS();
            pg8::Gemm g{UB + 256, (const bf16*)(ws_ + WS_WKV2) + (size_t)l * 512 * 256, M, 512, 256, NU}; pg8::StaticOrder S; S.init(M, 512, F.G, (int)blockIdx.x);
            pg8::EpiKV E{KVAB, SSQKV, NORM_EPS};
            pg8::gemm_phase<pg8::EpiKV, pg8::StaticOrder, true, true>(F.lds + RING_OFF, g, S, E);
        }
        __syncthreads();
#endif
#if PH_EN(3)
        for (int u = blockIdx.x; u < M / 64; u += F.G) conv_unit(F, l, u);
        for (int it = blockIdx.x; it < BATCH * 16; it += F.G) kmean_unit(F, it);
#endif
        DUP_END(2)
        GRID_BAR();
        DUP_BEGIN(3)
#if PH_EN(4)
        {
            PHASE_PTRS();
            pg8::Gemm g{CHB, (const bf16*)(ws_ + WS_WPW) + (size_t)l * 256 * 256, M, 256, 256, 256}; pg8::StaticOrder S; S.init(M, 256, F.G, (int)blockIdx.x);
            pg8::EpiPW E{HNY, UB, F.in[13] + l * 256};
            pg8::gemm_phase<pg8::EpiPW, pg8::StaticOrder, true, true>(F.lds + RING_OFF, g, S, E);
        }
        __syncthreads();
#endif
#if PH_EN(5)
        {
            PHASE_PTRS();
            const att::Tensors AT{UB, QAB, KVAB, KRB, HNY, (const float*)(ws_ + WS_BT), (const float*)(ws_ + WS_KMEAN), 1024, 0};
            const int x0 = (int)(xb_xcc_id() & 7u);
            int xq = 0;
            gu32* qctr = F.ctl + CW_QUEUE + (l * 8 + x0) * 64 + 16 * DUP_REP;
            for (;;) {
                if (F.tid == 0) F.MISC[16] = __hip_atomic_fetch_add(qctr, 1u, RLX_AGENT);
                __syncthreads();
                const int idx = (int)F.MISC[16];
                if (idx >= 192) { __syncthreads(); if (++xq == 8) break; qctr = F.ctl + CW_QUEUE + (l * 8 + ((x0 + xq) & 7)) * 64 + 16 * DUP_REP; continue; }
                const int xcur = (x0 + xq) & 7;
                int type, qb, bh;
                if (idx < 128) { const int g = idx >> 5, j = idx & 31; type = (j < 16) ? 0 : 2; qb = 15 - (j & 15); bh = xcur * 4 + g; }
                else { const int s = idx - 128; type = 1; qb = 15 - (s & 15); bh = xcur * 4 + (s >> 4); }
                const int b = bh >> 2, h = bh & 3;
#if defined(DUP_TYPE)
                if (DUP_REP == 1 && type != DUP_TYPE) { __syncthreads(); continue; }
#endif
#if defined(CMP_TUNED)
                if (DUP_REP == 1) { if (type == 2 && l == 0) { att::Tensors A2 = AT; A2.Y = QAB; A2.ypitch = 256; A2.ysub = 512; att::moba_unit_tuned(A2, b, h, qb, (LAS char*)(F.lds + RING_OFF), lds0 + RING_OFF); } else __syncthreads(); continue; }
#endif
#if defined(DUP_KNOB)
                if (DUP_REP == 1) { att::attn_unit<DUP_TYPE, DUP_KNOB>(AT, b, h, qb, (LAS char*)(F.lds + RING_OFF), lds0 + RING_OFF, whalf); continue; }
#endif
#if defined(TUNED_MLA)
                if (type == 0) att::mla_unit_tuned(AT, b, h, qb, (LAS char*)(F.lds + RING_OFF), lds0 + RING_OFF);
#else
                if (type == 0) att::attn_unit<0>(AT, b, h, qb, (LAS char*)(F.lds + RING_OFF), lds0 + RING_OFF, whalf);
#endif
#if !defined(TUNED_MOBA)
                else if (type == 2) att::attn_unit<2>(AT, b, h, qb, (LAS char*)(F.lds + RING_OFF), lds0 + RING_OFF, whalf);
#else
#if defined(TUNED_QB_LO)
                else if (type == 2 && qb >= TUNED_QB_LO && qb <= TUNED_QB_HI) att::moba_unit_tuned(AT, b, h, qb, (LAS char*)(F.lds + RING_OFF), lds0 + RING_OFF);
                else if (type == 2) att::attn_unit<2>(AT, b, h, qb, (LAS char*)(F.lds + RING_OFF), lds0 + RING_OFF, whalf);
#else
                else if (type == 2) att::moba_unit_tuned(AT, b, h, qb, (LAS char*)(F.lds + RING_OFF), lds0 + RING_OFF);
#endif
#endif
#if defined(SB_RES)
                else att::sb_unit_res(AT, b, h, qb, (LAS char*)(F.lds + RING_OFF), lds0 + RING_OFF, (LAS unsigned*)(F.MISC + 48));
#else
                else att::attn_unit<1>(AT, b, h, qb, (LAS char*)(F.lds + RING_OFF), lds0 + RING_OFF, whalf);
#endif
            }
        }
#endif
        DUP_END(3)
        GRID_BAR();
#if defined(CMP_TUNED)
        if (l == 0) {
            PHASE_PTRS();
            float best = 0.f;
            int t_ = threadIdx.x; asm volatile("" : "+v"(t_)); const int lane_ = t_ & 63; const int gw_ = blockIdx.x * NWAVES + __builtin_amdgcn_readfirstlane(t_ >> 6);
            for (int m = gw_; m < M; m += F.NGW) {
                float num = 0.f, den = 0.f;
#pragma unroll
                for (int j = 0; j < 4; ++j) { const float ya = __uint_as_float(((unsigned)HNY[(size_t)m * 1024 + 512 + lane_ * 4 + j]) << 16), yb = __uint_as_float(((unsigned)QAB[(size_t)m * 256 + lane_ * 4 + j]) << 16);
                    num += (ya - yb) * (ya - yb); den += ya * ya; }
#pragma unroll
                for (int o = 1; o < 16; o <<= 1) { num += __shfl_xor(num, o); den += __shfl_xor(den, o); }
                float e = sqrtf(num) / (sqrtf(den) + 1e-4f); if (!(e == e)) e = 1000.f;
#if CMP_TUNED == 2
                e = (e > 0.05f) ? (float)(1 + (m & 4095)) : 0.f;
#endif
                best = fmaxf(best, e);
            }
#pragma unroll
            for (int o = 1; o < 64; o <<= 1) best = fmaxf(best, __shfl_xor(best, o));
            if (lane_ == 0) atomicMax((unsigned*)(F.ctl + 12290), __float_as_uint(best));
        }
#endif
        if (args.mode == 1) return;
#if PH_EN(6)
        DUP_BEGIN(4)
        {
            PHASE_PTRS();
            pg8::Gemm g{HNY, (const bf16*)(ws_ + WS_WOUT) + (size_t)l * DM * DM, M, DM, DM, DM}; pg8::StaticOrder S; S.init(M, DM, F.G, (int)blockIdx.x);
            pg8::EpiOut E{UB, SSQO};
            pg8::gemm_phase<pg8::EpiOut, pg8::StaticOrder, true, true>(F.lds + RING_OFF, g, S, E);
        }
        DUP_END(4)
#endif
        GRID_BAR();
#if PH_EN(7)
        p_residual(F, l);
#if DUP_PHASE == 5
        if (l == 0) { GRID_BAR(); p_residual(F, l); }
#endif
#if DUP_PHASE == 6
        GRID_BAR(); GRID_BAR(); GRID_BAR(); GRID_BAR();
#endif
#endif
        if (l + 1 < DEPTH) GRID_BAR();
    }
#if defined(CMP_TUNED)
    GRID_BAR();
    { const float e = __uint_as_float(__hip_atomic_load(F.ctl + 12290, RLX_AGENT));
#if CMP_TUNED == 1
      const float sc = 1.0f + fminf(e, 3.0f);
#else
      const float sc = 1.0f + e / 4096.0f;
#endif
      for (size_t i = (size_t)blockIdx.x * NTHREADS + threadIdx.x; i < (size_t)M * DM; i += (size_t)F.G * NTHREADS) F.out[i] *= sc; }
#endif
}

#if defined(DBG_SEL)
__global__ void __launch_bounds__(NTHREADS, 1) dbg_kernel(Args args, int which) {
    extern __shared__ __attribute__((aligned(16))) unsigned char lds[];
    Frame F; F.lds = (LAS unsigned char*)lds; F.MISC = nullptr; F.tid = threadIdx.x; F.lane = F.tid & 63; F.wave = F.tid >> 6; F.G = gridDim.x; F.gw = 0; F.NGW = 0;
    for (int i = 0; i < 16; ++i) F.in[i] = args.in[i];
    F.out = args.out; F.ws = args.ws; F.ctl = (gu32*)(args.ws + WS_CTL);
    if (which == 0) dbg_check_u(F, 0);
    else if (which == 1) dbg_check(F, 0);
    else { const float e = __uint_as_float(__hip_atomic_load(F.ctl + CW_DBG, RLX_AGENT)); const float sc = 1.0f + fminf(2.0f, DBG_AMP * e);
      for (size_t i = (size_t)blockIdx.x * NTHREADS + threadIdx.x; i < (size_t)M * DM; i += (size_t)F.G * NTHREADS) F.out[i] *= sc; }
}
#endif
extern "C" void kernel_launch(void* const* d_in, const int* in_sizes, int n_in, void* d_out, int out_size, void* d_ws, size_t ws_size, hipStream_t stream) {
    static int grid = 0;
    if (grid == 0) {
        if (n_in != 16 || in_sizes[0] != M * DM || out_size != M * DM || ws_size < WS_END) { fprintf(stderr, "kernel_launch: unexpected shapes (n_in %d, in0 %d, out %d, ws %zu < %zu); nothing launched\n", n_in, n_in > 0 ? in_sizes[0] : -1, out_size, ws_size, (size_t)WS_END); grid = -1; return; }
        int dev = 0, cus = 0, per_cu = 0;
        if (hipGetDevice(&dev) != hipSuccess || hipDeviceGetAttribute(&cus, hipDeviceAttributeMultiprocessorCount, dev) != hipSuccess) { grid = -1; return; }
        if (hipFuncSetAttribute((const void*)hymba_fwd, hipFuncAttributeMaxDynamicSharedMemorySize, LDS_BYTES) != hipSuccess) { fprintf(stderr, "kernel_launch: hipFuncSetAttribute failed\n"); grid = -1; return; }
        if (hipOccupancyMaxActiveBlocksPerMultiprocessor(&per_cu, (const void*)hymba_fwd, NTHREADS, LDS_BYTES) != hipSuccess || per_cu < 1) fprintf(stderr, "kernel_launch: occupancy query reports %d\n", per_cu);
        (void)hipGetLastError();
        grid = cus;
    }
    if (grid < 0) return;
    if (hipMemsetAsync((char*)d_ws + WS_CTL, 0, CTL_ZERO_BYTES, stream) != hipSuccess) return;
    Args a{};
    for (int i = 0; i < 16; ++i) a.in[i] = (const float*)d_in[i];
    a.out = (float*)d_out; a.ws = (unsigned char*)d_ws; a.mode = 0; a.pad = 0;
#if defined(DBG_SEL)
    hipFuncSetAttribute((const void*)dbg_kernel, hipFuncAttributeMaxDynamicSharedMemorySize, LDS_BYTES);
    if ((DBG_SEL >> 3) & 1) { a.mode = 2; hipLaunchKernelGGL(hymba_fwd, dim3(grid), dim3(NTHREADS), LDS_BYTES, stream, a); hipLaunchKernelGGL(dbg_kernel, dim3(grid), dim3(NTHREADS), LDS_BYTES, stream, a, 0); hipMemsetAsync((char*)d_ws + WS_CTL, 0, 49152, stream); }
    if (DBG_SEL & 7) { a.mode = 1; hipLaunchKernelGGL(hymba_fwd, dim3(grid), dim3(NTHREADS), LDS_BYTES, stream, a); hipLaunchKernelGGL(dbg_kernel, dim3(grid), dim3(NTHREADS), LDS_BYTES, stream, a, 1); hipMemsetAsync((char*)d_ws + WS_CTL, 0, 49152, stream); }
    a.mode = 0;
    hipLaunchKernelGGL(hymba_fwd, dim3(grid), dim3(NTHREADS), LDS_BYTES, stream, a);
    hipLaunchKernelGGL(dbg_kernel, dim3(grid), dim3(NTHREADS), LDS_BYTES, stream, a, 2);
#else
    hipLaunchKernelGGL(hymba_fwd, dim3(grid), dim3(NTHREADS), LDS_BYTES, stream, a);
#endif
}
```

```cpp
#include <hip/hip_runtime.h>
#include <hip/hip_bf16.h>
#include <cstdio>
#include <cstdint>
#include <cmath>
#define TUNED_MOBA 1
#define TUNED_MLA 1
#define SB_RES 1
namespace pg8 {
#define PG8_LAS __attribute__((address_space(3)))
typedef unsigned short bf16_t;
typedef short bf16x8 __attribute__((ext_vector_type(8)));
typedef float f32x4 __attribute__((ext_vector_type(4)));
typedef unsigned u32x4 __attribute__((ext_vector_type(4)));
constexpr int BM = 256, BK = 64, HALF = 128, HTB = HALF * BK * 2  , STAGE_BYTES = 8 * HTB, NXCD = 8, WGM = 8;

__host__ __device__ __forceinline__ int lds_byte(int r, int c) { const int st = (r >> 4) * 2 + (c >> 5), rr = r & 15, cc = c & 31, ob = rr * 64 + cc * 2; return st * 1024 + (ob ^ (((ob >> 9) & 1) << 5)); }
__host__ __device__ __forceinline__ void stage_rc(int b, int& R, int& C) { const int st = b / 1024, sb = b % 1024, swz = sb ^ (((sb >> 9) & 1) << 5); R = (st >> 1) * 16 + swz / 64; C = (st & 1) * 32 + (swz % 64) / 2; }
__host__ __device__ __forceinline__ int perm32(int rho) { const int n = rho >> 4, i = rho & 15; return 8 * (i >> 2) + 4 * n + (i & 3); }

struct Unit { int pm, pn; };
struct Gemm { const bf16_t* A; const bf16_t* Bt; int M, N, K, lda; };

struct StaticOrder {
    int nM, nN, nwg, G, c;
    __host__ __device__ void init(int M, int N, int G_, int c_) { nM = M / BM; nN = N / BM; nwg = nM * nN; G = G_; c = c_; }
    __host__ __device__ bool next(int i, Unit& u) const {
        const long L = (long)i * G + c; if (L >= nwg) return false;
        int wgid = (int)L; { const int q = nwg / NXCD, r = nwg % NXCD, xcd = wgid % NXCD, off = wgid / NXCD; wgid = (xcd < r ? xcd * (q + 1) : r * (q + 1) + (xcd - r) * q) + off; }
        const int nig = WGM * nN, gid = wgid / nig, fm = gid * WGM, gsz = (nM - fm) < WGM ? (nM - fm) : WGM;
        u.pm = fm + ((wgid % nig) % gsz); u.pn = (wgid % nig) / gsz; return true;
    }
    __device__ __forceinline__ void a_ready(const Unit&) const {}
    __device__ __forceinline__ void done(const Unit&) const {}
};

__device__ __forceinline__ unsigned cvt_pk_bf16(float lo, float hi) { unsigned r; asm volatile("v_cvt_pk_bf16_f32 %0, %1, %2" : "=v"(r) : "v"(lo), "v"(hi)); return r; }
typedef float f32x2 __attribute__((ext_vector_type(2)));
__device__ __forceinline__ u32x4 pack8(f32x4 a, f32x4 b) { u32x4 w; w.x = cvt_pk_bf16(a[0], a[1]); w.y = cvt_pk_bf16(a[2], a[3]); w.z = cvt_pk_bf16(b[0], b[1]); w.w = cvt_pk_bf16(b[2], b[3]); return w; }
__device__ __forceinline__ float bf_lo(unsigned w) { return __uint_as_float(w << 16); }
__device__ __forceinline__ float bf_hi(unsigned w) { return __uint_as_float(w & 0xffff0000u); }
__device__ __forceinline__ float silu_f(float g) { return g / (1.0f + __expf(-g)); }

struct EpiIn {
    static constexpr bool PERM = true, AFTER_DRAIN = false;
    bf16_t* U; float* ssq_q; float* ssq_kv; bf16_t* KR; const float* cosT; const float* sinT; float qscale; const float* rstd;
    __device__ __forceinline__ void operator()(const f32x4 (&acc0)[2][2][4][2], const Unit& u, int wr, int wc, int fr, int fq) const {
        const int pn = u.pn;
        f32x4 acc[2][2][4][2];
#pragma unroll
        for (int ai = 0; ai < 2; ++ai)
#pragma unroll
            for (int m = 0; m < 4; ++m) { const float rs = rstd[u.pm * BM + wr * 64 + fr + ai * HALF + m * 16];
#pragma unroll
                for (int bj = 0; bj < 2; ++bj)
#pragma unroll
                    for (int n = 0; n < 2; ++n) acc[ai][bj][m][n] = acc0[ai][bj][m][n] * rs; }
        const float sc = (pn == 2 || pn == 5) ? qscale : 1.0f;
        const int row0 = u.pm * BM + wr * 64 + fr, col0 = pn * BM + wc * 32 + 8 * fq;
#pragma unroll
        for (int ai = 0; ai < 2; ++ai)
#pragma unroll
            for (int m = 0; m < 4; ++m) { bf16_t* rowp = U + (size_t)(row0 + ai * HALF + m * 16) * 3584 + col0;
#pragma unroll
                for (int bj = 0; bj < 2; ++bj) *(u32x4*)(rowp + bj * HALF) = pack8(acc[ai][bj][m][0] * sc, acc[ai][bj][m][1] * sc); }
        if (pn <= 1) {
            float* ssq = pn == 0 ? ssq_q : ssq_kv;
#pragma unroll
            for (int ai = 0; ai < 2; ++ai)
#pragma unroll
                for (int m = 0; m < 4; ++m) {
                    float s = 0.f;
#pragma unroll
                    for (int n = 0; n < 2; ++n) { const f32x4 x = acc[ai][0][m][n]; s += (x[0] * x[0] + x[1] * x[1]) + (x[2] * x[2] + x[3] * x[3]); }
                    if (pn == 0) {
#pragma unroll
                        for (int n = 0; n < 2; ++n) { const f32x4 x = acc[ai][1][m][n]; s += (x[0] * x[0] + x[1] * x[1]) + (x[2] * x[2] + x[3] * x[3]); } }
                    s += __shfl_xor(s, 16); s += __shfl_xor(s, 32);
                    if (fq == 0) ssq[(size_t)(row0 + ai * HALF + m * 16) * 4 + wc] = s;
                }
        }
        if (pn == 1 && wc == 0) {
#pragma unroll
            for (int ai = 0; ai < 2; ++ai)
#pragma unroll
                for (int m = 0; m < 4; ++m) { const int row = row0 + ai * HALF + m * 16, pos = row & 4095;
                    const f32x4 c = *(const f32x4*)(cosT + pos * 16 + 4 * fq), s = *(const f32x4*)(sinT + pos * 16 + 4 * fq);
                    const f32x4 x1 = acc[ai][1][m][0], x2 = acc[ai][1][m][1];
                    *(u32x4*)(KR + (size_t)row * 32 + 8 * fq) = pack8(x1 * c - x2 * s, x1 * s + x2 * c);
                    asm volatile("" ::: "memory"); }
        }
    }
};
struct EpiQ {
    static constexpr bool PERM = true, AFTER_DRAIN = false;
    bf16_t* QA; const float* ssq_q; const float* cosT; const float* sinT; float scale; float eps;
    __device__ __forceinline__ void operator()(const f32x4 (&acc)[2][2][4][2], const Unit& u, int wr, int wc, int fr, int fq) const {
        const int row0 = u.pm * BM + wr * 64 + fr;
#pragma unroll
        for (int ai = 0; ai < 2; ++ai)
#pragma unroll
            for (int m = 0; m < 4; ++m) { const int row = row0 + ai * HALF + m * 16;
                const f32x4 s4 = *(const f32x4*)(ssq_q + (size_t)row * 4);
                const float rs = scale / sqrtf(((s4[0] + s4[1]) + (s4[2] + s4[3])) * (1.0f / 192.0f) + eps);
                if (u.pn == 0) {
#pragma unroll
                    for (int bj = 0; bj < 2; ++bj) *(u32x4*)(QA + (size_t)row * 384 + bj * HALF + wc * 32 + 8 * fq) = pack8(acc[ai][bj][m][0] * rs, acc[ai][bj][m][1] * rs);
                } else {
                    const int pos = row & 4095;
                    const f32x4 c = *(const f32x4*)(cosT + pos * 16 + 4 * fq), s = *(const f32x4*)(sinT + pos * 16 + 4 * fq);
                    const f32x4 x1 = acc[ai][0][m][0] * rs, x2 = acc[ai][0][m][1] * rs;
                    *(u32x4*)(QA + (size_t)row * 384 + 256 + wc * 32 + 8 * fq) = pack8(x1 * c - x2 * s, x1 * s + x2 * c);
                }
                asm volatile("" ::: "memory"); }
    }
};
struct EpiKV {
    static constexpr bool PERM = true, AFTER_DRAIN = false;
    bf16_t* KVA; const float* ssq_kv; float eps;
    __device__ __forceinline__ void operator()(const f32x4 (&acc)[2][2][4][2], const Unit& u, int wr, int wc, int fr, int fq) const {
        const int row0 = u.pm * BM + wr * 64 + fr;
#pragma unroll
        for (int ai = 0; ai < 2; ++ai)
#pragma unroll
            for (int m = 0; m < 4; ++m) { const int row = row0 + ai * HALF + m * 16;
                const f32x4 s4 = *(const f32x4*)(ssq_kv + (size_t)row * 4);
                const float rs = 1.0f / sqrtf(((s4[0] + s4[1]) + (s4[2] + s4[3])) * (1.0f / 128.0f) + eps);
#pragma unroll
                for (int bj = 0; bj < 2; ++bj) *(u32x4*)(KVA + (size_t)row * 512 + u.pn * BM + bj * HALF + wc * 32 + 8 * fq) = pack8(acc[ai][bj][m][0] * rs, acc[ai][bj][m][1] * rs);
                asm volatile("" ::: "memory"); }
    }
};
struct EpiPW {
    static constexpr bool PERM = true, AFTER_DRAIN = false;
    bf16_t* Y; const bf16_t* U; const float* pwb;
    __device__ __forceinline__ void operator()(const f32x4 (&acc)[2][2][4][2], const Unit& u, int wr, int wc, int fr, int fq) const {
        const int row0 = u.pm * BM + wr * 64 + fr, c0 = wc * 32 + 8 * fq;
#pragma unroll
        for (int ai = 0; ai < 2; ++ai)
#pragma unroll
            for (int m = 0; m < 4; ++m) { const int row = row0 + ai * HALF + m * 16;
#pragma unroll
                for (int bj = 0; bj < 2; ++bj) { const int c = c0 + bj * HALF;
                    const f32x4 b0 = *(const f32x4*)(pwb + c), b1 = *(const f32x4*)(pwb + c + 4);
                    const u32x4 g = *(const u32x4*)(U + (size_t)row * 3584 + 2560 + 768 + c);
                    f32x4 v0 = acc[ai][bj][m][0] + b0, v1 = acc[ai][bj][m][1] + b1;
                    v0[0] *= silu_f(bf_lo(g.x)); v0[1] *= silu_f(bf_hi(g.x)); v0[2] *= silu_f(bf_lo(g.y)); v0[3] *= silu_f(bf_hi(g.y));
                    v1[0] *= silu_f(bf_lo(g.z)); v1[1] *= silu_f(bf_hi(g.z)); v1[2] *= silu_f(bf_lo(g.w)); v1[3] *= silu_f(bf_hi(g.w));
                    *(u32x4*)(Y + (size_t)row * 1024 + 768 + c) = pack8(v0, v1);
                    asm volatile("" ::: "memory"); } }
    }
};
struct EpiOut {
    static constexpr bool PERM = true, AFTER_DRAIN = false;
    bf16_t* T; float* ssq_o;
    __device__ __forceinline__ void operator()(const f32x4 (&acc)[2][2][4][2], const Unit& u, int wr, int wc, int fr, int fq) const {
        const int row0 = u.pm * BM + wr * 64 + fr, col0 = u.pn * BM + wc * 32 + 8 * fq;
#pragma unroll
        for (int ai = 0; ai < 2; ++ai)
#pragma unroll
            for (int m = 0; m < 4; ++m) { const int row = row0 + ai * HALF + m * 16; float s = 0.f;
#pragma unroll
                for (int bj = 0; bj < 2; ++bj) { *(u32x4*)(T + (size_t)row * 1024 + col0 + bj * HALF) = pack8(acc[ai][bj][m][0], acc[ai][bj][m][1]);
#pragma unroll
                    for (int n = 0; n < 2; ++n) { const f32x4 x = acc[ai][bj][m][n]; s += (x[0] * x[0] + x[1] * x[1]) + (x[2] * x[2] + x[3] * x[3]); } }
                s += __shfl_xor(s, 16); s += __shfl_xor(s, 32);
                if (fq == 0) ssq_o[(size_t)row * 16 + u.pn * 4 + wc] = s; }
    }
};
template <class Epi, class Sched, bool ALIGN_EPI = false, bool SP2 = false>
__device__ __forceinline__ void gemm_phase(PG8_LAS unsigned char* lds, const Gemm g, const Sched& S, const Epi& E) {
    int tid_ = threadIdx.x; asm volatile("" : "+v"(tid_));
    const int tid = tid_, wid = __builtin_amdgcn_readfirstlane(tid >> 6), lane = tid & 63, wr = wid >> 2, wc = wid & 3, fr = lane & 15, fq = lane >> 4;
    const int K = g.K, nt = K / BK;
    unsigned voffA[2], voffB[2];
#pragma unroll
    for (int i = 0; i < 2; ++i) { int R, C; stage_rc(tid * 16 + i * 8192, R, C); const int Rb = Epi::PERM ? ((R & ~31) + perm32(R & 31)) : R;
        voffA[i] = (unsigned)(R * g.lda + C) * 2u; voffB[i] = (unsigned)(Rb * K + C) * 2u; }
    const size_t kstep = (size_t)(BK * 2);
    const size_t hstepA = (size_t)HALF * g.lda * 2, hstepB = (size_t)HALF * K * 2;
    const size_t tstepA = 2 * hstepA, tstepB = 2 * hstepB;
    const unsigned ldsw = (unsigned)wid * 1024u;
    const int aoff = lds_byte(wr * 64 + fr, fq * 8), boff = lds_byte(wc * 32 + fr, fq * 8);
#define PG8_SA(b, h) (((b) * 2 + (h)) * HTB)
#define PG8_SB(b, h) ((4 + (b) * 2 + (h)) * HTB)
#define PG8_STAGE(bufoff, gbase, voff) do { _Pragma("unroll") for (int _i = 0; _i < 2; ++_i) \
        __builtin_amdgcn_global_load_lds((const unsigned*)((const char*)(gbase) + (voff)[_i]), (PG8_LAS unsigned*)(lds + (bufoff) + ldsw + _i * 8192), 16, 0, 0); } while (0)
#define PG8_LDA(dst, b, h) do { _Pragma("unroll") for (int m = 0; m < 4; ++m) _Pragma("unroll") for (int k = 0; k < 2; ++k) dst[m][k] = *(const PG8_LAS bf16x8*)(lds + PG8_SA(b, h) + aoff + m * 2048 + k * 1024); } while (0)
#define PG8_LDB(dst, b, h) do { _Pragma("unroll") for (int n = 0; n < 2; ++n) _Pragma("unroll") for (int k = 0; k < 2; ++k) dst[n][k] = *(const PG8_LAS bf16x8*)(lds + PG8_SB(b, h) + boff + n * 2048 + k * 1024); } while (0)
#define PG8_MMA(ai, bj, At, Bt) do { __builtin_amdgcn_s_setprio(1); _Pragma("unroll") for (int m = 0; m < 4; ++m) _Pragma("unroll") for (int n = 0; n < 2; ++n) _Pragma("unroll") for (int k = 0; k < 2; ++k) \
        acc[ai][bj][m][n] = __builtin_amdgcn_mfma_f32_16x16x32_bf16(Bt[n][k], At[m][k], acc[ai][bj][m][n], 0, 0, 0); __builtin_amdgcn_s_setprio(0); } while (0)
#define PG8_WAIT_V(n) asm volatile("s_waitcnt vmcnt(" #n ")" ::: "memory")
#define PG8_WAIT_L(n) asm volatile("s_waitcnt lgkmcnt(" #n ")" ::: "memory")
#define PG8_BAR __builtin_amdgcn_s_barrier()
#define PG8_SCHED __builtin_amdgcn_sched_barrier(0)
    Unit cur, nxt; int ui = 0;
    if (!S.next(0, cur)) return;
    f32x4 acc[2][2][4][2];
#pragma unroll
    for (int a = 0; a < 2; ++a)
#pragma unroll
        for (int b = 0; b < 2; ++b)
#pragma unroll
            for (int m = 0; m < 4; ++m)
#pragma unroll
                for (int n = 0; n < 2; ++n) acc[a][b][m][n] = (f32x4){0.f, 0.f, 0.f, 0.f};
    bf16x8 At[4][2], B0[2][2], B1[2][2];
    const char* cA = (const char*)g.A + (size_t)cur.pm * tstepA; const char* cB = (const char*)g.Bt + (size_t)cur.pn * tstepB;
    S.a_ready(cur);
    if constexpr (SP2) {
        PG8_STAGE(PG8_SB(0, 0), cB, voffB); PG8_STAGE(PG8_SB(0, 1), cB + hstepB, voffB); PG8_STAGE(PG8_SA(0, 0), cA, voffA); PG8_STAGE(PG8_SA(0, 1), cA + hstepA, voffA);
        if (wr == 1) PG8_BAR;
        PG8_WAIT_V(2); PG8_BAR;
        PG8_STAGE(PG8_SB(1, 0), cB + kstep, voffB); PG8_STAGE(PG8_SA(1, 0), cA + kstep, voffA); PG8_STAGE(PG8_SB(1, 1), cB + hstepB + kstep, voffB);
        PG8_WAIT_V(6); PG8_BAR;
    } else {
        PG8_STAGE(PG8_SB(0, 0), cB, voffB); PG8_STAGE(PG8_SA(0, 0), cA, voffA); PG8_STAGE(PG8_SB(0, 1), cB + hstepB, voffB); PG8_STAGE(PG8_SA(0, 1), cA + hstepA, voffA);
        if (wr == 1) PG8_BAR;
        PG8_WAIT_V(4); PG8_BAR;
        PG8_STAGE(PG8_SB(1, 0), cB + kstep, voffB); PG8_STAGE(PG8_SA(1, 0), cA + kstep, voffA); PG8_STAGE(PG8_SB(1, 1), cB + hstepB + kstep, voffB);
        PG8_WAIT_V(6); PG8_BAR;
    }
    for (;;) {
        const bool has_next = S.next(ui + 1, nxt);
        const char* nA = has_next ? (const char*)g.A + (size_t)nxt.pm * tstepA : cA; const char* nB = has_next ? (const char*)g.Bt + (size_t)nxt.pn * tstepB : cB;
#pragma nounroll
        for (int t = 0; t < nt; t += 2) {
            const bool last = (t == nt - 2);
            const char* a1 = cA + (size_t)(t + 1) * kstep;
            const char* a2 = last ? nA : cA + (size_t)(t + 2) * kstep; const char* b2 = last ? nB : cB + (size_t)(t + 2) * kstep;
            const char* a3 = a2 + kstep; const char* b3 = b2 + kstep;
            if (last && has_next) S.a_ready(nxt);
            if constexpr (SP2) {
            PG8_LDB(B0, 0, 0); PG8_LDB(B1, 0, 1); PG8_SCHED; PG8_LDA(At, 0, 0); PG8_STAGE(PG8_SA(1, 1), a1 + hstepA, voffA);
            PG8_WAIT_V(8); PG8_WAIT_L(0); PG8_BAR; PG8_MMA(0, 0, At, B0); PG8_MMA(0, 1, At, B1); PG8_BAR; PG8_SCHED;
            PG8_LDA(At, 0, 1); PG8_STAGE(PG8_SB(0, 0), b2, voffB); PG8_STAGE(PG8_SB(0, 1), b2 + hstepB, voffB); PG8_STAGE(PG8_SA(0, 0), a2, voffA);
            PG8_WAIT_V(8); PG8_WAIT_L(0); PG8_BAR; PG8_MMA(1, 0, At, B0); PG8_MMA(1, 1, At, B1); PG8_BAR; PG8_SCHED;
            PG8_LDB(B0, 1, 0); PG8_LDB(B1, 1, 1); PG8_SCHED; PG8_LDA(At, 1, 0); PG8_STAGE(PG8_SA(0, 1), a2 + hstepA, voffA);
            PG8_WAIT_V(8); PG8_WAIT_L(0); PG8_BAR; PG8_MMA(0, 0, At, B0); PG8_MMA(0, 1, At, B1); PG8_BAR; PG8_SCHED;
            PG8_LDA(At, 1, 1); PG8_STAGE(PG8_SB(1, 0), b3, voffB); PG8_STAGE(PG8_SB(1, 1), b3 + hstepB, voffB); PG8_STAGE(PG8_SA(1, 0), a3, voffA);
            PG8_WAIT_V(8); PG8_WAIT_L(0); PG8_BAR; PG8_MMA(1, 0, At, B0); PG8_MMA(1, 1, At, B1); PG8_BAR; PG8_SCHED;
            } else {
            PG8_LDB(B0, 0, 0); PG8_SCHED; PG8_LDA(At, 0, 0); PG8_STAGE(PG8_SA(1, 1), a1 + hstepA, voffA);
            PG8_WAIT_L(8); PG8_BAR; PG8_WAIT_L(0); PG8_MMA(0, 0, At, B0); PG8_BAR; PG8_SCHED;
            PG8_LDB(B1, 0, 1); PG8_STAGE(PG8_SB(0, 0), b2, voffB);
            PG8_BAR; PG8_WAIT_L(0); PG8_MMA(0, 1, At, B1); PG8_BAR;
            PG8_LDA(At, 0, 1); PG8_STAGE(PG8_SA(0, 0), a2, voffA);
            PG8_BAR; PG8_WAIT_L(0); PG8_MMA(1, 0, At, B0); PG8_BAR; PG8_SCHED;
            PG8_STAGE(PG8_SB(0, 1), b2 + hstepB, voffB);
            PG8_WAIT_V(6); PG8_BAR; PG8_MMA(1, 1, At, B1); PG8_BAR;
            PG8_LDB(B0, 1, 0); PG8_SCHED; PG8_LDA(At, 1, 0); PG8_STAGE(PG8_SA(0, 1), a2 + hstepA, voffA);
            PG8_WAIT_L(8); PG8_BAR; PG8_WAIT_L(0); PG8_MMA(0, 0, At, B0); PG8_BAR; PG8_SCHED;
            PG8_LDB(B1, 1, 1); PG8_STAGE(PG8_SB(1, 0), b3, voffB);
            PG8_BAR; PG8_WAIT_L(0); PG8_MMA(0, 1, At, B1); PG8_BAR;
            PG8_LDA(At, 1, 1); PG8_STAGE(PG8_SA(1, 0), a3, voffA);
            PG8_BAR; PG8_WAIT_L(0); PG8_MMA(1, 0, At, B0); PG8_BAR; PG8_SCHED;
            PG8_STAGE(PG8_SB(1, 1), b3 + hstepB, voffB);
            PG8_WAIT_V(6); PG8_BAR; PG8_MMA(1, 1, At, B1); PG8_BAR;
            }
        }
        if constexpr (ALIGN_EPI) { if (wr == 0) PG8_BAR; }
        if constexpr (!Epi::AFTER_DRAIN) { E(acc, cur, wr, wc, fr, fq); S.done(cur); }
        if (!has_next) break;
#pragma unroll
        for (int a = 0; a < 2; ++a)
#pragma unroll
            for (int b = 0; b < 2; ++b)
#pragma unroll
                for (int m = 0; m < 4; ++m)
#pragma unroll
                    for (int n = 0; n < 2; ++n) acc[a][b][m][n] = (f32x4){0.f, 0.f, 0.f, 0.f};
        cur = nxt; cA = nA; cB = nB; ++ui;
        if constexpr (ALIGN_EPI) { if (wr == 1) PG8_BAR; }
    }
    PG8_WAIT_V(0);
    if constexpr (!ALIGN_EPI) { if (wr == 0) PG8_BAR; }
    PG8_BAR;
    if constexpr (Epi::AFTER_DRAIN) { E.fused(acc, cur, wr, wc, fr, fq, lds, wid, lane); S.done(cur); }
#undef PG8_SA
#undef PG8_SB
#undef PG8_STAGE
#undef PG8_LDA
#undef PG8_LDB
#undef PG8_MMA
#undef PG8_WAIT_V
#undef PG8_WAIT_L
#undef PG8_BAR
#undef PG8_SCHED
}
}
namespace att {
typedef __hip_bfloat16 hbf16;
typedef short bf16x8 __attribute__((ext_vector_type(8)));
typedef short s16x4 __attribute__((ext_vector_type(4)));
typedef float f32x16 __attribute__((ext_vector_type(16)));
typedef float f32x4 __attribute__((ext_vector_type(4)));
typedef unsigned u32x4 __attribute__((ext_vector_type(4)));
typedef unsigned short bf16_t;
#define ALAS __attribute__((address_space(3)))
typedef ALAS const char* lds_cptr;
constexpr int SEQ = 4096, QB = 256, KVBLK = 64;
constexpr int SLOTK = 12288, SLOTV = 8192, NSLOT = 3;
constexpr int L_K = 0, L_V = NSLOT * SLOTK, L_WS = L_V + NSLOT * SLOTV, L_OST = L_WS + 8 * 256, L_TBL = L_OST + 8 * 4096, TBL_N = 256 + 4096, L_NINF = L_TBL + TBL_N * 4,
              L_KM = L_NINF + 256, L_FLAG = L_KM + 4096, L_END = L_FLAG + 64;
constexpr int UP = 3584;
constexpr float SB_EXIT = -64.0f;
#define ASBAR() __builtin_amdgcn_sched_barrier(0)
#define AWAIT_BAR(N) asm volatile("s_waitcnt vmcnt(" #N ") lgkmcnt(0)\n\ts_barrier" ::: "memory")
__device__ __forceinline__ int crow(int r, int hi) { return (r & 3) + 8 * (r >> 2) + 4 * hi; }
__device__ __forceinline__ void glds16(const void* gsrc, unsigned lds_dst) { unsigned keep;
    asm volatile("s_mov_b32 %0, m0\n\ts_mov_b32 m0, %2\n\ts_nop 0\n\tglobal_load_lds_dwordx4 %1, off\n\ts_mov_b32 m0, %0" : "=&s"(keep) : "v"(gsrc), "s"(lds_dst) : "memory"); }
typedef float f32x2_t __attribute__((ext_vector_type(2))); typedef __bf16 bf16x2_t __attribute__((ext_vector_type(2)));
__device__ __forceinline__ unsigned cvtpk(float lo, float hi) { f32x2_t v = {lo, hi}; bf16x2_t b = __builtin_convertvector(v, bf16x2_t); return __builtin_bit_cast(unsigned, b); }
__device__ __forceinline__ float bflo(unsigned w) { return __uint_as_float(w << 16); }
__device__ __forceinline__ float bfhi(unsigned w) { return __uint_as_float(w & 0xffff0000u); }
__device__ __forceinline__ float max3f(float a, float b, float c) { float r; asm("v_max3_f32 %0, %1, %2, %3" : "=v"(r) : "v"(a), "v"(b), "v"(c)); return r; }
__device__ __forceinline__ float rowmax32(const f32x16& p0, const f32x16& p1) {
    float a = max3f(p0[0], p0[1], p0[2]), b = max3f(p0[3], p0[4], p0[5]), c = max3f(p1[0], p1[1], p1[2]), d = max3f(p1[3], p1[4], p1[5]);
    a = max3f(a, p0[6], p0[7]); b = max3f(b, p0[8], p0[9]); c = max3f(c, p1[6], p1[7]); d = max3f(d, p1[8], p1[9]);
    a = max3f(a, p0[10], p0[11]); b = max3f(b, p0[12], p0[13]); c = max3f(c, p1[10], p1[11]); d = max3f(d, p1[12], p1[13]);
    a = max3f(a, p0[14], p0[15]); c = max3f(c, p1[14], p1[15]);
    a = max3f(a, b, c); return max3f(a, d, d);
}
__device__ __forceinline__ float swap_max(float m) { auto rr = __builtin_amdgcn_permlane32_swap(__float_as_uint(m), __float_as_uint(m), false, false); return fmaxf(__uint_as_float(rr[0]), __uint_as_float(rr[1])); }
__device__ __forceinline__ float swap_add(float m) { auto rr = __builtin_amdgcn_permlane32_swap(__float_as_uint(m), __float_as_uint(m), false, false); return __uint_as_float(rr[0]) + __uint_as_float(rr[1]); }

template <int ND> __device__ __forceinline__ void qkt(f32x16& p0, f32x16& p1, lds_cptr kslot, const bf16x8* qr, const f32x16& cinit, int r32, int hi) {
    const lds_cptr kb = kslot + hi * 1024 + r32 * 16;
    bf16x8 kf[2 * ND];
#pragma unroll
    for (int d0 = 0; d0 < ND; ++d0) { kf[2 * d0] = *(const ALAS bf16x8*)(kb + d0 * 2048); kf[2 * d0 + 1] = *(const ALAS bf16x8*)(kb + d0 * 2048 + 512); }
    ASBAR();
#pragma unroll
    for (int d0 = 0; d0 < ND; ++d0) {
        if (d0 == 0) { p0 = __builtin_amdgcn_mfma_f32_32x32x16_bf16(kf[0], qr[0], cinit, 0, 0, 0); p1 = __builtin_amdgcn_mfma_f32_32x32x16_bf16(kf[1], qr[0], cinit, 0, 0, 0); }
        else { p0 = __builtin_amdgcn_mfma_f32_32x32x16_bf16(kf[2 * d0], qr[d0], p0, 0, 0, 0); p1 = __builtin_amdgcn_mfma_f32_32x32x16_bf16(kf[2 * d0 + 1], qr[d0], p1, 0, 0, 0); }
    }
}
__device__ __forceinline__ void pv(f32x16* o, int vb, bf16x8 pa0, bf16x8 pa1, bf16x8 pa2, bf16x8 pa3) {
#pragma unroll
    for (int d0 = 0; d0 < 2; ++d0) { s16x4 lo[4], hi[4];
#pragma unroll
        for (int ks = 0; ks < 4; ++ks) {
            asm volatile("ds_read_b64_tr_b16 %0,%1 offset:%c2" : "=&v"(lo[ks]) : "v"(vb), "i"(d0 * 4096 + ks * 1024) : "memory");
            asm volatile("ds_read_b64_tr_b16 %0,%1 offset:%c2" : "=&v"(hi[ks]) : "v"(vb), "i"(d0 * 4096 + ks * 1024 + 512) : "memory"); }
        asm volatile("s_waitcnt lgkmcnt(0)" ::: "memory"); ASBAR();
#define APK(k) (bf16x8){lo[k][0], lo[k][1], lo[k][2], lo[k][3], hi[k][0], hi[k][1], hi[k][2], hi[k][3]}
        o[d0] = __builtin_amdgcn_mfma_f32_32x32x16_bf16(pa0, APK(0), o[d0], 0, 0, 0);
        o[d0] = __builtin_amdgcn_mfma_f32_32x32x16_bf16(pa1, APK(1), o[d0], 0, 0, 0);
        o[d0] = __builtin_amdgcn_mfma_f32_32x32x16_bf16(pa2, APK(2), o[d0], 0, 0, 0);
        o[d0] = __builtin_amdgcn_mfma_f32_32x32x16_bf16(pa3, APK(3), o[d0], 0, 0, 0);
#undef APK
    }
}
__device__ __forceinline__ bf16x8 pk8(const f32x16& p, int b) { u32x4 w; w.x = cvtpk(p[b], p[b + 1]); w.y = cvtpk(p[b + 2], p[b + 3]); w.z = cvtpk(p[b + 4], p[b + 5]); w.w = cvtpk(p[b + 6], p[b + 7]); return __builtin_bit_cast(bf16x8, w); }

struct Tensors { const bf16_t* U; const bf16_t* QA; const bf16_t* KVA; const bf16_t* KR; bf16_t* Y; const float* BT; const float* KMEAN; int ypitch, ysub; };

template <int TYPE, int KNOB = 0> __device__ __forceinline__ void attn_unit(const Tensors& T, int b, int h, int qb, ALAS char* shm, unsigned lds0, int half) {
    constexpr int ND = (TYPE == 0) ? 6 : 4;
    int tid_ = threadIdx.x; asm volatile("" : "+v"(tid_));
    const int tid = tid_, lane = tid & 63, r32 = lane & 31, hi = lane >> 5; const int wid = __builtin_amdgcn_readfirstlane(tid >> 6);
    const long rowbase = (long)b * SEQ; const int q0 = qb * QB;
    const int NT = (q0 + QB) / KVBLK;
    const bf16_t *Qp, *Kp, *Vp; int pitchQ, pitchK, pitchV, gcol, ycol;
    if (TYPE == 0) { Qp = T.QA + h * 64; pitchQ = 384; Kp = T.KVA + h * 64; pitchK = 512; Vp = T.KVA + 256 + h * 64; pitchV = 512; }
    else { const int base = (TYPE == 1 ? 512 : 1280) + h * 64; Qp = T.U + base; Kp = T.U + base + 256; Vp = T.U + base + 512; pitchQ = pitchK = pitchV = UP; }
    gcol = 2560 + TYPE * 256 + h * 64; ycol = TYPE * 256 + h * 64;
    ALAS float* wsf = (ALAS float*)(shm + L_WS) + wid * 64;
    const long qrow = rowbase + q0 + wid * 32 + r32;
    bf16x8 qr[ND];
#pragma unroll
    for (int d0 = 0; d0 < 4; ++d0) qr[d0] = *(const bf16x8*)(Qp + qrow * pitchQ + d0 * 16 + hi * 8);
    if (TYPE == 0) {
#pragma unroll
        for (int d0 = 4; d0 < ND; ++d0) qr[d0] = *(const bf16x8*)(T.QA + qrow * 384 + 256 + h * 32 + (d0 - 4) * 16 + hi * 8);
    }
#pragma unroll
    for (int d0 = 0; d0 < ND; ++d0) asm volatile("" : "+v"(qr[d0]));
    const bf16_t* ksrc = Kp + (rowbase + lane) * pitchK + wid * 8;
    const bf16_t* vsrc = Vp + (rowbase + 16 * (wid & 3) + (lane >> 2)) * pitchV + (wid >> 2) * 32 + (lane & 3) * 8;
    const bf16_t* krsrc = T.KR + (rowbase + lane) * 32 + (wid & 3) * 8;
    const unsigned kdst = lds0 + L_K + wid * 1024, vdst = lds0 + L_V + wid * 1024, krdst = lds0 + L_K + (8 + (wid & 3)) * 1024;
#define DMA_TILE(t, s) do { if (KNOB == 1 && dma_skip) break; glds16(ksrc + (long)(t) * KVBLK * pitchK, (unsigned)__builtin_amdgcn_readfirstlane(kdst + (s) * SLOTK)); \
        if (TYPE == 0) glds16(krsrc + (long)(t) * KVBLK * 32, (unsigned)__builtin_amdgcn_readfirstlane(krdst + (s) * SLOTK)); \
        glds16(vsrc + (long)(t) * KVBLK * pitchV, (unsigned)__builtin_amdgcn_readfirstlane(vdst + (s) * SLOTV)); } while (0)
#define TILE_WAIT(more) do { if (KNOB == 5) break; if (more) { if (TYPE == 0) AWAIT_BAR(3); else AWAIT_BAR(2); } else AWAIT_BAR(0); } while (0)
#define EVEN_BAR() do { if (KNOB != 5) asm volatile("s_waitcnt lgkmcnt(0)\n\ts_barrier" ::: "memory"); } while (0)
    bool dma_skip = false; (void)dma_skip;
    const int vb0 = (int)(lds0 + L_V) + ((lane >> 4) & 1) * 32 + (lane & 3) * 8 + (4 * hi + ((lane & 15) >> 2)) * 64;
    const lds_cptr kbase = (lds_cptr)shm + L_K;
    const int qrel = wid * 32 + r32;
    f32x16 o[2]; o[0] = f32x16{}; o[1] = f32x16{};
    f32x16 p0, p1;

    if (TYPE != 1) {
        unsigned selmask = 0u;
        ALAS const float* tbl = (ALAS const float*)(shm + L_TBL);
        ALAS const float* ninf = (ALAS const float*)(shm + L_NINF);
        if (TYPE == 2) {
            const float* bt = T.BT + (size_t)h * TBL_N;
            const int nfill = 256 + q0 + 256;
            for (int i = tid; i < nfill; i += 512) ((ALAS float*)(shm + L_TBL))[i] = bt[i];
            if (tid < 64) ((ALAS float*)(shm + L_NINF))[tid] = -INFINITY;
            for (int i = tid; i < 16 * 64; i += 512) ((ALAS float*)(shm + L_KM))[i] = T.KMEAN[((size_t)b * 16 + (i >> 6)) * 256 + h * 64 + (i & 63)];
            asm volatile("s_waitcnt vmcnt(0) lgkmcnt(0)\n\ts_barrier" ::: "memory");
            float qf[32];
#pragma unroll
            for (int d0 = 0; d0 < 4; ++d0) { const u32x4 w = __builtin_bit_cast(u32x4, qr[d0]);
                qf[d0 * 8 + 0] = bflo(w.x); qf[d0 * 8 + 1] = bfhi(w.x); qf[d0 * 8 + 2] = bflo(w.y); qf[d0 * 8 + 3] = bfhi(w.y);
                qf[d0 * 8 + 4] = bflo(w.z); qf[d0 * 8 + 5] = bfhi(w.z); qf[d0 * 8 + 6] = bflo(w.w); qf[d0 * 8 + 7] = bfhi(w.w); }
            float v1 = -INFINITY, v2 = -INFINITY, v3 = -INFINITY; int i1 = -1, i2 = -1, i3 = -1;
            for (int j = 0; j < qb; ++j) {
                ALAS const float* km = (ALAS const float*)(shm + L_KM) + j * 64 + hi * 8;
                float g = 0.f;
#pragma unroll
                for (int d0 = 0; d0 < 4; ++d0) { const f32x4 a = *(ALAS const f32x4*)(km + d0 * 16), c = *(ALAS const f32x4*)(km + d0 * 16 + 4);
                    g += qf[d0 * 8 + 0] * a[0] + qf[d0 * 8 + 1] * a[1] + qf[d0 * 8 + 2] * a[2] + qf[d0 * 8 + 3] * a[3];
                    g += qf[d0 * 8 + 4] * c[0] + qf[d0 * 8 + 5] * c[1] + qf[d0 * 8 + 6] * c[2] + qf[d0 * 8 + 7] * c[3]; }
                g = swap_add(g);
                if (g > v1) { v3 = v2; i3 = i2; v2 = v1; i2 = i1; v1 = g; i1 = j; }
                else if (g > v2) { v3 = v2; i3 = i2; v2 = g; i2 = j; }
                else if (g > v3) { v3 = g; i3 = j; }
            }
            if (i1 >= 0) selmask |= 1u << i1;
            if (i2 >= 0) selmask |= 1u << i2;
            if (i3 >= 0) selmask |= 1u << i3;
        }
        constexpr float THR = 6.0f;
        float mref = 0.f, l_run = 0.f; bool started = false;
        f32x16 negm = f32x16{};
        DMA_TILE(0, 0); DMA_TILE(1, 1); dma_skip = true;
        if (half) TILE_WAIT(true);
        int sl = 0, sl2 = 2;
        for (int t = 0; t < NT; ++t) {
            if (half == 0) TILE_WAIT(t + 1 < NT); else { EVEN_BAR(); if (t + 2 < NT) DMA_TILE(t + 2, sl2); }
            const int jb = t - (NT - 4);
            const bool wave_active = (jb < 0) || (64 * jb <= wid * 32 + 31);
            bool sel = true;
            if (TYPE == 2 && jb < 0) sel = (selmask >> (t >> 2)) & 1u;
            const bool act = wave_active && (TYPE != 2 || __any(sel));
            if (act) {
                if (KNOB == 3 || KNOB == 7) { p0 = negm; p1 = negm; asm volatile("" : "+v"(p0), "+v"(p1)); } else qkt<ND>(p0, p1, kbase + sl * SLOTK, qr, negm, r32, hi);
                if (TYPE == 2) {
                    ALAS const float* pb = sel ? tbl + (q0 + qrel - 64 * t - 4 * hi + 197) : ninf;
#pragma unroll
                    for (int r = 0; r < 16; ++r) { const int ko = (r & 3) + 8 * (r >> 2); p0[r] += pb[59 - ko]; p1[r] += pb[27 - ko]; }
                }
                if (jb >= 0) {
#pragma unroll
                    for (int r = 0; r < 16; ++r) { const int kv = 64 * jb + 4 * hi + (r & 3) + 8 * (r >> 2); if (kv > qrel) p0[r] = -INFINITY; if (kv + 32 > qrel) p1[r] = -INFINITY; }
                }
                float mx = rowmax32(p0, p1);
                mx = swap_max(mx);
                float dl = 0.f;
                if (!started) { if (mx > -INFINITY) dl = mx; } else if (mx > THR) dl = mx;
                if (__any(dl != 0.f)) {
                    const float f = started ? __builtin_amdgcn_exp2f(-dl) : 1.0f;
                    mref += dl; l_run *= f;
#pragma unroll
                    for (int r = 0; r < 16; ++r) { p0[r] -= dl; p1[r] -= dl; negm[r] = -mref; }
                    if (hi == 0) wsf[r32] = f;
                    asm volatile("s_waitcnt lgkmcnt(0)" ::: "memory");
#pragma unroll
                    for (int r = 0; r < 16; ++r) { const float g = wsf[crow(r, hi)]; o[0][r] *= g; o[1][r] *= g; }
                    asm volatile("s_waitcnt lgkmcnt(0)" ::: "memory");
                }
                if (mx > -INFINITY) started = true;
#pragma unroll
                for (int r = 0; r < 16; ++r) { if (KNOB != 2) p0[r] = __builtin_amdgcn_exp2f(p0[r]); }
            }
            if (half == 0) { EVEN_BAR(); if (t + 2 < NT) DMA_TILE(t + 2, sl2); } else TILE_WAIT(t + 2 < NT);
            if (act) {
#pragma unroll
                for (int r = 0; r < 16; ++r) { if (KNOB != 2) p1[r] = __builtin_amdgcn_exp2f(p1[r]); }
                { const f32x16 sv = p0 + p1;
                  const float s0 = (sv[0] + sv[1]) + (sv[2] + sv[3]), s1 = (sv[4] + sv[5]) + (sv[6] + sv[7]), s2 = (sv[8] + sv[9]) + (sv[10] + sv[11]), s3 = (sv[12] + sv[13]) + (sv[14] + sv[15]);
                  l_run += (s0 + s1) + (s2 + s3); }
                if (KNOB == 4 || KNOB == 7) { bf16x8 a_ = pk8(p0, 0), b_ = pk8(p0, 8), c_ = pk8(p1, 0), d_ = pk8(p1, 8); asm volatile("" :: "v"(a_), "v"(b_), "v"(c_), "v"(d_)); } else
                pv(o, vb0 + sl * SLOTV, pk8(p0, 0), pk8(p0, 8), pk8(p1, 0), pk8(p1, 8));
            }
            sl = (sl == 2) ? 0 : sl + 1; sl2 = (sl2 == 2) ? 0 : sl2 + 1;
        }
        if (half == 0) EVEN_BAR();
        l_run = swap_add(l_run);
        if (hi == 0) wsf[32 + r32] = l_run;
        asm volatile("s_waitcnt lgkmcnt(0)" ::: "memory");
#pragma unroll
        for (int r = 0; r < 16; ++r) { const float f = __builtin_amdgcn_rcpf(wsf[32 + crow(r, hi)]); o[0][r] *= f; o[1][r] *= f; }
    } else {
        bf16x8 Ta, Tb, Tones;
        { short ta[8], tb[8];
#pragma unroll
          for (int j = 0; j < 8; ++j) { const int kk = 8 * (j >> 2) + 4 * hi + (j & 3); ta[j] = (kk > r32) ? (short)0x3F80 : (short)0; tb[j] = (16 + kk > r32) ? (short)0x3F80 : (short)0; }
          Ta = (bf16x8){ta[0], ta[1], ta[2], ta[3], ta[4], ta[5], ta[6], ta[7]}; Tb = (bf16x8){tb[0], tb[1], tb[2], tb[3], tb[4], tb[5], tb[6], tb[7]};
          Tones = (bf16x8){(short)0x3F80, (short)0x3F80, (short)0x3F80, (short)0x3F80, (short)0x3F80, (short)0x3F80, (short)0x3F80, (short)0x3F80}; }
        float c = 0.f;
        ALAS unsigned* flags = (ALAS unsigned*)(shm + L_FLAG);
        DMA_TILE(NT - 1, 0); DMA_TILE(NT - 2, 1);
        if (half) TILE_WAIT(true);
        int sl = 0, sl2 = 2; bool ran_out = true;
        const f32x16 zero16 = f32x16{};
        for (int i = 0; i < NT; ++i) {
            const int t = NT - 1 - i;
            if (half == 0) {
                TILE_WAIT(i + 1 < NT);
                if (i > 0) { const ALAS unsigned* fl = flags + ((i - 1) & 1) * 8; const unsigned all = fl[0] & fl[1] & fl[2] & fl[3] & fl[4] & fl[5] & fl[6] & fl[7];
                             if (__builtin_amdgcn_readfirstlane(all) != 0u) { ran_out = false; break; } }
            } else { EVEN_BAR(); if (i + 2 < NT) DMA_TILE(t - 2, sl2); }
            const int jb = t - (NT - 4);
            const bool wave_active = (jb < 0) || (64 * jb < wid * 32 + 31);
            f32x16 D0, D1;
            if (wave_active) {
                qkt<ND>(p0, p1, kbase + sl * SLOTK, qr, zero16, r32, hi);
                f32x16 L0, L1;
#pragma unroll
                for (int r = 0; r < 16; ++r) {
                    { const float z = p0[r]; const float e = __builtin_amdgcn_exp2f(-fabsf(z)); const float sp = fmaxf(z, 0.f) + __builtin_amdgcn_logf(1.0f + e); p0[r] = z - sp; L0[r] = -sp; }
                    { const float z = p1[r]; const float e = __builtin_amdgcn_exp2f(-fabsf(z)); const float sp = fmaxf(z, 0.f) + __builtin_amdgcn_logf(1.0f + e); p1[r] = z - sp; L1[r] = -sp; }
                }
                if (jb >= 0) {
#pragma unroll
                    for (int r = 0; r < 16; ++r) { const int kv = 64 * jb + 4 * hi + (r & 3) + 8 * (r >> 2);
                        if (kv >= qrel) { p0[r] = -INFINITY; L0[r] = 0.f; } if (kv + 32 >= qrel) { p1[r] = -INFINITY; L1[r] = 0.f; } }
                }
                const bf16x8 B0 = pk8(L0, 0), B1 = pk8(L0, 8), B2 = pk8(L1, 0), B3 = pk8(L1, 8);
                f32x16 X = __builtin_amdgcn_mfma_f32_32x32x16_bf16(Tones, B2, zero16, 0, 0, 0);
                X = __builtin_amdgcn_mfma_f32_32x32x16_bf16(Tones, B3, X, 0, 0, 0);
                D0 = __builtin_amdgcn_mfma_f32_32x32x16_bf16(Ta, B0, X, 0, 0, 0);
                D0 = __builtin_amdgcn_mfma_f32_32x32x16_bf16(Tb, B1, D0, 0, 0, 0);
                D1 = __builtin_amdgcn_mfma_f32_32x32x16_bf16(Ta, B2, zero16, 0, 0, 0);
                D1 = __builtin_amdgcn_mfma_f32_32x32x16_bf16(Tb, B3, D1, 0, 0, 0);
                f32x16 TT = __builtin_amdgcn_mfma_f32_32x32x16_bf16(Tones, B0, X, 0, 0, 0);
                TT = __builtin_amdgcn_mfma_f32_32x32x16_bf16(Tones, B1, TT, 0, 0, 0);
#pragma unroll
                for (int r = 0; r < 16; ++r) { p0[r] += D0[r] + c; p1[r] += D1[r] + c; }
                c += TT[0];
            }
            { const bool done = __all(c < SB_EXIT); if (lane == 0) flags[(i & 1) * 8 + wid] = done ? 1u : 0u; }
            bool stop_after = false;
            if (half == 0) { EVEN_BAR(); if (i + 2 < NT) DMA_TILE(t - 2, sl2); }
            else { TILE_WAIT(i + 2 < NT);
                   const ALAS unsigned* fl = flags + (i & 1) * 8; const unsigned all = fl[0] & fl[1] & fl[2] & fl[3] & fl[4] & fl[5] & fl[6] & fl[7];
                   stop_after = __builtin_amdgcn_readfirstlane(all) != 0u; }
            if (wave_active) {
#pragma unroll
                for (int r = 0; r < 16; ++r) { p0[r] = __builtin_amdgcn_exp2f(p0[r]); p1[r] = __builtin_amdgcn_exp2f(p1[r]); }
                pv(o, vb0 + sl * SLOTV, pk8(p0, 0), pk8(p0, 8), pk8(p1, 0), pk8(p1, 8));
            }
            if (stop_after) { ran_out = false; break; }
            sl = (sl == 2) ? 0 : sl + 1; sl2 = (sl2 == 2) ? 0 : sl2 + 1;
        }
        if (half == 0 && ran_out) EVEN_BAR();
    }
    {
        ALAS bf16_t* stg = (ALAS bf16_t*)(shm + L_OST) + wid * 2048;
#pragma unroll
        for (int r = 0; r < 16; ++r) { const int orow = crow(r, hi);
#pragma unroll
            for (int d0 = 0; d0 < 2; ++d0) stg[orow * 64 + d0 * 32 + r32] = (bf16_t)(cvtpk(o[d0][r], 0.f) & 0xffffu); }
        asm volatile("s_waitcnt lgkmcnt(0)" ::: "memory");
#pragma unroll
        for (int i = 0; i < 4; ++i) { const int row = i * 8 + (lane >> 3), ch = lane & 7;
            const u32x4 v = *(ALAS const u32x4*)(stg + row * 64 + ch * 8);
            const long grow = rowbase + q0 + wid * 32 + row;
            const u32x4 g = *(const u32x4*)(T.U + grow * UP + gcol + ch * 8);
            float x[8] = {bflo(v.x), bfhi(v.x), bflo(v.y), bfhi(v.y), bflo(v.z), bfhi(v.z), bflo(v.w), bfhi(v.w)};
            const float gg[8] = {bflo(g.x), bfhi(g.x), bflo(g.y), bfhi(g.y), bflo(g.z), bfhi(g.z), bflo(g.w), bfhi(g.w)};
#pragma unroll
            for (int j = 0; j < 8; ++j) x[j] *= gg[j] / (1.0f + __expf(-gg[j]));
            u32x4 w; w.x = cvtpk(x[0], x[1]); w.y = cvtpk(x[2], x[3]); w.z = cvtpk(x[4], x[5]); w.w = cvtpk(x[6], x[7]);
            if (KNOB == 0) *(u32x4*)(T.Y + grow * T.ypitch + (ycol - T.ysub) + ch * 8) = w; else if (w.x == 0x12345678u && w.y == 0x9abcdef0u) *(u32x4*)(T.Y + grow * 1024 + ycol + ch * 8) = w; }
    }
    asm volatile("s_waitcnt vmcnt(0) lgkmcnt(0)\n\ts_barrier" ::: "memory");
#undef DMA_TILE
#undef TILE_WAIT
#undef EVEN_BAR
}
#undef ASBAR
#undef AWAIT_BAR
}
namespace att {
#define SBAR() __builtin_amdgcn_sched_barrier(0)
#ifdef CONSERVATIVE_BAR
#define WAIT_BAR(N) asm volatile("s_waitcnt vmcnt(0) lgkmcnt(0)\n\ts_barrier\n\ts_barrier" ::: "memory")
#else
#define WAIT_BAR(N) asm volatile("s_waitcnt vmcnt(" #N ") lgkmcnt(0)\n\ts_barrier" ::: "memory")
#endif
typedef short v4i16_t __attribute__((ext_vector_type(4)));
__device__ __forceinline__ void kload8(bf16x8* kf, lds_cptr kp) {
    kf[0] = *(const ALAS bf16x8*)(kp);        kf[1] = *(const ALAS bf16x8*)(kp + 512);
    kf[2] = *(const ALAS bf16x8*)(kp + 2048); kf[3] = *(const ALAS bf16x8*)(kp + 2560);
    kf[4] = *(const ALAS bf16x8*)(kp + 4096); kf[5] = *(const ALAS bf16x8*)(kp + 4608);
    kf[6] = *(const ALAS bf16x8*)(kp + 6144); kf[7] = *(const ALAS bf16x8*)(kp + 6656);
}
__device__ __forceinline__ void kload2(bf16x8* kf, lds_cptr kp, int j) { kf[2 * j] = *(const ALAS bf16x8*)(kp + j * 2048); kf[2 * j + 1] = *(const ALAS bf16x8*)(kp + j * 2048 + 512); }
__device__ __forceinline__ s16x4 vtr(lds_cptr p) { return __builtin_bit_cast(s16x4, __builtin_amdgcn_ds_read_tr16_b64_v4i16((ALAS v4i16_t*)p)); }
__device__ __forceinline__ void cmask(f32x16& p0, f32x16& p1, int jb, int qrel, int hi) {
    const float NEG = -INFINITY; const int kb = 64 * jb + 4 * hi;
#pragma unroll
    for (int r = 0; r < 16; ++r) { const int kv = kb + (r & 3) + 8 * (r >> 2); if (kv > qrel) p0[r] = NEG; if (kv + 32 > qrel) p1[r] = NEG; }
}

__device__ __forceinline__ float rowmax_cv(const f32x16& p0, const f32x16& p1) {
    float a = __builtin_fmaxf(__builtin_fmaxf(p0[0], p0[1]), p1[0]), b = __builtin_fmaxf(__builtin_fmaxf(p0[2], p0[3]), p1[1]); a = __builtin_fmaxf(__builtin_fmaxf(a, p1[2]), p1[3]);
#pragma unroll
    for (int r = 4; r < 16; r += 4) { a = __builtin_fmaxf(__builtin_fmaxf(a, p0[r]), p0[r + 1]); b = __builtin_fmaxf(__builtin_fmaxf(b, p0[r + 2]), p0[r + 3]); a = __builtin_fmaxf(__builtin_fmaxf(a, p1[r]), p1[r + 1]); b = __builtin_fmaxf(__builtin_fmaxf(b, p1[r + 2]), p1[r + 3]); }
    return __builtin_fmaxf(a, b);
}
#ifndef TUNED_THR
#define TUNED_THR 6.0f
#endif
__device__ __forceinline__ void moba_unit_tuned(const Tensors& T, int b, int h, int qb, ALAS char* shm, unsigned lds0) {
    int tid_ = threadIdx.x; asm volatile("" : "+v"(tid_));
    const int tid = tid_, lane = tid & 63, r32 = lane & 31, hi = lane >> 5; const int wid = __builtin_amdgcn_readfirstlane(tid >> 6);
    const long rowbase = (long)b * SEQ; const int q0 = qb * QB;
    const int NT = (q0 + QB) / KVBLK;
    const bf16_t* Qp = T.U + 1280 + h * 64; const bf16_t* Kp = T.U + 1536 + h * 64; const bf16_t* Vp = T.U + 1792 + h * 64;
    const int gcol = 2560 + 512 + h * 64, ycol = 512 + h * 64;
    ALAS float* wsf = (ALAS float*)(shm + L_WS) + wid * 64;
    const long qrow = rowbase + q0 + wid * 32 + r32;
    const bf16_t* ksrc = Kp + (rowbase + lane) * UP + wid * 8;
    const bf16_t* vsrc = Vp + (rowbase + 16 * (wid & 3) + (lane >> 2)) * UP + (wid >> 2) * 32 + (lane & 3) * 8;
    const unsigned kdst = lds0 + L_K + wid * 1024, vdst = lds0 + L_V + wid * 1024;
#define DMA_K(t, si) glds16(ksrc + (long)(t) * KVBLK * UP, (unsigned)__builtin_amdgcn_readfirstlane(kdst + (si) * SLOTK))
#define DMA_V(t, si) glds16(vsrc + (long)(t) * KVBLK * UP, (unsigned)__builtin_amdgcn_readfirstlane(vdst + (si) * SLOTV))
    const int vb0 = (int)(lds0 + L_V) + ((lane >> 4) & 1) * 32 + (lane & 3) * 8 + (4 * hi + ((lane & 15) >> 2)) * 64;
    const lds_cptr shm3 = (lds_cptr)shm; const lds_cptr kp0 = shm3 + L_K + hi * 1024 + r32 * 16;
    const lds_cptr vp0 = shm3 + L_V + ((lane >> 4) & 1) * 32 + (lane & 3) * 8 + (4 * hi + ((lane & 15) >> 2)) * 64;
    const int qrel = wid * 32 + r32;
    ALAS const float* tbl = (ALAS const float*)(shm + L_TBL);
    ALAS const float* ninf = (ALAS const float*)(shm + L_NINF);
    bf16x8 qr[4];
#pragma unroll
    for (int d0 = 0; d0 < 4; ++d0) qr[d0] = *(const bf16x8*)(Qp + qrow * UP + d0 * 16 + hi * 8);
    unsigned selmask = 0u;
    {
        const float* bt = T.BT + (size_t)h * TBL_N;
        const int nfill = (256 + q0 + 256) < 1408 ? (256 + q0 + 256) : 1408;
        for (int i = tid; i < nfill; i += 512) ((ALAS float*)(shm + L_TBL))[i] = bt[i];
        if (tid < 64) ((ALAS float*)(shm + L_NINF))[tid] = -INFINITY;
        if (tid == 64) ((ALAS float*)(shm + L_TBL))[256 + 1024] = bt[256 + 1024];
        for (int i = tid; i < 16 * 64; i += 512) ((ALAS float*)(shm + L_KM))[i] = T.KMEAN[((size_t)b * 16 + (i >> 6)) * 256 + h * 64 + (i & 63)];
        asm volatile("s_waitcnt vmcnt(0) lgkmcnt(0)\n\ts_barrier" ::: "memory");
        float qf[32];
#pragma unroll
        for (int d0 = 0; d0 < 4; ++d0) { const u32x4 w = __builtin_bit_cast(u32x4, qr[d0]);
            qf[d0 * 8 + 0] = bflo(w.x); qf[d0 * 8 + 1] = bfhi(w.x); qf[d0 * 8 + 2] = bflo(w.y); qf[d0 * 8 + 3] = bfhi(w.y);
            qf[d0 * 8 + 4] = bflo(w.z); qf[d0 * 8 + 5] = bfhi(w.z); qf[d0 * 8 + 6] = bflo(w.w); qf[d0 * 8 + 7] = bfhi(w.w); }
        float v1 = -INFINITY, v2 = -INFINITY, v3 = -INFINITY; int i1 = -1, i2 = -1, i3 = -1;
        for (int j = 0; j < qb; ++j) {
            ALAS const float* km = (ALAS const float*)(shm + L_KM) + j * 64 + hi * 8;
            float g = 0.f;
#pragma unroll
            for (int d0 = 0; d0 < 4; ++d0) { const f32x4 a = *(ALAS const f32x4*)(km + d0 * 16), c = *(ALAS const f32x4*)(km + d0 * 16 + 4);
                g += qf[d0 * 8 + 0] * a[0] + qf[d0 * 8 + 1] * a[1] + qf[d0 * 8 + 2] * a[2] + qf[d0 * 8 + 3] * a[3];
                g += qf[d0 * 8 + 4] * c[0] + qf[d0 * 8 + 5] * c[1] + qf[d0 * 8 + 6] * c[2] + qf[d0 * 8 + 7] * c[3]; }
            g = swap_add(g);
            if (g > v1) { v3 = v2; i3 = i2; v2 = v1; i2 = i1; v1 = g; i1 = j; }
            else if (g > v2) { v3 = v2; i3 = i2; v2 = g; i2 = j; }
            else if (g > v3) { v3 = g; i3 = j; }
        }
        if (i1 >= 0) selmask |= 1u << i1;
        if (i2 >= 0) selmask |= 1u << i2;
        if (i3 >= 0) selmask |= 1u << i3;
        selmask |= 1u << qb;
    }
#pragma unroll
    for (int d0 = 0; d0 < 4; ++d0) asm volatile("" : "+v"(qr[d0]));
    float c31 = tbl[256 + 1024]; asm volatile("s_waitcnt lgkmcnt(0)" : "+v"(c31) :: "memory");
    const int tfar = (q0 + 32 * wid - 853) >= 0 ? (q0 + 32 * wid - 853) / 64 : -1;
    DMA_K(0, 0); DMA_V(0, 0); DMA_K(1, 1);
    bf16x8 kf[8];
    float mhat = 0.f, l_reg = 0.f; f32x16 o[2]; o[0] = f32x16{}; o[1] = f32x16{}; f32x16 negm = f32x16{}; asm volatile("" : "+v"(negm));
    bool resc = false; bool started = false;
#if defined(NO_BIAS_PROBE)
#define BIAS(P0, P1, t) do { const bool sel_ = (selmask >> ((t) >> 2)) & 1u; const float add_ = sel_ ? 0.f : -INFINITY; _Pragma("unroll") for (int r = 0; r < 16; ++r) { P0[r] += add_; P1[r] += add_; } } while (0)
#else
#define BIAS8(P, base, r0) do { typedef float f32x8_ __attribute__((ext_vector_type(8))); f32x8_ bv_; \
        _Pragma("unroll") for (int r = 0; r < 8; ++r) { const int ko = ((r0 + r) & 3) + 8 * ((r0 + r) >> 2); bv_[r] = pb_[(base) - ko]; } \
        asm volatile("s_waitcnt lgkmcnt(0)" : "+v"(bv_) :: "memory"); \
        _Pragma("unroll") for (int r = 0; r < 8; ++r) P[r0 + r] += bv_[r]; } while (0)
#define BIAS(P0, P1, t) do { const bool sel_ = (selmask >> ((t) >> 2)) & 1u; \
        if ((t) <= tfar) { const float add_ = sel_ ? c31 : -INFINITY;          \
            _Pragma("unroll") for (int r = 0; r < 16; ++r) { P0[r] += add_; P1[r] += add_; } } \
        else { ALAS const float* pb_ = sel_ ? tbl + (q0 + qrel - 64 * (t) - 4 * hi + 197) : ninf; \
            BIAS8(P0, 59, 0); BIAS8(P0, 59, 8); BIAS8(P1, 27, 0); BIAS8(P1, 27, 8); } } while (0)
#endif
#define CMASK(P0, P1, t) do { int jb_ = (t) - (NT - 4); if (jb_ >= 0) cmask(P0, P1, jb_, qrel, hi); } while (0)
#define DECIDE(C0, C1, rm) do { resc = false; float dl = 0.f; \
        if (!started) { if (rm > -INFINITY) dl = rm; } else if (rm > TUNED_THR) dl = rm; \
        if (__builtin_expect(__any(dl != 0.f), 0)) { const float f = started ? __builtin_amdgcn_exp2f(-dl) : 1.0f; mhat += dl; \
            _Pragma("unroll") for (int r = 0; r < 16; ++r) { C0[r] -= dl; C1[r] -= dl; } \
            _Pragma("unroll") for (int r = 0; r < 16; ++r) negm[r] = -mhat; asm volatile("" : "+v"(negm)); \
            l_reg *= f; if (hi == 0) wsf[r32] = f; resc = true; } \
        if (rm > -INFINITY) started = true; } while (0)
#define RESC() do { if (resc) { asm volatile("s_waitcnt lgkmcnt(0)" ::: "memory"); \
        _Pragma("unroll") for (int d_ = 0; d_ < 2; ++d_) _Pragma("unroll") for (int r = 0; r < 16; ++r) o[d_][r] *= wsf[crow(r, hi)]; } } while (0)
    f32x16 pA0, pA1, pB0, pB1;
    int ip = 0, ic = 0, in_ = 1;
#define ROT() do { ip = ic; ic = in_; in_ = (in_ == NSLOT - 1) ? 0 : in_ + 1; } while (0)
    DMA_K(2, 2);
    WAIT_BAR(3);
    qkt<4>(pA0, pA1, shm3 + L_K, qr, negm, r32, hi);
    BIAS(pA0, pA1, 0); CMASK(pA0, pA1, 0);
    { float rm = rowmax_cv(pA0, pA1); rm = swap_max(rm); DECIDE(pA0, pA1, rm); }
#pragma unroll
    for (int r = 0; r < 16; ++r) { pA0[r] = __builtin_amdgcn_exp2f(pA0[r]); pA1[r] = __builtin_amdgcn_exp2f(pA1[r]); }
    WAIT_BAR(0);
    RESC();
    DMA_K(3, 0); DMA_V(1, 1);
    ROT();
    kload8(kf, kp0 + ic * SLOTK);
    WAIT_BAR(2);
    s16x4 vlo[8], vhi[8]; u32x4 pw0, pw1, pw2, pw3;
#define PKW(P, B) cvtpk(P[B], P[B + 1])
#define PAF(k) __builtin_bit_cast(bf16x8, pw##k)
#define VFR(i) (bf16x8){vlo[i][0], vlo[i][1], vlo[i][2], vlo[i][3], vhi[i][0], vhi[i][1], vhi[i][2], vhi[i][3]}
#define PIN(x) asm volatile("" : "+v"(x))
#define GAPA(MF, A0, A1, A2, A3, W0, W1, PW) do { MF; sacc += A0; sacc += A1; sacc += A2; sacc += A3; PIN(sacc); W0; W1; PIN(PW); SBAR(); } while (0)
#define EX(v) __builtin_amdgcn_exp2f(v)
#define GAPB(MF, X, B) do { MF; X[B] = EX(X[B]); X[B + 1] = EX(X[B + 1]); X[B + 2] = EX(X[B + 2]); X[B + 3] = EX(X[B + 3]); PIN(X); SBAR(); } while (0)
#define VRD(i) do { vlo[i] = vtr(vp_ + (((i) >> 2) * 4096 + ((i) & 3) * 1024)); vhi[i] = vtr(vp_ + (((i) >> 2) * 4096 + ((i) & 3) * 1024 + 512)); } while (0)
#define KRD(G, j) do { if (G) { kload2(kf, kp0 + in_ * SLOTK, j); SBAR(); } } while (0)
#define MFQ(c, a, b_) __builtin_amdgcn_mfma_f32_32x32x16_bf16(a, b_, c, 0, 0, 0)
#define STEP(C0, C1, P0, P1, t, GK, GV, GL) do { SBAR(); \
    const lds_cptr vp_ = vp0 + ip * SLOTV; \
    VRD(0); SBAR(); float sacc = (P0[0] + P0[1]); \
    GAPA(C0 = MFQ(negm, kf[0], qr[0]), P0[2], P0[3], P0[4], P0[5],     pw0[0] = PKW(P0, 0), pw0[1] = PKW(P0, 2), pw0); \
    VRD(4); SBAR(); GAPA(C1 = MFQ(negm, kf[1], qr[0]), P0[6], P0[7], P0[8], P0[9],     pw0[2] = PKW(P0, 4), pw0[3] = PKW(P0, 6), pw0); \
    VRD(1); SBAR(); GAPA(C0 = MFQ(C0, kf[2], qr[1]),   P0[10], P0[11], P0[12], P0[13], pw1[0] = PKW(P0, 8), pw1[1] = PKW(P0, 10), pw1); \
    VRD(5); SBAR(); GAPA(C1 = MFQ(C1, kf[3], qr[1]),   P0[14], P0[15], P1[0], P1[1],   pw1[2] = PKW(P0, 12), pw1[3] = PKW(P0, 14), pw1); \
    VRD(2); SBAR(); GAPA(C0 = MFQ(C0, kf[4], qr[2]),   P1[2], P1[3], P1[4], P1[5],     pw2[0] = PKW(P1, 0), pw2[1] = PKW(P1, 2), pw2); \
    VRD(6); SBAR(); GAPA(C1 = MFQ(C1, kf[5], qr[2]),   P1[6], P1[7], P1[8], P1[9],     pw2[2] = PKW(P1, 4), pw2[3] = PKW(P1, 6), pw2); \
    VRD(3); SBAR(); GAPA(C0 = MFQ(C0, kf[6], qr[3]),   P1[10], P1[11], P1[12], P1[13], pw3[0] = PKW(P1, 8), pw3[1] = PKW(P1, 10), pw3); \
    VRD(7); SBAR(); GAPA(C1 = MFQ(C1, kf[7], qr[3]),   P1[14], P1[15], 0.f, 0.f,       pw3[2] = PKW(P1, 12), pw3[3] = PKW(P1, 14), pw3); \
    l_reg += sacc; \
    if (GK) { DMA_K((t) + 3, ic); } if (GV) { DMA_V((t) + 1, in_); } \
    BIAS(C0, C1, t); CMASK(C0, C1, t); \
    { float rm = rowmax_cv(C0, C1); rm = swap_max(rm); DECIDE(C0, C1, rm); } \
    SBAR(); \
    GAPB(o[0] = MFQ(o[0], PAF(0), VFR(0)), C0, 0); \
    GAPB(o[1] = MFQ(o[1], PAF(0), VFR(4)), C0, 4); \
    KRD(GL, 0); GAPB(o[0] = MFQ(o[0], PAF(1), VFR(1)), C0, 8); \
    KRD(GL, 1); GAPB(o[1] = MFQ(o[1], PAF(1), VFR(5)), C0, 12); \
    KRD(GL, 2); GAPB(o[0] = MFQ(o[0], PAF(2), VFR(2)), C1, 0); \
    KRD(GL, 3); GAPB(o[1] = MFQ(o[1], PAF(2), VFR(6)), C1, 4); \
    GAPB(o[0] = MFQ(o[0], PAF(3), VFR(3)), C1, 8); \
    GAPB(o[1] = MFQ(o[1], PAF(3), VFR(7)), C1, 12); \
    } while (0)
    int t = 1;
#undef CMASK
#define CMASK(P0, P1, t) do {} while (0)
    for (; t + 5 < NT; t += 2) {
        STEP(pB0, pB1, pA0, pA1, t, true, true, true);     WAIT_BAR(2); RESC(); ROT();
        STEP(pA0, pA1, pB0, pB1, t + 1, true, true, true); WAIT_BAR(2); RESC(); ROT();
    }
#undef CMASK
#define CMASK(P0, P1, t) do { int jb_ = (t) - (NT - 4); if (jb_ >= 0) cmask(P0, P1, jb_, qrel, hi); } while (0)
#define ENDW(tt) do { if ((tt) + 3 < NT) { WAIT_BAR(2); } else if ((tt) + 2 < NT) { WAIT_BAR(1); } else { WAIT_BAR(0); } } while (0)
    for (; t + 1 < NT; t += 2) {
        STEP(pB0, pB1, pA0, pA1, t, (t + 3 < NT), (t + 1 < NT), (t + 1 < NT));         ENDW(t);     RESC(); ROT();
        STEP(pA0, pA1, pB0, pB1, t + 1, (t + 4 < NT), (t + 2 < NT), (t + 2 < NT));     ENDW(t + 1); RESC(); ROT();
    }
    u32x4 gq[4];
#pragma unroll
    for (int i = 0; i < 4; ++i) gq[i] = *(const u32x4*)(T.U + (rowbase + q0 + wid * 32 + i * 8 + (lane >> 3)) * UP + gcol + (lane & 7) * 8);
    STEP(pB0, pB1, pA0, pA1, NT - 1, false, false, false); RESC();
    { float sacc = pB0[0] + pB0[1];
#pragma unroll
      for (int r = 2; r < 16; ++r) sacc += pB0[r];
#pragma unroll
      for (int r = 0; r < 16; ++r) sacc += pB1[r];
      l_reg += sacc;
      SBAR(); pv(o, vb0 + ic * SLOTV, pk8(pB0, 0), pk8(pB0, 8), pk8(pB1, 0), pk8(pB1, 8)); }
    l_reg = swap_add(l_reg);
    if (hi == 0) wsf[32 + r32] = l_reg;
    asm volatile("s_waitcnt lgkmcnt(0)" ::: "memory");
#pragma unroll
    for (int r = 0; r < 16; ++r) { const float f = __builtin_amdgcn_rcpf(wsf[32 + crow(r, hi)]); o[0][r] *= f; o[1][r] *= f; }
    {
        ALAS bf16_t* stg = (ALAS bf16_t*)(shm + L_OST) + wid * 2048;
#pragma unroll
        for (int r = 0; r < 16; ++r) { const int orow = crow(r, hi);
#pragma unroll
            for (int d0 = 0; d0 < 2; ++d0) stg[orow * 64 + d0 * 32 + r32] = (bf16_t)(cvtpk(o[d0][r], 0.f) & 0xffffu); }
        asm volatile("s_waitcnt lgkmcnt(0)" ::: "memory");
#pragma unroll
        for (int i = 0; i < 4; ++i) asm volatile("" : "+v"(gq[i]));
#pragma unroll
        for (int i = 0; i < 4; ++i) { const int row = i * 8 + (lane >> 3), ch = lane & 7;
            const u32x4 v = *(ALAS const u32x4*)(stg + row * 64 + ch * 8);
            const long grow = rowbase + q0 + wid * 32 + row;
            const u32x4 g = gq[i];
            float x[8] = {bflo(v.x), bfhi(v.x), bflo(v.y), bfhi(v.y), bflo(v.z), bfhi(v.z), bflo(v.w), bfhi(v.w)};
            const float gg[8] = {bflo(g.x), bfhi(g.x), bflo(g.y), bfhi(g.y), bflo(g.z), bfhi(g.z), bflo(g.w), bfhi(g.w)};
#pragma unroll
            for (int j = 0; j < 8; ++j) x[j] *= gg[j] / (1.0f + __expf(-gg[j]));
            u32x4 w; w.x = cvtpk(x[0], x[1]); w.y = cvtpk(x[2], x[3]); w.z = cvtpk(x[4], x[5]); w.w = cvtpk(x[6], x[7]);
            *(u32x4*)(T.Y + grow * T.ypitch + (ycol - T.ysub) + ch * 8) = w; }
    }
    asm volatile("s_waitcnt vmcnt(0) lgkmcnt(0)\n\ts_barrier" ::: "memory");
#undef DMA_K
#undef DMA_V
#undef BIAS
#undef BIAS8
#undef CMASK
#undef DECIDE
#undef RESC
#undef ROT
#undef PKW
#undef PAF
#undef VFR
#undef PIN
#undef GAPA
#undef EX
#undef GAPB
#undef VRD
#undef KRD
#undef MFQ
#undef STEP
#undef ENDW
}

__device__ __forceinline__ void kload12(bf16x8* kf, lds_cptr kp) {
#pragma unroll
    for (int j = 0; j < 6; ++j) { kf[2 * j] = *(const ALAS bf16x8*)(kp + j * 2048); kf[2 * j + 1] = *(const ALAS bf16x8*)(kp + j * 2048 + 512); }
}
__device__ __forceinline__ void mla_unit_tuned(const Tensors& T, int b, int h, int qb, ALAS char* shm, unsigned lds0) {
    int tid_ = threadIdx.x; asm volatile("" : "+v"(tid_));
    const int tid = tid_, lane = tid & 63, r32 = lane & 31, hi = lane >> 5; const int wid = __builtin_amdgcn_readfirstlane(tid >> 6);
    const long rowbase = (long)b * SEQ; const int q0 = qb * QB;
    const int NT = (q0 + QB) / KVBLK;
    const bf16_t* Kp = T.KVA + h * 64; const bf16_t* Vp = T.KVA + 256 + h * 64;
    const int gcol = 2560 + h * 64, ycol = h * 64;
    ALAS float* wsf = (ALAS float*)(shm + L_WS) + wid * 64;
    const long qrow = rowbase + q0 + wid * 32 + r32;
    bf16x8 qr[6];
#pragma unroll
    for (int d0 = 0; d0 < 4; ++d0) qr[d0] = *(const bf16x8*)(T.QA + qrow * 384 + h * 64 + d0 * 16 + hi * 8);
#pragma unroll
    for (int d0 = 4; d0 < 6; ++d0) qr[d0] = *(const bf16x8*)(T.QA + qrow * 384 + 256 + h * 32 + (d0 - 4) * 16 + hi * 8);
#pragma unroll
    for (int d0 = 0; d0 < 6; ++d0) asm volatile("" : "+v"(qr[d0]));
    const bf16_t* ksrc = Kp + (rowbase + lane) * 512 + wid * 8;
    const bf16_t* krsrc = T.KR + (rowbase + lane) * 32 + (wid & 3) * 8;
    const bf16_t* vsrc = Vp + (rowbase + 16 * (wid & 3) + (lane >> 2)) * 512 + (wid >> 2) * 32 + (lane & 3) * 8;
    const unsigned kdst = lds0 + L_K + wid * 1024, krdst = lds0 + L_K + (8 + (wid & 3)) * 1024, vdst = lds0 + L_V + wid * 1024;
#define DMA_K(t, si) do { glds16(ksrc + (long)(t) * KVBLK * 512, (unsigned)__builtin_amdgcn_readfirstlane(kdst + (si) * SLOTK)); \
                          glds16(krsrc + (long)(t) * KVBLK * 32, (unsigned)__builtin_amdgcn_readfirstlane(krdst + (si) * SLOTK)); } while (0)
#define DMA_V(t, si) glds16(vsrc + (long)(t) * KVBLK * 512, (unsigned)__builtin_amdgcn_readfirstlane(vdst + (si) * SLOTV))
    const int vb0 = (int)(lds0 + L_V) + ((lane >> 4) & 1) * 32 + (lane & 3) * 8 + (4 * hi + ((lane & 15) >> 2)) * 64;
    const lds_cptr shm3 = (lds_cptr)shm; const lds_cptr kp0 = shm3 + L_K + hi * 1024 + r32 * 16;
    const lds_cptr vp0 = shm3 + L_V + ((lane >> 4) & 1) * 32 + (lane & 3) * 8 + (4 * hi + ((lane & 15) >> 2)) * 64;
    const int qrel = wid * 32 + r32;
    DMA_K(0, 0); DMA_V(0, 0); DMA_K(1, 1);
    bf16x8 kf[12];
    float mhat = 0.f, l_reg = 0.f; f32x16 o[2]; o[0] = f32x16{}; o[1] = f32x16{};
    const f32x16 zero16 = f32x16{};
    bool resc = false;
#define CMASK(P0, P1, t) do { int jb_ = (t) - (NT - 4); if (jb_ >= 0) cmask(P0, P1, jb_, qrel, hi); } while (0)
#define DECIDE(C0, C1, rmraw) do { resc = false; const float rel_ = (rmraw) - mhat; const float dl = (rel_ > 6.0f) ? rel_ : 0.f; \
        if (__builtin_expect(__any(dl != 0.f), 0)) { const float f = __builtin_amdgcn_exp2f(-dl); mhat += dl; l_reg *= f; if (hi == 0) wsf[r32] = f; resc = true; } \
        _Pragma("unroll") for (int r = 0; r < 16; ++r) { C0[r] -= mhat; C1[r] -= mhat; } } while (0)
#define RESC() do { if (resc) { asm volatile("s_waitcnt lgkmcnt(0)" ::: "memory"); \
        _Pragma("unroll") for (int d_ = 0; d_ < 2; ++d_) _Pragma("unroll") for (int r = 0; r < 16; ++r) o[d_][r] *= wsf[crow(r, hi)]; } } while (0)
    f32x16 pA0, pA1, pB0, pB1;
    int ip = 0, ic = 0, in_ = 1;
#define ROT() do { ip = ic; ic = in_; in_ = (in_ == NSLOT - 1) ? 0 : in_ + 1; } while (0)
    DMA_K(2, 2);
    WAIT_BAR(5);
    qkt<6>(pA0, pA1, shm3 + L_K, qr, zero16, r32, hi);
    CMASK(pA0, pA1, 0);
    { float rm = rowmax_cv(pA0, pA1); rm = swap_max(rm); mhat = rm;
#pragma unroll
      for (int r = 0; r < 16; ++r) { pA0[r] = __builtin_amdgcn_exp2f(pA0[r] - mhat); pA1[r] = __builtin_amdgcn_exp2f(pA1[r] - mhat); } }
    WAIT_BAR(0);
    DMA_K(3, 0); DMA_V(1, 1);
    ROT();
    kload12(kf, kp0 + ic * SLOTK);
    WAIT_BAR(3);
    s16x4 vlo[8], vhi[8]; u32x4 pw0, pw1, pw2, pw3;
#define PKW(P, B) cvtpk(P[B], P[B + 1])
#define PAF(k) __builtin_bit_cast(bf16x8, pw##k)
#define VFR(i) (bf16x8){vlo[i][0], vlo[i][1], vlo[i][2], vlo[i][3], vhi[i][0], vhi[i][1], vhi[i][2], vhi[i][3]}
#define PIN(x) asm volatile("" : "+v"(x))
#define GAPA(MF, A0, A1, A2, A3, W0, W1, PW) do { MF; sacc += A0; sacc += A1; sacc += A2; sacc += A3; PIN(sacc); W0; W1; PIN(PW); SBAR(); } while (0)
#define EX(v) __builtin_amdgcn_exp2f(v)
#define GAPB(MF, X, B) do { MF; X[B] = EX(X[B]); X[B + 1] = EX(X[B + 1]); X[B + 2] = EX(X[B + 2]); X[B + 3] = EX(X[B + 3]); PIN(X); SBAR(); } while (0)
#define VRD(i) do { vlo[i] = vtr(vp_ + (((i) >> 2) * 4096 + ((i) & 3) * 1024)); vhi[i] = vtr(vp_ + (((i) >> 2) * 4096 + ((i) & 3) * 1024 + 512)); } while (0)
#define KRD(G, j) do { if (G) { kload2(kf, kp0 + in_ * SLOTK, j); SBAR(); } } while (0)
#define MFQ(c, a, b_) __builtin_amdgcn_mfma_f32_32x32x16_bf16(a, b_, c, 0, 0, 0)
#define STEP(C0, C1, P0, P1, t, GK, GV, GL) do { SBAR(); \
    const lds_cptr vp_ = vp0 + ip * SLOTV; \
    VRD(0); SBAR(); float sacc = (P0[0] + P0[1]); \
    GAPA(C0 = MFQ(zero16, kf[0], qr[0]), P0[2], P0[3], P0[4], P0[5],     pw0[0] = PKW(P0, 0), pw0[1] = PKW(P0, 2), pw0); \
    VRD(4); SBAR(); GAPA(C1 = MFQ(zero16, kf[1], qr[0]), P0[6], P0[7], P0[8], P0[9],     pw0[2] = PKW(P0, 4), pw0[3] = PKW(P0, 6), pw0); \
    VRD(1); SBAR(); GAPA(C0 = MFQ(C0, kf[2], qr[1]),   P0[10], P0[11], P0[12], P0[13], pw1[0] = PKW(P0, 8), pw1[1] = PKW(P0, 10), pw1); \
    VRD(5); SBAR(); GAPA(C1 = MFQ(C1, kf[3], qr[1]),   P0[14], P0[15], P1[0], P1[1],   pw1[2] = PKW(P0, 12), pw1[3] = PKW(P0, 14), pw1); \
    VRD(2); SBAR(); GAPA(C0 = MFQ(C0, kf[4], qr[2]),   P1[2], P1[3], P1[4], P1[5],     pw2[0] = PKW(P1, 0), pw2[1] = PKW(P1, 2), pw2); \
    VRD(6); SBAR(); GAPA(C1 = MFQ(C1, kf[5], qr[2]),   P1[6], P1[7], P1[8], P1[9],     pw2[2] = PKW(P1, 4), pw2[3] = PKW(P1, 6), pw2); \
    VRD(3); SBAR(); GAPA(C0 = MFQ(C0, kf[6], qr[3]),   P1[10], P1[11], P1[12], P1[13], pw3[0] = PKW(P1, 8), pw3[1] = PKW(P1, 10), pw3); \
    VRD(7); SBAR(); GAPA(C1 = MFQ(C1, kf[7], qr[3]),   P1[14], P1[15], 0.f, 0.f,       pw3[2] = PKW(P1, 12), pw3[3] = PKW(P1, 14), pw3); \
    C0 = MFQ(C0, kf[8], qr[4]); C1 = MFQ(C1, kf[9], qr[4]); C0 = MFQ(C0, kf[10], qr[5]); C1 = MFQ(C1, kf[11], qr[5]); SBAR(); \
    l_reg += sacc; \
    if (GK) { DMA_K((t) + 3, ic); } if (GV) { DMA_V((t) + 1, in_); } \
    CMASK(C0, C1, t); \
    { float rm = rowmax_cv(C0, C1); rm = swap_max(rm); DECIDE(C0, C1, rm); } \
    SBAR(); \
    GAPB(o[0] = MFQ(o[0], PAF(0), VFR(0)), C0, 0); \
    KRD(GL, 0); GAPB(o[1] = MFQ(o[1], PAF(0), VFR(4)), C0, 4); \
    KRD(GL, 1); GAPB(o[0] = MFQ(o[0], PAF(1), VFR(1)), C0, 8); \
    KRD(GL, 2); GAPB(o[1] = MFQ(o[1], PAF(1), VFR(5)), C0, 12); \
    KRD(GL, 3); GAPB(o[0] = MFQ(o[0], PAF(2), VFR(2)), C1, 0); \
    KRD(GL, 4); GAPB(o[1] = MFQ(o[1], PAF(2), VFR(6)), C1, 4); \
    KRD(GL, 5); GAPB(o[0] = MFQ(o[0], PAF(3), VFR(3)), C1, 8); \
    GAPB(o[1] = MFQ(o[1], PAF(3), VFR(7)), C1, 12); \
    } while (0)
    int t = 1;
#undef CMASK
#define CMASK(P0, P1, t) do {} while (0)
    for (; t + 5 < NT; t += 2) {
        STEP(pB0, pB1, pA0, pA1, t, true, true, true);     WAIT_BAR(3); RESC(); ROT();
        STEP(pA0, pA1, pB0, pB1, t + 1, true, true, true); WAIT_BAR(3); RESC(); ROT();
    }
#undef CMASK
#define CMASK(P0, P1, t) do { int jb_ = (t) - (NT - 4); if (jb_ >= 0) cmask(P0, P1, jb_, qrel, hi); } while (0)
#define ENDW(tt) do { if ((tt) + 3 < NT) { WAIT_BAR(3); } else if ((tt) + 2 < NT) { WAIT_BAR(1); } else { WAIT_BAR(0); } } while (0)
    for (; t + 1 < NT; t += 2) {
        STEP(pB0, pB1, pA0, pA1, t, (t + 3 < NT), (t + 1 < NT), (t + 1 < NT));         ENDW(t);     RESC(); ROT();
        STEP(pA0, pA1, pB0, pB1, t + 1, (t + 4 < NT), (t + 2 < NT), (t + 2 < NT));     ENDW(t + 1); RESC(); ROT();
    }
    u32x4 gq[4];
#pragma unroll
    for (int i = 0; i < 4; ++i) gq[i] = *(const u32x4*)(T.U + (rowbase + q0 + wid * 32 + i * 8 + (lane >> 3)) * UP + gcol + (lane & 7) * 8);
    STEP(pB0, pB1, pA0, pA1, NT - 1, false, false, false); RESC();
    { float sacc = pB0[0] + pB0[1];
#pragma unroll
      for (int r = 2; r < 16; ++r) sacc += pB0[r];
#pragma unroll
      for (int r = 0; r < 16; ++r) sacc += pB1[r];
      l_reg += sacc;
      SBAR(); pv(o, vb0 + ic * SLOTV, pk8(pB0, 0), pk8(pB0, 8), pk8(pB1, 0), pk8(pB1, 8)); }
    l_reg = swap_add(l_reg);
    if (hi == 0) wsf[32 + r32] = l_reg;
    asm volatile("s_waitcnt lgkmcnt(0)" ::: "memory");
#pragma unroll
    for (int r = 0; r < 16; ++r) { const float f = __builtin_amdgcn_rcpf(wsf[32 + crow(r, hi)]); o[0][r] *= f; o[1][r] *= f; }
    {
        ALAS bf16_t* stg = (ALAS bf16_t*)(shm + L_OST) + wid * 2048;
#pragma unroll
        for (int r = 0; r < 16; ++r) { const int orow = crow(r, hi);
#pragma unroll
            for (int d0 = 0; d0 < 2; ++d0) stg[orow * 64 + d0 * 32 + r32] = (bf16_t)(cvtpk(o[d0][r], 0.f) & 0xffffu); }
        asm volatile("s_waitcnt lgkmcnt(0)" ::: "memory");
#pragma unroll
        for (int i = 0; i < 4; ++i) asm volatile("" : "+v"(gq[i]));
#pragma unroll
        for (int i = 0; i < 4; ++i) { const int row = i * 8 + (lane >> 3), ch = lane & 7;
            const u32x4 v = *(ALAS const u32x4*)(stg + row * 64 + ch * 8);
            const long grow = rowbase + q0 + wid * 32 + row;
            const u32x4 g = gq[i];
            float x[8] = {bflo(v.x), bfhi(v.x), bflo(v.y), bfhi(v.y), bflo(v.z), bfhi(v.z), bflo(v.w), bfhi(v.w)};
            const float gg[8] = {bflo(g.x), bfhi(g.x), bflo(g.y), bfhi(g.y), bflo(g.z), bfhi(g.z), bflo(g.w), bfhi(g.w)};
#pragma unroll
            for (int j = 0; j < 8; ++j) x[j] *= gg[j] / (1.0f + __expf(-gg[j]));
            u32x4 w; w.x = cvtpk(x[0], x[1]); w.y = cvtpk(x[2], x[3]); w.z = cvtpk(x[4], x[5]); w.w = cvtpk(x[6], x[7]);
            *(u32x4*)(T.Y + grow * T.ypitch + (ycol - T.ysub) + ch * 8) = w; }
    }
    asm volatile("s_waitcnt vmcnt(0) lgkmcnt(0)\n\ts_barrier" ::: "memory");
#undef DMA_K
#undef DMA_V
#undef CMASK
#undef DECIDE
#undef RESC
#undef ROT
#undef PKW
#undef PAF
#undef VFR
#undef PIN
#undef GAPA
#undef EX
#undef GAPB
#undef VRD
#undef KRD
#undef MFQ
#undef STEP
#undef ENDW
}
#undef SBAR
#undef WAIT_BAR
}
namespace att {
constexpr int SBW = 6, SB_K = 0, SB_V = SBW * 8192, SB_STG = 2 * SBW * 8192, SB_END = SB_STG + 8 * 4096;
__device__ __forceinline__ void sb_unit_res(const Tensors& T, int b, int h, int qb, ALAS char* shm, unsigned lds0, ALAS unsigned* flags) {
    int tid_ = threadIdx.x; asm volatile("" : "+v"(tid_));
    const int tid = tid_, lane = tid & 63, r32 = lane & 31, hi = lane >> 5; const int wid = __builtin_amdgcn_readfirstlane(tid >> 6);
    const long rowbase = (long)b * SEQ; const int q0 = qb * QB;
    const int NT = (q0 + QB) / KVBLK;
    const bf16_t* Qp = T.U + 512 + h * 64; const bf16_t* Kp = Qp + 256; const bf16_t* Vp = Qp + 512;
    const int gcol = 2560 + 256 + h * 64, ycol = 256 + h * 64;
    const bf16_t* ksrc = Kp + (rowbase + lane) * UP + wid * 8;
    const bf16_t* vsrc = Vp + (rowbase + 16 * (wid & 3) + (lane >> 2)) * UP + (wid >> 2) * 32 + (lane & 3) * 8;
    const unsigned kdst = lds0 + SB_K + wid * 1024, vdst = lds0 + SB_V + wid * 1024;
    const int vb0 = (int)(lds0 + SB_V) + ((lane >> 4) & 1) * 32 + (lane & 3) * 8 + (4 * hi + ((lane & 15) >> 2)) * 64;
    const lds_cptr kbase = (lds_cptr)shm + SB_K;
    const int qrel = wid * 32 + r32;
    int base = NT - 1, nW = (base + 1 < SBW) ? base + 1 : SBW;
#define DMA_WIN() do { for (int s_ = 0; s_ < nW; ++s_) { glds16(ksrc + (long)(base - s_) * KVBLK * UP, (unsigned)__builtin_amdgcn_readfirstlane(kdst + s_ * 8192)); \
                                                          glds16(vsrc + (long)(base - s_) * KVBLK * UP, (unsigned)__builtin_amdgcn_readfirstlane(vdst + s_ * 8192)); } } while (0)
    DMA_WIN();
    const long qrow = rowbase + q0 + wid * 32 + r32;
    bf16x8 qr[4];
#pragma unroll
    for (int d0 = 0; d0 < 4; ++d0) qr[d0] = *(const bf16x8*)(Qp + qrow * UP + d0 * 16 + hi * 8);
    bf16x8 Ta, Tb, Tones;
    { short ta[8], tb[8];
#pragma unroll
      for (int j = 0; j < 8; ++j) { const int kk = 8 * (j >> 2) + 4 * hi + (j & 3); ta[j] = (kk > r32) ? (short)0x3F80 : (short)0; tb[j] = (16 + kk > r32) ? (short)0x3F80 : (short)0; }
      Ta = (bf16x8){ta[0], ta[1], ta[2], ta[3], ta[4], ta[5], ta[6], ta[7]}; Tb = (bf16x8){tb[0], tb[1], tb[2], tb[3], tb[4], tb[5], tb[6], tb[7]};
      Tones = (bf16x8){(short)0x3F80, (short)0x3F80, (short)0x3F80, (short)0x3F80, (short)0x3F80, (short)0x3F80, (short)0x3F80, (short)0x3F80}; }
    u32x4 gt[4];
#pragma unroll
    for (int i = 0; i < 4; ++i) gt[i] = *(const u32x4*)(T.U + (rowbase + q0 + wid * 32 + i * 8 + (lane >> 3)) * UP + gcol + (lane & 7) * 8);
#pragma unroll
    for (int d0 = 0; d0 < 4; ++d0) asm volatile("" : "+v"(qr[d0]));
#pragma unroll
    for (int i = 0; i < 4; ++i) asm volatile("" : "+v"(gt[i]));
    float c = 0.f; f32x16 o[2]; o[0] = f32x16{}; o[1] = f32x16{};
    const f32x16 zero16 = f32x16{};
    bool mydone = false;
    for (;;) {
        asm volatile("s_waitcnt vmcnt(0) lgkmcnt(0)\n\ts_barrier" ::: "memory");
        if (!mydone) {
            for (int s = 0; s < nW; ++s) {
                const int t = base - s, jb = t - (NT - 4);
                const bool wave_active = (jb < 0) || (64 * jb < wid * 32 + 31);
                if (wave_active) {
                    f32x16 p0, p1, D0, D1;
                    qkt<4>(p0, p1, kbase + s * 8192, qr, zero16, r32, hi);
                    f32x16 L0, L1;
#pragma unroll
                    for (int r = 0; r < 16; ++r) {
                        { const float z = p0[r]; const float e = __builtin_amdgcn_exp2f(-fabsf(z)); const float sp = fmaxf(z, 0.f) + __builtin_amdgcn_logf(1.0f + e); p0[r] = z - sp; L0[r] = -sp; }
                        { const float z = p1[r]; const float e = __builtin_amdgcn_exp2f(-fabsf(z)); const float sp = fmaxf(z, 0.f) + __builtin_amdgcn_logf(1.0f + e); p1[r] = z - sp; L1[r] = -sp; }
                    }
                    if (jb >= 0) {
#pragma unroll
                        for (int r = 0; r < 16; ++r) { const int kv = 64 * jb + 4 * hi + (r & 3) + 8 * (r >> 2);
                            if (kv >= qrel) { p0[r] = -INFINITY; L0[r] = 0.f; } if (kv + 32 >= qrel) { p1[r] = -INFINITY; L1[r] = 0.f; } }
                    }
                    const bf16x8 B0 = pk8(L0, 0), B1 = pk8(L0, 8), B2 = pk8(L1, 0), B3 = pk8(L1, 8);
                    f32x16 X = __builtin_amdgcn_mfma_f32_32x32x16_bf16(Tones, B2, zero16, 0, 0, 0);
                    X = __builtin_amdgcn_mfma_f32_32x32x16_bf16(Tones, B3, X, 0, 0, 0);
                    D0 = __builtin_amdgcn_mfma_f32_32x32x16_bf16(Ta, B0, X, 0, 0, 0);
                    D0 = __builtin_amdgcn_mfma_f32_32x32x16_bf16(Tb, B1, D0, 0, 0, 0);
                    D1 = __builtin_amdgcn_mfma_f32_32x32x16_bf16(Ta, B2, zero16, 0, 0, 0);
                    D1 = __builtin_amdgcn_mfma_f32_32x32x16_bf16(Tb, B3, D1, 0, 0, 0);
                    f32x16 TT = __builtin_amdgcn_mfma_f32_32x32x16_bf16(Tones, B0, X, 0, 0, 0);
                    TT = __builtin_amdgcn_mfma_f32_32x32x16_bf16(Tones, B1, TT, 0, 0, 0);
#pragma unroll
                    for (int r = 0; r < 16; ++r) { p0[r] += D0[r] + c; p1[r] += D1[r] + c; }
                    c += TT[0];
#pragma unroll
                    for (int r = 0; r < 16; ++r) { p0[r] = __builtin_amdgcn_exp2f(p0[r]); p1[r] = __builtin_amdgcn_exp2f(p1[r]); }
                    pv(o, vb0 + s * 8192, pk8(p0, 0), pk8(p0, 8), pk8(p1, 0), pk8(p1, 8));
                }
                if (__all(c < SB_EXIT)) { mydone = true; break; }
            }
        }
        base -= nW;
        if (base < 0) break;
        if (lane == 0) flags[wid] = mydone ? 1u : 0u;
        asm volatile("s_waitcnt lgkmcnt(0)\n\ts_barrier" ::: "memory");
        { const unsigned all = flags[0] & flags[1] & flags[2] & flags[3] & flags[4] & flags[5] & flags[6] & flags[7];
          if (__builtin_amdgcn_readfirstlane(all) != 0u) break; }
        nW = (base + 1 < SBW) ? base + 1 : SBW;
        DMA_WIN();
    }
    {
        ALAS bf16_t* stg = (ALAS bf16_t*)(shm + SB_STG) + wid * 2048;
#pragma unroll
        for (int r = 0; r < 16; ++r) { const int orow = crow(r, hi);
#pragma unroll
            for (int d0 = 0; d0 < 2; ++d0) stg[orow * 64 + d0 * 32 + r32] = (bf16_t)(cvtpk(o[d0][r], 0.f) & 0xffffu); }
        asm volatile("s_waitcnt lgkmcnt(0)" ::: "memory");
#pragma unroll
        for (int i = 0; i < 4; ++i) { const int row = i * 8 + (lane >> 3), ch = lane & 7;
            const u32x4 v = *(ALAS const u32x4*)(stg + row * 64 + ch * 8);
            const long grow = rowbase + q0 + wid * 32 + row;
            const u32x4 g = gt[i];
            float x[8] = {bflo(v.x), bfhi(v.x), bflo(v.y), bfhi(v.y), bflo(v.z), bfhi(v.z), bflo(v.w), bfhi(v.w)};
            const float gg[8] = {bflo(g.x), bfhi(g.x), bflo(g.y), bfhi(g.y), bflo(g.z), bfhi(g.z), bflo(g.w), bfhi(g.w)};
#pragma unroll
            for (int j = 0; j < 8; ++j) x[j] *= gg[j] / (1.0f + __expf(-gg[j]));
            u32x4 w; w.x = cvtpk(x[0], x[1]); w.y = cvtpk(x[2], x[3]); w.z = cvtpk(x[4], x[5]); w.w = cvtpk(x[6], x[7]);
            *(u32x4*)(T.Y + grow * T.ypitch + (ycol - T.ysub) + ch * 8) = w; }
    }
    asm volatile("s_waitcnt vmcnt(0) lgkmcnt(0)\n\ts_barrier" ::: "memory");
#undef DMA_WIN
}
}

constexpr int NWAVES = 8, NTHREADS = NWAVES * 64;
constexpr int BATCH = 8, SEQ = 4096, DM = 1024, DEPTH = 4, M = BATCH * SEQ, D_IN = 3424, NU = 3584;
constexpr float NORM_EPS = 1e-6f;
constexpr float LOG2E = 1.4426950408889634f;
constexpr float QSCALE_64 = 0.125f * LOG2E;
constexpr float QSCALE_96 = 0.10206207261596575f * LOG2E;
constexpr size_t MiB = 1u << 20;
constexpr size_t WS_CTL = 0, CTL_ZERO_BYTES = 1 * MiB;
constexpr size_t WS_WIN = 1 * MiB, WS_WOUT = 29 * MiB, WS_WQ2 = 37 * MiB, WS_WKV2 = 38 * MiB, WS_WPW = 39 * MiB;
constexpr size_t WS_ROPE = 39 * MiB + 512 * 1024, WS_BT = 40 * MiB, WS_KMEAN = 40 * MiB + 256 * 1024;
constexpr size_t WS_SSQQ = 41 * MiB, WS_SSQKV = 41 * MiB + 512 * 1024, WS_SSQO = 42 * MiB, WS_KR = 44 * MiB, WS_CONVH = 46 * MiB, WS_QA = 62 * MiB, WS_KVA = 86 * MiB;
constexpr size_t WS_HNY = 118 * MiB;
constexpr size_t WS_U = 182 * MiB;
constexpr size_t WS_XB = 406 * MiB;
constexpr size_t WS_RSTD = 40 * MiB + 384 * 1024;
constexpr size_t WS_END = 470 * MiB;
static_assert(WS_WIN + (size_t)DEPTH * NU * DM * 2 <= WS_WOUT && WS_WOUT + (size_t)DEPTH * DM * DM * 2 <= WS_WQ2 && WS_WPW + (size_t)DEPTH * 256 * 256 * 2 <= WS_ROPE, "ws map (weights)");
static_assert(WS_ROPE + 2 * SEQ * 16 * 4 <= WS_BT && WS_BT + 4 * 4352 * 4 <= WS_KMEAN && WS_KMEAN + BATCH * 16 * 256 * 4 <= WS_SSQQ && WS_SSQO + (size_t)M * 16 * 4 <= WS_KR, "ws map (tables)");
static_assert(WS_KR + (size_t)M * 32 * 2 <= WS_CONVH && WS_CONVH + (size_t)M * 256 * 2 <= WS_QA && WS_QA + (size_t)M * 384 * 2 <= WS_KVA && WS_KVA + (size_t)M * 512 * 2 <= WS_HNY &&
              WS_HNY + (size_t)M * DM * 2 <= WS_U && WS_U + (size_t)M * NU * 2 <= WS_XB && WS_XB + (size_t)M * DM * 2 <= WS_END && WS_RSTD + (size_t)M * 4 <= WS_SSQQ, "ws map (activations)");
constexpr int CW_BAR = 4096, CW_QUEUE = 8192;
constexpr int RING_OFF = 0, RING_BYTES = 131072, LDSCTL_OFF = RING_BYTES, MISC_OFF = LDSCTL_OFF + 320, LDS_BYTES = 147456;
#ifndef PH_MASK
#define PH_MASK 0xFFFF
#endif
#define PH_EN(k) ((PH_MASK >> (k)) & 1)
static_assert(att::L_END <= RING_BYTES, "attention LDS map");
static_assert(att::SB_END <= RING_BYTES, "stick-breaking LDS map");
#define GAS __attribute__((address_space(1)))
#define LAS __attribute__((address_space(3)))
typedef unsigned short bf16;
typedef unsigned v4u __attribute__((ext_vector_type(4)));
typedef float f32x4 __attribute__((ext_vector_type(4)));
typedef short bf16x8 __attribute__((ext_vector_type(8)));
typedef GAS unsigned gu32;
typedef GAS unsigned long long gu64;
#define RLX_AGENT __ATOMIC_RELAXED, __HIP_MEMORY_SCOPE_AGENT
#define LDS_WAIT() asm volatile("s_waitcnt lgkmcnt(0)" ::: "memory")
#define VM_WAIT() asm volatile("s_waitcnt vmcnt(0)" ::: "memory")
__device__ __forceinline__ unsigned long long rt() { return __builtin_amdgcn_s_memrealtime(); }
__device__ __forceinline__ unsigned f2bf(float f) { unsigned u = __builtin_bit_cast(unsigned, f); return (u + 0x7fffu + ((u >> 16) & 1u)) >> 16; }
__device__ __forceinline__ unsigned pk2(float lo, float hi) { return f2bf(lo) | (f2bf(hi) << 16); }
#define XB_TMO      128
#define XB_XCNT(j)  (256  + 64 * (j))
#define XB_XSUB(j)  (1280 + 64 * (j))
#define XB_XGEN(j)  (2304 + 64 * (j))
#define XB_TOP      3328
#define XB_TOPGEN   3392
#define XCD_BAR_WORDS 3456
#define XB_SPIN_CAP (1u << 18)

__device__ __forceinline__ unsigned xb_ld(unsigned* p)              { return __hip_atomic_load(p, __ATOMIC_RELAXED, __HIP_MEMORY_SCOPE_AGENT); }
__device__ __forceinline__ unsigned xb_add(unsigned* p, unsigned v) { return __hip_atomic_fetch_add(p, v, __ATOMIC_RELAXED, __HIP_MEMORY_SCOPE_AGENT); }
__device__ __forceinline__ unsigned xb_xcc_id() { return (unsigned)__builtin_amdgcn_s_getreg((3 << 11) | 20) & 0xFu; }
#define XB_SPIN(cond, bar) do { unsigned _sp = 0; while (cond) { __builtin_amdgcn_s_sleep(1); \
    if ((++_sp & 255u) == 0u) { if (xb_ld(&(bar)[XB_TMO])) break; if (_sp > XB_SPIN_CAP) { atomicAdd(&(bar)[XB_TMO], 1u); break; } } } } while (0)

struct XcdBarrier {
    unsigned* bar; unsigned x;
    volatile LAS unsigned* st;
};

__device__ __forceinline__ XcdBarrier xcd_barrier_post(unsigned* bar, volatile LAS unsigned* st) {
    XcdBarrier b; b.bar = bar; b.x = xb_xcc_id(); b.st = st;
    if (threadIdx.x == 0) (void)xb_add(&bar[XB_XCNT(b.x)], 1u);
    return b;
}
__device__ __forceinline__ void xcd_barrier_complete(unsigned* bar, unsigned x, unsigned& nloc, unsigned& nx) {
    const unsigned G = gridDim.x * gridDim.y * gridDim.z;
    unsigned sum, cnt, mine, sp = 0u;
    for (;;) {
        sum = 0u; cnt = 0u; mine = 0u;
#pragma unroll
        for (unsigned j = 0; j < 16; ++j) { const unsigned c = xb_ld(&bar[XB_XCNT(j)]); sum += c; cnt += (c > 0u) ? 1u : 0u; mine = (j == x) ? c : mine; }
        if (sum == G) break;
        __builtin_amdgcn_s_sleep(1);
        if ((++sp & 255u) == 0u) { if (xb_ld(&bar[XB_TMO])) break; if (sp > XB_SPIN_CAP) { atomicAdd(&bar[XB_TMO], 1u); break; } }
    }
    nloc = mine > 0u ? mine : 1u; nx = cnt > 0u ? cnt : 1u;
}

__device__ __forceinline__ void xcd_barrier(const XcdBarrier& b) {
    asm volatile("s_waitcnt vmcnt(0)" ::: "memory");
    __syncthreads();
    if (threadIdx.x == 0) {
        unsigned* bar = b.bar;
        __builtin_amdgcn_s_waitcnt(0);
        unsigned nloc = b.st[0], nx = b.st[1];
        if (nloc == 0u) { xcd_barrier_complete(bar, b.x, nloc, nx); b.st[0] = nloc; b.st[1] = nx; }
        const unsigned old = xb_add(&bar[XB_XSUB(b.x)], 1u);
        const unsigned gen = old / nloc;
        if (old + 1u == (gen + 1u) * nloc) {
            __builtin_amdgcn_fence(__ATOMIC_RELEASE, "agent");
            asm volatile("s_waitcnt vmcnt(0)" ::: "memory");
            const unsigned og = xb_add(&bar[XB_TOP], 1u);
            const unsigned tg = og / nx;
            if (og + 1u == (tg + 1u) * nx) xb_add(&bar[XB_TOPGEN], 1u);
            else XB_SPIN(xb_ld(&bar[XB_TOPGEN]) == tg, bar);
            __builtin_amdgcn_fence(__ATOMIC_ACQUIRE, "agent");
            xb_add(&bar[XB_XGEN(b.x)], 1u);
            asm volatile("s_waitcnt vmcnt(0)" ::: "memory");
        } else {
            XB_SPIN(xb_ld(&bar[XB_XGEN(b.x)]) == gen, bar);
            __builtin_amdgcn_fence(__ATOMIC_ACQUIRE, "agent");
            asm volatile("s_waitcnt vmcnt(0)" ::: "memory");
        }
    }
    __syncthreads();
}

struct Frame {
    LAS unsigned char* lds;
    volatile LAS unsigned* MISC;
    gu32* ctl;
    int tid, lane, wave, G, gw, NGW;
    const float* in[16];
    float* out; unsigned char* ws;
};
#define LOCAL_FRAME() Frame F = F0; { int t_ = threadIdx.x; asm volatile("" : "+v"(t_)); F.tid = t_; F.lane = t_ & 63; F.wave = __builtin_amdgcn_readfirstlane(t_ >> 6); \
    F.gw = blockIdx.x * NWAVES + F.wave; unsigned char* w_ = F0.ws; asm volatile("" : "+s"(w_)); F.ws = w_; }
__device__ __forceinline__ float wave_sum(float v) {
#pragma unroll
    for (int o = 1; o < 64; o <<= 1) v += __shfl_xor(v, o);
    return v;
}
__device__ __forceinline__ int ropemap(int j) { const int f = j >> 3, jj = j & 7; return jj < 4 ? 4 * f + jj : 16 + 4 * f + (jj - 4); }
__device__ __forceinline__ int src_in(int n) {
    const int t = n >> 8, c = n & 255;
    if (t == 0) return c < 192 ? c : -1;
    if (t == 1) return c < 128 ? 192 + c : (c < 160 ? 320 + ropemap(c - 128) : -1);
    return 352 + (t - 2) * 256 + c;
}
__device__ __forceinline__ int src_q(int n) {
    if (n < 256) return (n >> 6) * 96 + (n & 63);
    if (n < 384) { const int j = n - 256; return (j >> 5) * 96 + 64 + ropemap(j & 31); }
    return -1;
}
__device__ __forceinline__ int src_kv(int n) {
    if (n < 256) return (n >> 6) * 128 + (n & 63);
    const int j = n - 256; return (j >> 6) * 128 + 64 + (j & 63);
}
template <int MAP> __device__ __forceinline__ void cvt_weight(const float* W, const float* gv, bf16* Wt, int N, int K, int Ksrc, int Nsrc, int gt, int ngt) {
    const int items = N * (K / 8);
    for (int it = gt; it < items; it += ngt) {
        const int n = it % N, kc = it / N;
        const int sc = MAP == 0 ? src_in(n) : MAP == 1 ? src_q(n) : MAP == 2 ? src_kv(n) : n;
        float v[8];
#pragma unroll
        for (int i = 0; i < 8; ++i) { const int k = kc * 8 + i; v[i] = (sc >= 0 && k < Ksrc) ? W[(size_t)k * Nsrc + sc] * (gv ? gv[k] : 1.0f) : 0.0f; }
        v4u o; o.x = pk2(v[0], v[1]); o.y = pk2(v[2], v[3]); o.z = pk2(v[4], v[5]); o.w = pk2(v[6], v[7]);
        *(GAS v4u*)(Wt + (size_t)n * K + kc * 8) = o;
    }
}
__device__ __forceinline__ void row_to_bf16_rstd(const f32x4 (&v)[4], bf16* orow, float* rstd, int lane) {
    float s = 0.f;
#pragma unroll
    for (int j = 0; j < 4; ++j) s += (v[j][0] * v[j][0] + v[j][1] * v[j][1]) + (v[j][2] * v[j][2] + v[j][3] * v[j][3]);
    const float r = 1.0f / sqrtf(wave_sum(s) * (1.0f / 1024.0f) + NORM_EPS);
    if (lane == 0) *rstd = r;
#pragma unroll
    for (int j = 0; j < 4; ++j) *(GAS unsigned long long*)(orow + 4 * lane + 256 * j) = (unsigned long long)pk2(v[j][0], v[j][1]) | ((unsigned long long)pk2(v[j][2], v[j][3]) << 32);
}

__device__ __forceinline__ void p_prologue(Frame& F0) {
    LOCAL_FRAME();
    const int gt = blockIdx.x * NTHREADS + F.tid, ngt = F.G * NTHREADS;
    for (int l = 0; l < DEPTH; ++l) {
        cvt_weight<0>(F.in[2] + (size_t)l * DM * D_IN, F.in[1] + l * DM, (bf16*)(F.ws + WS_WIN) + (size_t)l * NU * DM, NU, DM, DM, D_IN, gt, ngt);
        cvt_weight<1>(F.in[4] + (size_t)l * 192 * 384, F.in[3] + l * 192, (bf16*)(F.ws + WS_WQ2) + (size_t)l * 512 * 256, 512, 256, 192, 384, gt, ngt);
        cvt_weight<2>(F.in[6] + (size_t)l * 128 * 512, F.in[5] + l * 128, (bf16*)(F.ws + WS_WKV2) + (size_t)l * 512 * 256, 512, 256, 128, 512, gt, ngt);
        cvt_weight<3>(F.in[12] + (size_t)l * 256 * 256, nullptr, (bf16*)(F.ws + WS_WPW) + (size_t)l * 256 * 256, 256, 256, 256, 256, gt, ngt);
        cvt_weight<3>(F.in[14] + (size_t)l * DM * DM, nullptr, (bf16*)(F.ws + WS_WOUT) + (size_t)l * DM * DM, DM, DM, DM, DM, gt, ngt);
    }
    float* cosT = (float*)(F.ws + WS_ROPE); float* sinT = cosT + SEQ * 16;
    for (int it = gt; it < SEQ * 16; it += ngt) { const int pos = it >> 4, i = it & 15;
        const float freq = powf(10000.0f, -(float)i / 16.0f); const float ang = (float)pos * freq;
        cosT[it] = cosf(ang); sinT[it] = sinf(ang); }
    float* BT = (float*)(F.ws + WS_BT);
    for (int it = gt; it < 4 * att::TBL_N; it += ngt) { const int h = it / att::TBL_N, idx = it % att::TBL_N; const int dist = idx - 256; const int n = dist > 0 ? dist : 0;
        int bucket;
        if (n < 16) bucket = n;
        else { bucket = 16 + (int)floor((log2((double)n) - 4.0) * (8.0 / 3.0) + 1e-9); if (bucket > 31) bucket = 31; }
        BT[it] = F.in[7][bucket * 4 + h] * 1.4426950408889634f; }
    const float* x = F.in[0]; bf16* XB = (bf16*)(F.ws + WS_XB); float* RS = (float*)(F.ws + WS_RSTD);
    for (int m0 = F.gw * 4; m0 < M; m0 += F.NGW * 4) { f32x4 v[4][4];
#pragma unroll
        for (int r = 0; r < 4; ++r)
#pragma unroll
            for (int j = 0; j < 4; ++j) v[r][j] = *(const f32x4*)(x + (size_t)(m0 + r) * DM + 4 * F.lane + 256 * j);
#pragma unroll
        for (int r = 0; r < 4; ++r) row_to_bf16_rstd(v[r], XB + (size_t)(m0 + r) * DM, RS + m0 + r, F.lane); }
}

__device__ __forceinline__ void conv_unit(Frame& F0, int l, int unit) {
    LOCAL_FRAME();
    const bf16* U = (const bf16*)(F.ws + WS_U); bf16* CH = (bf16*)(F.ws + WS_CONVH);
    LAS float* xg = (LAS float*)F.lds;
    const int r0 = unit * 64, s0 = r0 & (SEQ - 1);
    {
        v4u av[6], gv[6];
#pragma unroll
        for (int k = 0; k < 6; ++k) { const int it = F.tid + k * NTHREADS; const int rr = it >> 5, cg = it & 31; const int srow = r0 - 30 + rr;
            if (it < 94 * 32 && s0 - 30 + rr >= 0) { av[k] = *(const GAS v4u*)(U + (size_t)srow * NU + 2048 + cg * 8); gv[k] = *(const GAS v4u*)(U + (size_t)srow * NU + 2304 + cg * 8); }
            else { av[k] = (v4u){0u, 0u, 0u, 0u}; gv[k] = (v4u){0u, 0u, 0u, 0u}; } }
#pragma unroll
        for (int k = 0; k < 6; ++k) { const int it = F.tid + k * NTHREADS; const int rr = it >> 5, cg = it & 31;
            if (it < 94 * 32) {
                const float a8[8] = {pg8::bf_lo(av[k].x), pg8::bf_hi(av[k].x), pg8::bf_lo(av[k].y), pg8::bf_hi(av[k].y), pg8::bf_lo(av[k].z), pg8::bf_hi(av[k].z), pg8::bf_lo(av[k].w), pg8::bf_hi(av[k].w)};
                const float g8[8] = {pg8::bf_lo(gv[k].x), pg8::bf_hi(gv[k].x), pg8::bf_lo(gv[k].y), pg8::bf_hi(gv[k].y), pg8::bf_lo(gv[k].z), pg8::bf_hi(gv[k].z), pg8::bf_lo(gv[k].w), pg8::bf_hi(gv[k].w)};
                float o[8];
#pragma unroll
                for (int j = 0; j < 8; ++j) o[j] = a8[j] / (1.0f + __expf(-g8[j]));
                *(LAS f32x4*)(xg + rr * 256 + cg * 8) = (f32x4){o[0], o[1], o[2], o[3]}; *(LAS f32x4*)(xg + rr * 256 + cg * 8 + 4) = (f32x4){o[4], o[5], o[6], o[7]}; } }
    }
    __syncthreads();
    const int c = F.tid & 255, rh = F.tid >> 8;
    float y[32];
    { float win[62], wt[31];
      const float* dw = F.in[8] + (size_t)l * 31 * 256 + c;
#pragma unroll
      for (int w = 0; w < 31; ++w) wt[w] = dw[w * 256];
#pragma unroll
      for (int i = 0; i < 62; ++i) win[i] = xg[(rh * 32 + i) * 256 + c];
      const float bias = F.in[9][l * 256 + c];
#pragma unroll
      for (int s = 0; s < 32; ++s) { float a = bias;
#pragma unroll
          for (int w = 0; w < 31; ++w) a += wt[w] * win[s + w];
          y[s] = a; } }
    __syncthreads();
#pragma unroll
    for (int s = 0; s < 32; ++s) xg[(rh * 32 + s) * 256 + c] = y[s];
    __syncthreads();
    const f32x4 lg = *(const f32x4*)(F.in[10] + l * 256 + 4 * F.lane), lb = *(const f32x4*)(F.in[11] + l * 256 + 4 * F.lane);
#pragma unroll
    for (int i = 0; i < 8; ++i) { const int row = 8 * F.wave + i;
        const f32x4 v = *(LAS f32x4*)(xg + row * 256 + 4 * F.lane);
        const float mean = wave_sum((v[0] + v[1]) + (v[2] + v[3])) * (1.0f / 256.0f);
        const f32x4 d = v - mean;
        const float var = wave_sum((d[0] * d[0] + d[1] * d[1]) + (d[2] * d[2] + d[3] * d[3])) * (1.0f / 256.0f);
        const float rstd = 1.0f / sqrtf(var + NORM_EPS);
        f32x4 o = d * rstd * lg + lb;
#pragma unroll
        for (int j = 0; j < 4; ++j) o[j] = o[j] / (1.0f + __expf(-o[j]));
        *(GAS unsigned long long*)(CH + (size_t)(r0 + row) * 256 + 4 * F.lane) = (unsigned long long)pk2(o[0], o[1]) | ((unsigned long long)pk2(o[2], o[3]) << 32); }
    __syncthreads();
}
__device__ __forceinline__ void kmean_unit(Frame& F0, int item) {
    LOCAL_FRAME();
    const bf16* U = (const bf16*)(F.ws + WS_U); float* KM = (float*)(F.ws + WS_KMEAN);
    LAS float* part = (LAS float*)F.lds;
    const int cg = F.tid & 31, rg = F.tid >> 5; const size_t base = (size_t)item * 256 + rg * 16;
    float a[8];
#pragma unroll
    for (int j = 0; j < 8; ++j) a[j] = 0.f;
#pragma unroll
    for (int i = 0; i < 16; ++i) { const v4u k = *(const GAS v4u*)(U + (base + i) * NU + 1536 + cg * 8);
        a[0] += pg8::bf_lo(k.x); a[1] += pg8::bf_hi(k.x); a[2] += pg8::bf_lo(k.y); a[3] += pg8::bf_hi(k.y); a[4] += pg8::bf_lo(k.z); a[5] += pg8::bf_hi(k.z); a[6] += pg8::bf_lo(k.w); a[7] += pg8::bf_hi(k.w); }
#pragma unroll
    for (int j = 0; j < 8; ++j) part[rg * 256 + cg * 8 + j] = a[j];
    __syncthreads();
    if (F.tid < 256) { float s = 0.f;
#pragma unroll
        for (int r = 0; r < 16; ++r) s += part[r * 256 + F.tid];
        KM[(size_t)item * 256 + F.tid] = s * (1.0f / 256.0f); }
    __syncthreads();
}
__device__ __forceinline__ void p_residual(Frame& F0, int l) {
    LOCAL_FRAME();
    bf16* XB = (bf16*)(F.ws + WS_XB); float* RS = (float*)(F.ws + WS_RSTD);
    const bf16* T = (const bf16*)(F.ws + WS_U); const float* SS = (const float*)(F.ws + WS_SSQO);
    const float* gp = F.in[15] + l * DM;
    f32x4 g[2][2];
#pragma unroll
    for (int j = 0; j < 2; ++j) { g[j][0] = *(const f32x4*)(gp + 8 * F.lane + 512 * j); g[j][1] = *(const f32x4*)(gp + 8 * F.lane + 512 * j + 4); }
    constexpr int R = 4;
    for (int m0 = F.gw * R; m0 < M; m0 += F.NGW * R) {
        v4u xw[R][2], tw[R][2]; f32x4 sq[R][4];
#pragma unroll
        for (int r = 0; r < R; ++r) { const size_t m = (size_t)(m0 + r);
#pragma unroll
            for (int j = 0; j < 2; ++j) { xw[r][j] = *(const GAS v4u*)(XB + m * DM + 8 * F.lane + 512 * j); tw[r][j] = *(const GAS v4u*)(T + m * DM + 8 * F.lane + 512 * j); }
#pragma unroll
            for (int q = 0; q < 4; ++q) sq[r][q] = *(const f32x4*)(SS + m * 16 + 4 * q); }
#pragma unroll
        for (int r = 0; r < R; ++r) { const size_t m = (size_t)(m0 + r);
            const float ss = (((sq[r][0][0] + sq[r][0][1]) + (sq[r][0][2] + sq[r][0][3])) + ((sq[r][1][0] + sq[r][1][1]) + (sq[r][1][2] + sq[r][1][3]))) + (((sq[r][2][0] + sq[r][2][1]) + (sq[r][2][2] + sq[r][2][3])) + ((sq[r][3][0] + sq[r][3][1]) + (sq[r][3][2] + sq[r][3][3])));
            const float rstd = 1.0f / sqrtf(ss * (1.0f / 1024.0f) + NORM_EPS);
            f32x4 v[2][2]; float s2 = 0.f;
#pragma unroll
            for (int j = 0; j < 2; ++j) {
                const f32x4 xa = (f32x4){pg8::bf_lo(xw[r][j].x), pg8::bf_hi(xw[r][j].x), pg8::bf_lo(xw[r][j].y), pg8::bf_hi(xw[r][j].y)}, xb = (f32x4){pg8::bf_lo(xw[r][j].z), pg8::bf_hi(xw[r][j].z), pg8::bf_lo(xw[r][j].w), pg8::bf_hi(xw[r][j].w)};
                const f32x4 ta = (f32x4){pg8::bf_lo(tw[r][j].x), pg8::bf_hi(tw[r][j].x), pg8::bf_lo(tw[r][j].y), pg8::bf_hi(tw[r][j].y)}, tb = (f32x4){pg8::bf_lo(tw[r][j].z), pg8::bf_hi(tw[r][j].z), pg8::bf_lo(tw[r][j].w), pg8::bf_hi(tw[r][j].w)};
                v[j][0] = xa + ta * rstd * g[j][0]; v[j][1] = xb + tb * rstd * g[j][1];
#pragma unroll
                for (int h = 0; h < 2; ++h) s2 += (v[j][h][0] * v[j][h][0] + v[j][h][1] * v[j][h][1]) + (v[j][h][2] * v[j][h][2] + v[j][h][3] * v[j][h][3]); }
            if (l + 1 < DEPTH) {
                const float rn = 1.0f / sqrtf(wave_sum(s2) * (1.0f / 1024.0f) + NORM_EPS);
                if (F.lane == 0) RS[m] = rn;
#pragma unroll
                for (int j = 0; j < 2; ++j) { v4u o; o.x = pk2(v[j][0][0], v[j][0][1]); o.y = pk2(v[j][0][2], v[j][0][3]); o.z = pk2(v[j][1][0], v[j][1][1]); o.w = pk2(v[j][1][2], v[j][1][3]);
                    *(GAS v4u*)(XB + m * DM + 8 * F.lane + 512 * j) = o; }
            } else {
#pragma unroll
                for (int j = 0; j < 2; ++j) { *(f32x4*)(F.out + m * DM + 8 * F.lane + 512 * j) = v[j][0]; *(f32x4*)(F.out + m * DM + 8 * F.lane + 512 * j + 4) = v[j][1]; }
            }
        }
    }
}


#if defined(DBG_SEL)
#ifndef DBG_LAYER
#define DBG_LAYER 0
#endif
#ifndef DBG_AMP
#define DBG_AMP 4.0f
#endif
constexpr int CW_DBG = 12288;
__device__ __forceinline__ float blk_sum(float v, LAS float* red, int tid) {
    v = wave_sum(v);
    __syncthreads();
    if ((tid & 63) == 0) red[tid >> 6] = v;
    __syncthreads();
    float s = 0.f;
#pragma unroll
    for (int i = 0; i < 8; ++i) s += red[i];
    __syncthreads();
    return s;
}
__device__ __forceinline__ float blk_max(float v, LAS float* red, int tid) {
#pragma unroll
    for (int o = 1; o < 64; o <<= 1) v = fmaxf(v, __shfl_xor(v, o));
    __syncthreads();
    if ((tid & 63) == 0) red[tid >> 6] = v;
    __syncthreads();
    float s = red[0];
#pragma unroll
    for (int i = 1; i < 8; ++i) s = fmaxf(s, red[i]);
    __syncthreads();
    return s;
}
__device__ __forceinline__ float bfv(const bf16* p) { return __uint_as_float(((unsigned)*p) << 16); }
__device__ __forceinline__ int dbg_bucket(int dist) { const int n = dist > 0 ? dist : 0; if (n < 16) return n; int b = 16 + (int)(log((double)n / 16.0) / log(64.0) * 16.0 + 1e-9); return b > 31 ? 31 : b; }
__device__ __forceinline__ void dbg_report(Frame& F, float num, float den, int tid) {
    if (tid == 0) { float e = sqrtf(num) / fmaxf(sqrtf(den), 1e-20f); if (!(e == e)) e = 100.f; atomicMax((unsigned*)(F.ctl + CW_DBG), __float_as_uint(e)); }
}
__device__ __forceinline__ void dbg_task(Frame& F, int l, int mixer, int b, int t, int h) {
    const int tid = threadIdx.x;
    const bf16* U = (const bf16*)(F.ws + WS_U); const bf16* Y = (const bf16*)(F.ws + WS_HNY);
    LAS float* sc = (LAS float*)F.lds;
    LAS float* aux = sc + 4096;
    LAS float* qv = aux + 4096;
    LAS float* vec = qv + 128;
    LAS float* red = vec + 256;
    LAS int* sel = (LAS int*)(red + 16);
    const size_t row = (size_t)b * SEQ + t; const size_t rb = (size_t)b * SEQ;
    float yn = 0.f, ycmp = 0.f; int ycol = 0;
    __syncthreads();
    if (mixer == 0) {
        const float* guq = F.in[3] + l * 192; const float* wuq = F.in[4] + (size_t)l * 192 * 384;
        const float* gkv = F.in[5] + l * 128; const float* wukv = F.in[6] + (size_t)l * 128 * 512;
        float ssq = 0.f;
        for (int r = 0; r < 192; ++r) { const float c = bfv(U + row * NU + r); ssq += c * c; }
        const float rq = 1.0f / sqrtf(ssq / 192.0f + NORM_EPS);
        if (tid < 96) { float a = 0.f; for (int r = 0; r < 192; ++r) a += bfv(U + row * NU + r) * rq * guq[r] * wuq[r * 384 + h * 96 + tid]; qv[tid] = a; }
        __syncthreads();
        if (tid < 16) { const float fr = powf(10000.0f, -(float)tid / 16.0f), ang = (float)t * fr, c = cosf(ang), s = sinf(ang); const float x1 = qv[64 + tid], x2 = qv[80 + tid]; qv[64 + tid] = x1 * c - x2 * s; qv[80 + tid] = x1 * s + x2 * c; }
        __syncthreads();
        if (tid < 128) { float a = 0.f; for (int d = 0; d < 64; ++d) a += wukv[tid * 512 + h * 128 + d] * qv[d]; vec[tid] = a * gkv[tid]; }
        __syncthreads();
        const float scale = 0.10206207261596575f;
        for (int s = tid; s <= t; s += NTHREADS) {
            const bf16* ur = U + (rb + s) * NU + 256;
            float ss = 0.f, dn = 0.f;
            for (int r = 0; r < 128; ++r) { const float c = bfv(ur + r); ss += c * c; dn += c * vec[r]; }
            const float rk = 1.0f / sqrtf(ss / 128.0f + NORM_EPS);
            aux[s] = rk;
            float dr = 0.f;
            for (int i = 0; i < 16; ++i) {
                const int f = i >> 2, jj = i & 3; const float x1 = bfv(ur + 128 + 8 * f + jj), x2 = bfv(ur + 128 + 8 * f + 4 + jj);
                const float fr = powf(10000.0f, -(float)i / 16.0f), ang = (float)s * fr, c = cosf(ang), sn = sinf(ang);
                dr += (x1 * c - x2 * sn) * qv[64 + i] + (x1 * sn + x2 * c) * qv[80 + i]; }
            sc[s] = (dn * rk + dr) * scale;
        }
        __syncthreads();
        float mx = -INFINITY; for (int s = tid; s <= t; s += NTHREADS) mx = fmaxf(mx, sc[s]);
        mx = blk_max(mx, red, tid);
        float sm = 0.f; for (int s = tid; s <= t; s += NTHREADS) { const float p = expf(sc[s] - mx); sc[s] = p; sm += p; }
        sm = blk_sum(sm, red, tid);
        { const int r = tid & 127, q4 = tid >> 7; float a = 0.f;
          for (int s = q4; s <= t; s += 4) a += sc[s] * bfv(U + (rb + s) * NU + 256 + r) * aux[s];
          __syncthreads(); ((LAS float*)F.lds)[8192 + 512 + tid] = a; __syncthreads();
          if (tid < 128) vec[128 + tid] = (((LAS float*)F.lds)[8192 + 512 + tid] + ((LAS float*)F.lds)[8192 + 512 + 128 + tid] + ((LAS float*)F.lds)[8192 + 512 + 256 + tid] + ((LAS float*)F.lds)[8192 + 512 + 384 + tid]) * gkv[tid] / sm; }
        __syncthreads();
        if (tid < 64) { float o = 0.f; for (int r = 0; r < 128; ++r) o += vec[128 + r] * wukv[r * 512 + h * 128 + 64 + tid]; yn = o; }
        ycol = h * 64;
    } else if (mixer == 1) {
        const bf16* qp = U + row * NU + 512 + h * 64;
        if (tid < 64) qv[tid] = bfv(qp + tid) / LOG2E;
        __syncthreads();
        for (int s = tid; s < t; s += NTHREADS) { const bf16* kp = U + (rb + s) * NU + 768 + h * 64; float z = 0.f; for (int d = 0; d < 64; ++d) z += qv[d] * bfv(kp + d);
            const float sp = fmaxf(z, 0.f) + log1pf(expf(-fabsf(z)));
            sc[s] = z - sp;
            aux[s] = -sp; }
        __syncthreads();
        if (tid == 0) { float run = 0.f; for (int s = t - 1; s >= 0; --s) { const float a = expf(sc[s] + run); run += aux[s]; sc[s] = a; } }
        __syncthreads();
        if (tid < 64) { float o = 0.f; for (int s = 0; s < t; ++s) { const float a = sc[s]; if (a != 0.f) o += a * bfv(U + (rb + s) * NU + 1024 + h * 64 + tid); } yn = o; }
        ycol = 256 + h * 64;
    } else {
        const bf16* qp = U + row * NU + 1280 + h * 64;
        if (tid < 64) qv[tid] = bfv(qp + tid) / LOG2E;
        __syncthreads();
        const int own = t >> 8;
        { const int j = tid >> 5, dg = tid & 31; float g = 0.f;
          if (j < own) { float m0 = 0.f, m1 = 0.f; for (int s = 0; s < 256; ++s) { const bf16* kp = U + (rb + j * 256 + s) * NU + 1536 + h * 64 + 2 * dg; m0 += bfv(kp); m1 += bfv(kp + 1); }
              g = (m0 * qv[2 * dg] + m1 * qv[2 * dg + 1]) * (1.0f / 256.0f); }
#pragma unroll
          for (int o = 1; o < 32; o <<= 1) g += __shfl_xor(g, o);
          if (dg == 0) vec[j] = (j < own) ? g : -INFINITY; }
        __syncthreads();
        if (tid == 0) { float v1 = -INFINITY, v2 = -INFINITY, v3 = -INFINITY; int i1 = -1, i2 = -1, i3 = -1;
            for (int j = 0; j < own; ++j) { const float g = vec[j];
                if (g > v1) { v3 = v2; i3 = i2; v2 = v1; i2 = i1; v1 = g; i1 = j; } else if (g > v2) { v3 = v2; i3 = i2; v2 = g; i2 = j; } else if (g > v3) { v3 = g; i3 = j; } }
            sel[0] = i1; sel[1] = i2; sel[2] = i3; }
        __syncthreads();
        const int s0 = sel[0], s1 = sel[1], s2 = sel[2];
        const float* rb_ = F.in[7];
        for (int s = tid; s <= t; s += NTHREADS) { const int blk = s >> 8; const bool ok = (blk == own) || blk == s0 || blk == s1 || blk == s2;
            float z = -INFINITY;
            if (ok) { const bf16* kp = U + (rb + s) * NU + 1536 + h * 64; z = 0.f; for (int d = 0; d < 64; ++d) z += qv[d] * bfv(kp + d); z += rb_[dbg_bucket(t - s) * 4 + h]; }
            sc[s] = z; }
        __syncthreads();
        float mx = -INFINITY; for (int s = tid; s <= t; s += NTHREADS) mx = fmaxf(mx, sc[s]);
        mx = blk_max(mx, red, tid);
        float sm = 0.f; for (int s = tid; s <= t; s += NTHREADS) { const float p = expf(sc[s] - mx); sc[s] = p; sm += p; }
        sm = blk_sum(sm, red, tid);
        if (tid < 64) { float o = 0.f; for (int s = 0; s <= t; ++s) { const float p = sc[s]; if (p != 0.f) o += p * bfv(U + (rb + s) * NU + 1792 + h * 64 + tid); } yn = o / sm; }
        ycol = 512 + h * 64;
    }
    float num = 0.f, den = 0.f;
    if (tid < 64) { const float g = bfv(U + row * NU + 2560 + ycol + tid); yn *= g / (1.0f + expf(-g)); ycmp = bfv(Y + row * DM + ycol + tid); num = (ycmp - yn) * (ycmp - yn); den = yn * yn; }
    num = blk_sum(num, red, tid); den = blk_sum(den, red, tid);
    dbg_report(F, num, den, tid);
    __syncthreads();
}
__device__ __forceinline__ void dbg_check(Frame& F, int l) {
    constexpr int ts[24] = {0, 1, 2, 5, 17, 31, 32, 33, 63, 64, 100, 255, 256, 257, 300, 511, 512, 1000, 1023, 1024, 2047, 2048, 3000, 4095};
    for (int task = blockIdx.x; task < 576; task += F.G) {
        const int h = task & 3, ti = (task >> 2) % 24, bb = (task / 96) & 1, mixer = task / 192;
        if (!((DBG_SEL >> mixer) & 1)) continue;
        int t = 0;
#pragma unroll
        for (int i = 0; i < 24; ++i) if (i == ti) t = ts[i];
        dbg_task(F, l, mixer, bb ? 7 : 0, t, h);
    }
}
__device__ __forceinline__ void dbg_check_u(Frame& F, int l) {
    if (blockIdx.x != 0) return;
    const bf16* U = (const bf16*)(F.ws + WS_U); const bf16* HN = (const bf16*)(F.ws + WS_XB); const float* W = F.in[2] + (size_t)l * DM * D_IN;
    const int tid = threadIdx.x;
    const int rsel = tid >> 7, cs = tid & 127;
    const size_t row = rsel == 0 ? 0 : rsel == 1 ? 4097 : rsel == 2 ? 20000 : 32767;
    int ucol, src;
    if (cs < 32) { ucol = 256 + 128 + cs; src = 320 + ropemap(cs); }
    else if (cs < 64) { const int c = 6 * (cs - 32); ucol = c; src = c; }
    else if (cs < 96) { const int c = 4 * (cs - 64); ucol = 256 + c; src = 192 + c; }
    else { const int k = cs - 96; const int tile = 2 + (k % 12), c = (k * 37) & 255; ucol = tile * 256 + c; src = 352 + (tile - 2) * 256 + c; }
    float a = 0.f;
    for (int k = 0; k < DM; ++k) a += bfv(HN + row * DM + k) * F.in[1][l * DM + k] * W[(size_t)k * D_IN + src];
    a *= ((const float*)(F.ws + WS_RSTD))[row];
    if (ucol >= 512 && ucol < 768) a *= QSCALE_64;
    if (ucol >= 1280 && ucol < 1536) a *= QSCALE_64;
    const float u = bfv(U + row * NU + ucol);
    float e = fabsf(u - a) / (fabsf(a) + 0.05f); if (!(e == e)) e = 100.f;
    atomicMax((unsigned*)(F.ctl + CW_DBG), __float_as_uint(e));
}
#endif
struct Args { const float* in[16]; float* out; unsigned char* ws; int mode, pad; };
__global__ void __launch_bounds__(NTHREADS, 2) hymba_fwd(Args args) {
    extern __shared__ __attribute__((aligned(16))) unsigned char lds[];
    Frame F;
    F.lds = (LAS unsigned char*)lds;
    F.MISC = (volatile LAS unsigned*)(F.lds + MISC_OFF);
    F.tid = threadIdx.x; F.lane = F.tid & 63; F.wave = __builtin_amdgcn_readfirstlane(F.tid >> 6);
    F.G = gridDim.x; F.gw = blockIdx.x * NWAVES + F.wave; F.NGW = F.G * NWAVES;
#pragma unroll
    for (int i = 0; i < 16; ++i) F.in[i] = args.in[i];
    F.out = args.out; F.ws = args.ws; F.ctl = (gu32*)(args.ws + WS_CTL);
#if defined(ZERO_ALL_LDS)
    for (int u = F.tid; u < LDS_BYTES / 4; u += NTHREADS) ((LAS unsigned*)(F.lds))[u] = 0u;
#endif
    for (int u = F.tid; u < (LDS_BYTES - LDSCTL_OFF) / 4; u += NTHREADS) ((LAS unsigned*)(F.lds + LDSCTL_OFF))[u] = 0u;
    __syncthreads();
    { const unsigned simd = (unsigned)__builtin_amdgcn_s_getreg((1 << 11) | (4 << 6) | 4) & 3u; if (F.lane == 0) F.MISC[32 + F.wave] = simd; }
    __syncthreads();
    int whalf = 0;
    { const unsigned me = F.MISC[32 + F.wave]; int rank = 0;
#pragma unroll
      for (int j = 0; j < NWAVES; ++j) rank += (j < F.wave && F.MISC[32 + j] == me) ? 1 : 0;
#if defined(ANTI_HALF)
      whalf = __builtin_amdgcn_readfirstlane((int)(me & 1u)); }
#else
      whalf = __builtin_amdgcn_readfirstlane(rank & 1); }
#endif
    XcdBarrier bar = xcd_barrier_post((unsigned*)(F.ctl + CW_BAR), F.MISC + 8);
    const unsigned lds0 = (unsigned)(uintptr_t)lds;
#ifndef DUP_PHASE
#define DUP_PHASE 0
#endif
#if DUP_PHASE
#define DUP_BEGIN(k) _Pragma("nounroll") for (int rep_ = 0; rep_ < ((DUP_PHASE == (k)) ? 2 : 1); ++rep_) { if (rep_) GRID_BAR();
#define DUP_END(k) }
#define DUP_REP rep_
#else
#define DUP_BEGIN(k) { const int rep_ = 0; (void)rep_;
#define DUP_END(k) }
#define DUP_REP 0
#endif
#define GRID_BAR() do { XcdBarrier b_ = bar; asm volatile("" : "+s"(b_.x)); xcd_barrier(b_); } while (0)

#define PHASE_PTRS() unsigned char* ws_ = F.ws; asm volatile("" : "+s"(ws_)); \
    bf16* const HNY = (bf16*)(ws_ + WS_HNY); bf16* const UB = (bf16*)(ws_ + WS_U); \
    float* const SSQQ = (float*)(ws_ + WS_SSQQ); float* const SSQKV = (float*)(ws_ + WS_SSQKV); float* const SSQO = (float*)(ws_ + WS_SSQO); \
    bf16* const KRB = (bf16*)(ws_ + WS_KR); bf16* const QAB = (bf16*)(ws_ + WS_QA); bf16* const KVAB = (bf16*)(ws_ + WS_KVA); bf16* const CHB = (bf16*)(ws_ + WS_CONVH); \
    const float* const cosT = (const float*)(ws_ + WS_ROPE); const float* const sinT = cosT + SEQ * 16; \
    (void)HNY; (void)UB; (void)SSQQ; (void)SSQKV; (void)SSQO; (void)KRB; (void)QAB; (void)KVAB; (void)CHB; (void)cosT; (void)sinT

#if PH_EN(0)
    p_prologue(F);
#if DUP_PHASE == 9
    GRID_BAR(); p_prologue(F);
#endif
#endif
    GRID_BAR();

    for (int l = 0; l < DEPTH; ++l) {
#if PH_EN(1)
        DUP_BEGIN(1)
        {
            PHASE_PTRS();
            pg8::Gemm g{(const bf16*)(ws_ + WS_XB), (const bf16*)(ws_ + WS_WIN) + (size_t)l * NU * DM, M, NU, DM, DM}; pg8::StaticOrder S; S.init(M, NU, F.G, (int)blockIdx.x);
            pg8::EpiIn E{UB, SSQQ, SSQKV, KRB, cosT, sinT, QSCALE_64, (const float*)(ws_ + WS_RSTD)};
            pg8::gemm_phase<pg8::EpiIn, pg8::StaticOrder, true, true>(F.lds + RING_OFF, g, S, E);
        }
        DUP_END(1)
#endif
        GRID_BAR();
        if (args.mode == 2) return;
        DUP_BEGIN(2)
#if PH_EN(2)
        {
            PHASE_PTRS();
            pg8::Gemm g{UB, (const bf16*)(ws_ + WS_WQ2) + (size_t)l * 512 * 256, M, 512, 256, NU}; pg8::StaticOrder S; S.init(M, 512, F.G, (int)blockIdx.x);
            pg8::EpiQ E{QAB, SSQQ, cosT, sinT, QSCALE_96, NORM_EPS};
            pg8::gemm_phase<pg8::EpiQ, pg8::StaticOrder, true, true>(F.lds + RING_OFF, g, S, E);
        }
        __syncthreads();
#endif
#if PH_EN(8)
        {
            PHASE_PTRS();
            pg8::Gemm g{UB + 256, (const bf16*)(ws_ + WS_WKV2) + (size_t)l * 512 * 256, M, 512, 256, NU}; pg8::StaticOrder S; S.init(M, 512, F.G, (int)blockIdx.x);
            pg8::EpiKV E{KVAB, SSQKV, NORM_EPS};
            pg8::gemm_phase<pg8::EpiKV, pg8::StaticOrder, true, true>(F.lds + RING_OFF, g, S, E);
        }
        __syncthreads();
#endif
#if PH_EN(3)
        for (int u = blockIdx.x; u < M / 64; u += F.G) conv_unit(F, l, u);
        for (int it = blockIdx.x; it < BATCH * 16; it += F.G) kmean_unit(F, it);
#endif
        DUP_END(2)
        GRID_BAR();
        DUP_BEGIN(3)
#if PH_EN(4)
        {
            PHASE_PTRS();
            pg8::Gemm g{CHB, (const bf16*)(ws_ + WS_WPW) + (size_t)l * 256 * 256, M, 256, 256, 256}; pg8::StaticOrder S; S.init(M, 256, F.G, (int)blockIdx.x);
            pg8::EpiPW E{HNY, UB, F.in[13] + l * 256};
            pg8::gemm_phase<pg8::EpiPW, pg8::StaticOrder, true, true>(F.lds + RING_OFF, g, S, E);
        }
        __syncthreads();
#endif
#if PH_EN(5)
        {
            PHASE_PTRS();
            const att::Tensors AT{UB, QAB, KVAB, KRB, HNY, (const float*)(ws_ + WS_BT), (const float*)(ws_ + WS_KMEAN), 1024, 0};
            const int x0 = (int)(xb_xcc_id() & 7u);
            int xcur = x0;
            gu32* const qbase = F.ctl + CW_QUEUE + (l * 8) * 64 + 16 * DUP_REP;
            gu32* qctr = qbase + x0 * 64;
            for (;;) {
                if (F.tid == 0) F.MISC[16] = __hip_atomic_fetch_add(qctr, 1u, RLX_AGENT);
                __syncthreads();
                const int idx = (int)F.MISC[16];
                if (idx >= 192) {
                    __syncthreads();
                    { int t8 = (int)threadIdx.x; asm volatile("" : "+v"(t8));
                      if (t8 < 8) F.MISC[24 + t8] = __hip_atomic_load(qbase + t8 * 64, RLX_AGENT); }
                    __syncthreads();
                    int best = -1; unsigned bv = 192u;
#pragma unroll
                    for (int j = 0; j < 8; ++j) { const unsigned v = F.MISC[24 + j]; if (v < bv) { bv = v; best = j; } }
                    __syncthreads();
                    best = __builtin_amdgcn_readfirstlane(best);
                    if (best < 0) break;
                    xcur = best; qctr = qbase + best * 64; continue;
                }
                int type, qb, bh;
                if (idx < 128) { const int g = idx >> 5, j = idx & 31; type = (j < 16) ? 0 : 2; qb = 15 - (j & 15); bh = xcur * 4 + g; }
                else { const int s = idx - 128; type = 1; qb = 15 - (s & 15); bh = xcur * 4 + (s >> 4); }
                const int b = bh >> 2, h = bh & 3;
#if defined(DUP_TYPE)
                if (DUP_REP == 1 && type != DUP_TYPE) { __syncthreads(); continue; }
#endif
#if defined(CMP_TUNED)
                if (DUP_REP == 1) { if (type == 2 && l == 0) { att::Tensors A2 = AT; A2.Y = QAB; A2.ypitch = 256; A2.ysub = 512; att::moba_unit_tuned(A2, b, h, qb, (LAS char*)(F.lds + RING_OFF), lds0 + RING_OFF); } else __syncthreads(); continue; }
#endif
#if defined(DUP_KNOB)
                if (DUP_REP == 1) { att::attn_unit<DUP_TYPE, DUP_KNOB>(AT, b, h, qb, (LAS char*)(F.lds + RING_OFF), lds0 + RING_OFF, whalf); continue; }
#endif
#if defined(TUNED_MLA)
                if (type == 0) att::mla_unit_tuned(AT, b, h, qb, (LAS char*)(F.lds + RING_OFF), lds0 + RING_OFF);
#else
                if (type == 0) att::attn_unit<0>(AT, b, h, qb, (LAS char*)(F.lds + RING_OFF), lds0 + RING_OFF, whalf);
#endif
#if !defined(TUNED_MOBA)
                else if (type == 2) att::attn_unit<2>(AT, b, h, qb, (LAS char*)(F.lds + RING_OFF), lds0 + RING_OFF, whalf);
#else
#if defined(TUNED_QB_LO)
                else if (type == 2 && qb >= TUNED_QB_LO && qb <= TUNED_QB_HI) att::moba_unit_tuned(AT, b, h, qb, (LAS char*)(F.lds + RING_OFF), lds0 + RING_OFF);
                else if (type == 2) att::attn_unit<2>(AT, b, h, qb, (LAS char*)(F.lds + RING_OFF), lds0 + RING_OFF, whalf);
#else
                else if (type == 2) att::moba_unit_tuned(AT, b, h, qb, (LAS char*)(F.lds + RING_OFF), lds0 + RING_OFF);
#endif
#endif
#if defined(SB_RES)
                else att::sb_unit_res(AT, b, h, qb, (LAS char*)(F.lds + RING_OFF), lds0 + RING_OFF, (LAS unsigned*)(F.MISC + 48));
#else
                else att::attn_unit<1>(AT, b, h, qb, (LAS char*)(F.lds + RING_OFF), lds0 + RING_OFF, whalf);
#endif
            }
        }
#endif
        DUP_END(3)
        GRID_BAR();
#if defined(CMP_TUNED)
        if (l == 0) {
            PHASE_PTRS();
            float best = 0.f;
            int t_ = threadIdx.x; asm volatile("" : "+v"(t_)); const int lane_ = t_ & 63; const int gw_ = blockIdx.x * NWAVES + __builtin_amdgcn_readfirstlane(t_ >> 6);
            for (int m = gw_; m < M; m += F.NGW) {
                float num = 0.f, den = 0.f;
#pragma unroll
                for (int j = 0; j < 4; ++j) { const float ya = __uint_as_float(((unsigned)HNY[(size_t)m * 1024 + 512 + lane_ * 4 + j]) << 16), yb = __uint_as_float(((unsigned)QAB[(size_t)m * 256 + lane_ * 4 + j]) << 16);
                    num += (ya - yb) * (ya - yb); den += ya * ya; }
#pragma unroll
                for (int o = 1; o < 16; o <<= 1) { num += __shfl_xor(num, o); den += __shfl_xor(den, o); }
                float e = sqrtf(num) / (sqrtf(den) + 1e-4f); if (!(e == e)) e = 1000.f;
#if CMP_TUNED == 2
                e = (e > 0.05f) ? (float)(1 + (m & 4095)) : 0.f;
#endif
                best = fmaxf(best, e);
            }
#pragma unroll
            for (int o = 1; o < 64; o <<= 1) best = fmaxf(best, __shfl_xor(best, o));
            if (lane_ == 0) atomicMax((unsigned*)(F.ctl + 12290), __float_as_uint(best));
        }
#endif
        if (args.mode == 1) return;
#if PH_EN(6)
        DUP_BEGIN(4)
        {
            PHASE_PTRS();
            pg8::Gemm g{HNY, (const bf16*)(ws_ + WS_WOUT) + (size_t)l * DM * DM, M, DM, DM, DM}; pg8::StaticOrder S; S.init(M, DM, F.G, (int)blockIdx.x);
            pg8::EpiOut E{UB, SSQO};
            pg8::gemm_phase<pg8::EpiOut, pg8::StaticOrder, true, true>(F.lds + RING_OFF, g, S, E);
        }
        DUP_END(4)
#endif
        GRID_BAR();
#if PH_EN(7)
        p_residual(F, l);
#if DUP_PHASE == 5
        if (l == 0) { GRID_BAR(); p_residual(F, l); }
#endif
#if DUP_PHASE == 6
        GRID_BAR(); GRID_BAR(); GRID_BAR(); GRID_BAR();
#endif
#endif
        if (l + 1 < DEPTH) GRID_BAR();
    }
#if defined(CMP_TUNED)
    GRID_BAR();
    { const float e = __uint_as_float(__hip_atomic_load(F.ctl + 12290, RLX_AGENT));
#if CMP_TUNED == 1
      const float sc = 1.0f + fminf(e, 3.0f);
#else
      const float sc = 1.0f + e / 4096.0f;
#endif
      for (size_t i = (size_t)blockIdx.x * NTHREADS + threadIdx.x; i < (size_t)M * DM; i += (size_t)F.G * NTHREADS) F.out[i] *= sc; }
#endif
}

#if defined(DBG_SEL)
__global__ void __launch_bounds__(NTHREADS, 1) dbg_kernel(Args args, int which) {
    extern __shared__ __attribute__((aligned(16))) unsigned char lds[];
    Frame F; F.lds = (LAS unsigned char*)lds; F.MISC = nullptr; F.tid = threadIdx.x; F.lane = F.tid & 63; F.wave = F.tid >> 6; F.G = gridDim.x; F.gw = 0; F.NGW = 0;
    for (int i = 0; i < 16; ++i) F.in[i] = args.in[i];
    F.out = args.out; F.ws = args.ws; F.ctl = (gu32*)(args.ws + WS_CTL);
    if (which == 0) dbg_check_u(F, 0);
    else if (which == 1) dbg_check(F, 0);
    else { const float e = __uint_as_float(__hip_atomic_load(F.ctl + CW_DBG, RLX_AGENT)); const float sc = 1.0f + fminf(2.0f, DBG_AMP * e);
      for (size_t i = (size_t)blockIdx.x * NTHREADS + threadIdx.x; i < (size_t)M * DM; i += (size_t)F.G * NTHREADS) F.out[i] *= sc; }
}
#endif
extern "C" void kernel_launch(void* const* d_in, const int* in_sizes, int n_in, void* d_out, int out_size, void* d_ws, size_t ws_size, hipStream_t stream) {
    static int grid = 0;
    if (grid == 0) {
        if (n_in != 16 || in_sizes[0] != M * DM || out_size != M * DM || ws_size < WS_END) { fprintf(stderr, "kernel_launch: unexpected shapes (n_in %d, in0 %d, out %d, ws %zu < %zu); nothing launched\n", n_in, n_in > 0 ? in_sizes[0] : -1, out_size, ws_size, (size_t)WS_END); grid = -1; return; }
        int dev = 0, cus = 0, per_cu = 0;
        if (hipGetDevice(&dev) != hipSuccess || hipDeviceGetAttribute(&cus, hipDeviceAttributeMultiprocessorCount, dev) != hipSuccess) { grid = -1; return; }
        if (hipFuncSetAttribute((const void*)hymba_fwd, hipFuncAttributeMaxDynamicSharedMemorySize, LDS_BYTES) != hipSuccess) { fprintf(stderr, "kernel_launch: hipFuncSetAttribute failed\n"); grid = -1; return; }
        if (hipOccupancyMaxActiveBlocksPerMultiprocessor(&per_cu, (const void*)hymba_fwd, NTHREADS, LDS_BYTES) != hipSuccess || per_cu < 1) fprintf(stderr, "kernel_launch: occupancy query reports %d\n", per_cu);
        (void)hipGetLastError();
        grid = cus;
    }
    if (grid < 0) return;
    if (hipMemsetAsync((char*)d_ws + WS_CTL, 0, CTL_ZERO_BYTES, stream) != hipSuccess) return;
    Args a{};
    for (int i = 0; i < 16; ++i) a.in[i] = (const float*)d_in[i];
    a.out = (float*)d_out; a.ws = (unsigned char*)d_ws; a.mode = 0; a.pad = 0;
#if defined(DBG_SEL)
    hipFuncSetAttribute((const void*)dbg_kernel, hipFuncAttributeMaxDynamicSharedMemorySize, LDS_BYTES);
    if ((DBG_SEL >> 3) & 1) { a.mode = 2; hipLaunchKernelGGL(hymba_fwd, dim3(grid), dim3(NTHREADS), LDS_BYTES, stream, a); hipLaunchKernelGGL(dbg_kernel, dim3(grid), dim3(NTHREADS), LDS_BYTES, stream, a, 0); hipMemsetAsync((char*)d_ws + WS_CTL, 0, 49152, stream); }
    if (DBG_SEL & 7) { a.mode = 1; hipLaunchKernelGGL(hymba_fwd, dim3(grid), dim3(NTHREADS), LDS_BYTES, stream, a); hipLaunchKernelGGL(dbg_kernel, dim3(grid), dim3(NTHREADS), LDS_BYTES, stream, a, 1); hipMemsetAsync((char*)d_ws + WS_CTL, 0, 49152, stream); }
    a.mode = 0;
    hipLaunchKernelGGL(hymba_fwd, dim3(grid), dim3(NTHREADS), LDS_BYTES, stream, a);
    hipLaunchKernelGGL(dbg_kernel, dim3(grid), dim3(NTHREADS), LDS_BYTES, stream, a, 2);
#else
    hipLaunchKernelGGL(hymba_fwd, dim3(grid), dim3(NTHREADS), LDS_BYTES, stream, a);
#endif
}
```

```cpp
#include <hip/hip_runtime.h>
#include <hip/hip_bf16.h>
#include <cstdio>
#include <cstdint>
#include <cmath>
#define TUNED_MOBA 1
#define TUNED_MLA 1
#define SB_RES 1
namespace pg8 {
#define PG8_LAS __attribute__((address_space(3)))
typedef unsigned short bf16_t;
typedef short bf16x8 __attribute__((ext_vector_type(8)));
typedef float f32x4 __attribute__((ext_vector_type(4)));
typedef unsigned u32x4 __attribute__((ext_vector_type(4)));
constexpr int BM = 256, BK = 64, HALF = 128, HTB = HALF * BK * 2  , STAGE_BYTES = 8 * HTB, NXCD = 8, WGM = 4;

__host__ __device__ __forceinline__ int lds_byte(int r, int c) { const int st = (r >> 4) * 2 + (c >> 5), rr = r & 15, cc = c & 31, ob = rr * 64 + cc * 2; return st * 1024 + (ob ^ (((ob >> 9) & 1) << 5)); }
__host__ __device__ __forceinline__ void stage_rc(int b, int& R, int& C) { const int st = b / 1024, sb = b % 1024, swz = sb ^ (((sb >> 9) & 1) << 5); R = (st >> 1) * 16 + swz / 64; C = (st & 1) * 32 + (swz % 64) / 2; }
__host__ __device__ __forceinline__ int perm32(int rho) { const int n = rho >> 4, i = rho & 15; return 8 * (i >> 2) + 4 * n + (i & 3); }

struct Unit { int pm, pn; };
struct Gemm { const bf16_t* A; const bf16_t* Bt; int M, N, K, lda; };

template <int WGM_> struct StaticOrderT {
    int nM, nN, nwg, G, c;
    __host__ __device__ void init(int M, int N, int G_, int c_) { nM = M / BM; nN = N / BM; nwg = nM * nN; G = G_; c = c_; }
    __host__ __device__ bool next(int i, Unit& u) const {
        const long L = (long)i * G + c; if (L >= nwg) return false;
        int wgid = (int)L; { const int q = nwg / NXCD, r = nwg % NXCD, xcd = wgid % NXCD, off = wgid / NXCD; wgid = (xcd < r ? xcd * (q + 1) : r * (q + 1) + (xcd - r) * q) + off; }
        const int nig = WGM_ * nN, gid = wgid / nig, fm = gid * WGM_, gsz = (nM - fm) < WGM_ ? (nM - fm) : WGM_;
        u.pm = fm + ((wgid % nig) % gsz); u.pn = (wgid % nig) / gsz; return true;
    }
    __device__ __forceinline__ void a_ready(const Unit&) const {}
    __device__ __forceinline__ void done(const Unit&) const {}
};
typedef StaticOrderT<WGM> StaticOrder;

__device__ __forceinline__ unsigned cvt_pk_bf16(float lo, float hi) { unsigned r; asm volatile("v_cvt_pk_bf16_f32 %0, %1, %2" : "=v"(r) : "v"(lo), "v"(hi)); return r; }
typedef float f32x2 __attribute__((ext_vector_type(2)));
__device__ __forceinline__ u32x4 pack8(f32x4 a, f32x4 b) { u32x4 w; w.x = cvt_pk_bf16(a[0], a[1]); w.y = cvt_pk_bf16(a[2], a[3]); w.z = cvt_pk_bf16(b[0], b[1]); w.w = cvt_pk_bf16(b[2], b[3]); return w; }
__device__ __forceinline__ float bf_lo(unsigned w) { return __uint_as_float(w << 16); }
__device__ __forceinline__ float bf_hi(unsigned w) { return __uint_as_float(w & 0xffff0000u); }
__device__ __forceinline__ float silu_f(float g) { return g * __builtin_amdgcn_rcpf(1.0f + __expf(-g)); }

struct EpiIn {
    static constexpr bool PERM = true, AFTER_DRAIN = false;
    bf16_t* U; float* ssq_q; float* ssq_kv; bf16_t* KR; const float* cosT; const float* sinT; float qscale; const float* rstd;
    __device__ __forceinline__ void operator()(const f32x4 (&acc0)[2][2][4][2], const Unit& u, int wr, int wc, int fr, int fq) const {
        const int pn = u.pn;
        f32x4 acc[2][2][4][2];
#pragma unroll
        for (int ai = 0; ai < 2; ++ai)
#pragma unroll
            for (int m = 0; m < 4; ++m) { const float rs = rstd[u.pm * BM + wr * 64 + fr + ai * HALF + m * 16];
#pragma unroll
                for (int bj = 0; bj < 2; ++bj)
#pragma unroll
                    for (int n = 0; n < 2; ++n) acc[ai][bj][m][n] = acc0[ai][bj][m][n] * rs; }
        const float sc = (pn == 2 || pn == 5) ? qscale : 1.0f;
        const int row0 = u.pm * BM + wr * 64 + fr, col0 = pn * BM + wc * 32 + 8 * fq;
#pragma unroll
        for (int ai = 0; ai < 2; ++ai)
#pragma unroll
            for (int m = 0; m < 4; ++m) { bf16_t* rowp = U + (size_t)(row0 + ai * HALF + m * 16) * 3584 + col0;
#pragma unroll
                for (int bj = 0; bj < 2; ++bj) *(u32x4*)(rowp + bj * HALF) = pack8(acc[ai][bj][m][0] * sc, acc[ai][bj][m][1] * sc); }
        if (pn <= 1) {
            float* ssq = pn == 0 ? ssq_q : ssq_kv;
#pragma unroll
            for (int ai = 0; ai < 2; ++ai)
#pragma unroll
                for (int m = 0; m < 4; ++m) {
                    float s = 0.f;
#pragma unroll
                    for (int n = 0; n < 2; ++n) { const f32x4 x = acc[ai][0][m][n]; s += (x[0] * x[0] + x[1] * x[1]) + (x[2] * x[2] + x[3] * x[3]); }
                    if (pn == 0) {
#pragma unroll
                        for (int n = 0; n < 2; ++n) { const f32x4 x = acc[ai][1][m][n]; s += (x[0] * x[0] + x[1] * x[1]) + (x[2] * x[2] + x[3] * x[3]); } }
                    s += __shfl_xor(s, 16); s += __shfl_xor(s, 32);
                    if (fq == 0) ssq[(size_t)(row0 + ai * HALF + m * 16) * 4 + wc] = s;
                }
        }
        if (pn == 1 && wc == 0) {
#pragma unroll
            for (int ai = 0; ai < 2; ++ai)
#pragma unroll
                for (int m = 0; m < 4; ++m) { const int row = row0 + ai * HALF + m * 16, pos = row & 4095;
                    const f32x4 c = *(const f32x4*)(cosT + pos * 16 + 4 * fq), s = *(const f32x4*)(sinT + pos * 16 + 4 * fq);
                    const f32x4 x1 = acc[ai][1][m][0], x2 = acc[ai][1][m][1];
                    *(u32x4*)(KR + (size_t)row * 32 + 8 * fq) = pack8(x1 * c - x2 * s, x1 * s + x2 * c);
                    asm volatile("" ::: "memory"); }
        }
    }
};
struct EpiQ {
    static constexpr bool PERM = true, AFTER_DRAIN = false;
    bf16_t* QA; const float* ssq_q; const float* cosT; const float* sinT; float scale; float eps;
    __device__ __forceinline__ void operator()(const f32x4 (&acc)[2][2][4][2], const Unit& u, int wr, int wc, int fr, int fq) const {
        const int row0 = u.pm * BM + wr * 64 + fr;
#pragma unroll
        for (int ai = 0; ai < 2; ++ai)
#pragma unroll
            for (int m = 0; m < 4; ++m) { const int row = row0 + ai * HALF + m * 16;
                const f32x4 s4 = *(const f32x4*)(ssq_q + (size_t)row * 4);
                const float rs = scale / sqrtf(((s4[0] + s4[1]) + (s4[2] + s4[3])) * (1.0f / 192.0f) + eps);
                if (u.pn == 0) {
#pragma unroll
                    for (int bj = 0; bj < 2; ++bj) *(u32x4*)(QA + (size_t)row * 384 + bj * HALF + wc * 32 + 8 * fq) = pack8(acc[ai][bj][m][0] * rs, acc[ai][bj][m][1] * rs);
                } else {
                    const int pos = row & 4095;
                    const f32x4 c = *(const f32x4*)(cosT + pos * 16 + 4 * fq), s = *(const f32x4*)(sinT + pos * 16 + 4 * fq);
                    const f32x4 x1 = acc[ai][0][m][0] * rs, x2 = acc[ai][0][m][1] * rs;
                    *(u32x4*)(QA + (size_t)row * 384 + 256 + wc * 32 + 8 * fq) = pack8(x1 * c - x2 * s, x1 * s + x2 * c);
                }
                }
    }
};
struct EpiKV {
    static constexpr bool PERM = true, AFTER_DRAIN = false;
    bf16_t* KVA; const float* ssq_kv; float eps;
    __device__ __forceinline__ void operator()(const f32x4 (&acc)[2][2][4][2], const Unit& u, int wr, int wc, int fr, int fq) const {
        const int row0 = u.pm * BM + wr * 64 + fr;
#pragma unroll
        for (int ai = 0; ai < 2; ++ai)
#pragma unroll
            for (int m = 0; m < 4; ++m) { const int row = row0 + ai * HALF + m * 16;
                const f32x4 s4 = *(const f32x4*)(ssq_kv + (size_t)row * 4);
                const float rs = 1.0f / sqrtf(((s4[0] + s4[1]) + (s4[2] + s4[3])) * (1.0f / 128.0f) + eps);
#pragma unroll
                for (int bj = 0; bj < 2; ++bj) *(u32x4*)(KVA + (size_t)row * 512 + u.pn * BM + bj * HALF + wc * 32 + 8 * fq) = pack8(acc[ai][bj][m][0] * rs, acc[ai][bj][m][1] * rs);
                }
    }
};
struct EpiPW {
    static constexpr bool PERM = true, AFTER_DRAIN = false;
    bf16_t* Y; const bf16_t* U; const float* pwb;
    __device__ __forceinline__ void operator()(const f32x4 (&acc)[2][2][4][2], const Unit& u, int wr, int wc, int fr, int fq) const {
        const int row0 = u.pm * BM + wr * 64 + fr, c0 = wc * 32 + 8 * fq;
#pragma unroll
        for (int ai = 0; ai < 2; ++ai)
#pragma unroll
            for (int m = 0; m < 4; ++m) { const int row = row0 + ai * HALF + m * 16;
#pragma unroll
                for (int bj = 0; bj < 2; ++bj) { const int c = c0 + bj * HALF;
                    const f32x4 b0 = *(const f32x4*)(pwb + c), b1 = *(const f32x4*)(pwb + c + 4);
                    const u32x4 g = *(const u32x4*)(U + (size_t)row * 3584 + 2560 + 768 + c);
                    f32x4 v0 = acc[ai][bj][m][0] + b0, v1 = acc[ai][bj][m][1] + b1;
                    v0[0] *= silu_f(bf_lo(g.x)); v0[1] *= silu_f(bf_hi(g.x)); v0[2] *= silu_f(bf_lo(g.y)); v0[3] *= silu_f(bf_hi(g.y));
                    v1[0] *= silu_f(bf_lo(g.z)); v1[1] *= silu_f(bf_hi(g.z)); v1[2] *= silu_f(bf_lo(g.w)); v1[3] *= silu_f(bf_hi(g.w));
                    *(u32x4*)(Y + (size_t)row * 1024 + 768 + c) = pack8(v0, v1);
                    asm volatile("" ::: "memory"); } }
    }
};
struct EpiOut {
    static constexpr bool PERM = true, AFTER_DRAIN = false;
    bf16_t* T; float* ssq_o;
    __device__ __forceinline__ void operator()(const f32x4 (&acc)[2][2][4][2], const Unit& u, int wr, int wc, int fr, int fq) const {
        const int row0 = u.pm * BM + wr * 64 + fr, col0 = u.pn * BM + wc * 32 + 8 * fq;
#pragma unroll
        for (int ai = 0; ai < 2; ++ai)
#pragma unroll
            for (int m = 0; m < 4; ++m) { const int row = row0 + ai * HALF + m * 16; float s = 0.f;
#pragma unroll
                for (int bj = 0; bj < 2; ++bj) { *(u32x4*)(T + (size_t)row * 1024 + col0 + bj * HALF) = pack8(acc[ai][bj][m][0], acc[ai][bj][m][1]);
#pragma unroll
                    for (int n = 0; n < 2; ++n) { const f32x4 x = acc[ai][bj][m][n]; s += (x[0] * x[0] + x[1] * x[1]) + (x[2] * x[2] + x[3] * x[3]); } }
                s += __shfl_xor(s, 16); s += __shfl_xor(s, 32);
                if (fq == 0) ssq_o[(size_t)row * 16 + u.pn * 4 + wc] = s; }
    }
};
template <class Epi, class Sched, bool ALIGN_EPI = false, bool SP2 = false>
__device__ __forceinline__ void gemm_phase(PG8_LAS unsigned char* lds, const Gemm g, const Sched& S, const Epi& E) {
    int tid_ = threadIdx.x; asm volatile("" : "+v"(tid_));
    const int tid = tid_, wid = __builtin_amdgcn_readfirstlane(tid >> 6), lane = tid & 63, wr = wid >> 2, wc = wid & 3, fr = lane & 15, fq = lane >> 4;
    const int K = g.K, nt = K / BK;
    unsigned voffA[2], voffB[2];
#pragma unroll
    for (int i = 0; i < 2; ++i) { int R, C; stage_rc(tid * 16 + i * 8192, R, C); const int Rb = Epi::PERM ? ((R & ~31) + perm32(R & 31)) : R;
        voffA[i] = (unsigned)(R * g.lda + C) * 2u; voffB[i] = (unsigned)(Rb * K + C) * 2u; }
    const size_t kstep = (size_t)(BK * 2);
    const size_t hstepA = (size_t)HALF * g.lda * 2, hstepB = (size_t)HALF * K * 2;
    const size_t tstepA = 2 * hstepA, tstepB = 2 * hstepB;
    const unsigned ldsw = (unsigned)wid * 1024u;
    const int aoff = lds_byte(wr * 64 + fr, fq * 8), boff = lds_byte(wc * 32 + fr, fq * 8);
#define PG8_SA(b, h) (((b) * 2 + (h)) * HTB)
#define PG8_SB(b, h) ((4 + (b) * 2 + (h)) * HTB)
#define PG8_STAGE(bufoff, gbase, voff) do { _Pragma("unroll") for (int _i = 0; _i < 2; ++_i) \
        __builtin_amdgcn_global_load_lds((const unsigned*)((const char*)(gbase) + (voff)[_i]), (PG8_LAS unsigned*)(lds + (bufoff) + ldsw + _i * 8192), 16, 0, 0); } while (0)
#define PG8_LDA(dst, b, h) do { _Pragma("unroll") for (int m = 0; m < 4; ++m) _Pragma("unroll") for (int k = 0; k < 2; ++k) dst[m][k] = *(const PG8_LAS bf16x8*)(lds + PG8_SA(b, h) + aoff + m * 2048 + k * 1024); } while (0)
#define PG8_LDB(dst, b, h) do { _Pragma("unroll") for (int n = 0; n < 2; ++n) _Pragma("unroll") for (int k = 0; k < 2; ++k) dst[n][k] = *(const PG8_LAS bf16x8*)(lds + PG8_SB(b, h) + boff + n * 2048 + k * 1024); } while (0)
#define PG8_MMA(ai, bj, At, Bt) do { __builtin_amdgcn_s_setprio(1); _Pragma("unroll") for (int m = 0; m < 4; ++m) _Pragma("unroll") for (int n = 0; n < 2; ++n) _Pragma("unroll") for (int k = 0; k < 2; ++k) \
        acc[ai][bj][m][n] = __builtin_amdgcn_mfma_f32_16x16x32_bf16(Bt[n][k], At[m][k], acc[ai][bj][m][n], 0, 0, 0); __builtin_amdgcn_s_setprio(0); } while (0)
#define PG8_WAIT_V(n) asm volatile("s_waitcnt vmcnt(" #n ")" ::: "memory")
#define PG8_WAIT_L(n) asm volatile("s_waitcnt lgkmcnt(" #n ")" ::: "memory")
#define PG8_BAR __builtin_amdgcn_s_barrier()
#define PG8_SCHED __builtin_amdgcn_sched_barrier(0)
    Unit cur, nxt; int ui = 0;
    if (!S.next(0, cur)) return;
    f32x4 acc[2][2][4][2];
#pragma unroll
    for (int a = 0; a < 2; ++a)
#pragma unroll
        for (int b = 0; b < 2; ++b)
#pragma unroll
            for (int m = 0; m < 4; ++m)
#pragma unroll
                for (int n = 0; n < 2; ++n) acc[a][b][m][n] = (f32x4){0.f, 0.f, 0.f, 0.f};
    bf16x8 At[4][2], B0[2][2], B1[2][2];
    const char* cA = (const char*)g.A + (size_t)cur.pm * tstepA; const char* cB = (const char*)g.Bt + (size_t)cur.pn * tstepB;
    S.a_ready(cur);
    if constexpr (SP2) {
        PG8_STAGE(PG8_SB(0, 0), cB, voffB); PG8_STAGE(PG8_SB(0, 1), cB + hstepB, voffB); PG8_STAGE(PG8_SA(0, 0), cA, voffA); PG8_STAGE(PG8_SA(0, 1), cA + hstepA, voffA);
        if (wr == 1) PG8_BAR;
        PG8_WAIT_V(2); PG8_BAR;
        PG8_STAGE(PG8_SB(1, 0), cB + kstep, voffB); PG8_STAGE(PG8_SA(1, 0), cA + kstep, voffA); PG8_STAGE(PG8_SB(1, 1), cB + hstepB + kstep, voffB);
        PG8_WAIT_V(6); PG8_BAR;
    } else {
        PG8_STAGE(PG8_SB(0, 0), cB, voffB); PG8_STAGE(PG8_SA(0, 0), cA, voffA); PG8_STAGE(PG8_SB(0, 1), cB + hstepB, voffB); PG8_STAGE(PG8_SA(0, 1), cA + hstepA, voffA);
        if (wr == 1) PG8_BAR;
        PG8_WAIT_V(4); PG8_BAR;
        PG8_STAGE(PG8_SB(1, 0), cB + kstep, voffB); PG8_STAGE(PG8_SA(1, 0), cA + kstep, voffA); PG8_STAGE(PG8_SB(1, 1), cB + hstepB + kstep, voffB);
        PG8_WAIT_V(6); PG8_BAR;
    }
    for (;;) {
        const bool has_next = S.next(ui + 1, nxt);
        const char* nA = has_next ? (const char*)g.A + (size_t)nxt.pm * tstepA : cA; const char* nB = has_next ? (const char*)g.Bt + (size_t)nxt.pn * tstepB : cB;
#pragma nounroll
        for (int t = 0; t < nt; t += 2) {
            const bool last = (t == nt - 2);
            const char* a1 = cA + (size_t)(t + 1) * kstep;
            const char* a2 = last ? nA : cA + (size_t)(t + 2) * kstep; const char* b2 = last ? nB : cB + (size_t)(t + 2) * kstep;
            const char* a3 = a2 + kstep; const char* b3 = b2 + kstep;
            if (last && has_next) S.a_ready(nxt);
            if constexpr (SP2) {
            PG8_LDB(B0, 0, 0); PG8_LDB(B1, 0, 1); PG8_SCHED; PG8_LDA(At, 0, 0); PG8_STAGE(PG8_SA(1, 1), a1 + hstepA, voffA);
            PG8_WAIT_V(8); PG8_WAIT_L(0); PG8_BAR; PG8_MMA(0, 0, At, B0); PG8_MMA(0, 1, At, B1); PG8_BAR; PG8_SCHED;
            PG8_LDA(At, 0, 1); PG8_STAGE(PG8_SB(0, 0), b2, voffB); PG8_STAGE(PG8_SB(0, 1), b2 + hstepB, voffB); PG8_STAGE(PG8_SA(0, 0), a2, voffA);
            PG8_WAIT_V(8); PG8_WAIT_L(0); PG8_BAR; PG8_MMA(1, 0, At, B0); PG8_MMA(1, 1, At, B1); PG8_BAR; PG8_SCHED;
            PG8_LDB(B0, 1, 0); PG8_LDB(B1, 1, 1); PG8_SCHED; PG8_LDA(At, 1, 0); PG8_STAGE(PG8_SA(0, 1), a2 + hstepA, voffA);
            PG8_WAIT_V(8); PG8_WAIT_L(0); PG8_BAR; PG8_MMA(0, 0, At, B0); PG8_MMA(0, 1, At, B1); PG8_BAR; PG8_SCHED;
            PG8_LDA(At, 1, 1); PG8_STAGE(PG8_SB(1, 0), b3, voffB); PG8_STAGE(PG8_SB(1, 1), b3 + hstepB, voffB); PG8_STAGE(PG8_SA(1, 0), a3, voffA);
            PG8_WAIT_V(8); PG8_WAIT_L(0); PG8_BAR; PG8_MMA(1, 0, At, B0); PG8_MMA(1, 1, At, B1); PG8_BAR; PG8_SCHED;
            } else {
            PG8_LDB(B0, 0, 0); PG8_SCHED; PG8_LDA(At, 0, 0); PG8_STAGE(PG8_SA(1, 1), a1 + hstepA, voffA);
            PG8_WAIT_L(8); PG8_BAR; PG8_WAIT_L(0); PG8_MMA(0, 0, At, B0); PG8_BAR; PG8_SCHED;
            PG8_LDB(B1, 0, 1); PG8_STAGE(PG8_SB(0, 0), b2, voffB);
            PG8_BAR; PG8_WAIT_L(0); PG8_MMA(0, 1, At, B1); PG8_BAR;
            PG8_LDA(At, 0, 1); PG8_STAGE(PG8_SA(0, 0), a2, voffA);
            PG8_BAR; PG8_WAIT_L(0); PG8_MMA(1, 0, At, B0); PG8_BAR; PG8_SCHED;
            PG8_STAGE(PG8_SB(0, 1), b2 + hstepB, voffB);
            PG8_WAIT_V(6); PG8_BAR; PG8_MMA(1, 1, At, B1); PG8_BAR;
            PG8_LDB(B0, 1, 0); PG8_SCHED; PG8_LDA(At, 1, 0); PG8_STAGE(PG8_SA(0, 1), a2 + hstepA, voffA);
            PG8_WAIT_L(8); PG8_BAR; PG8_WAIT_L(0); PG8_MMA(0, 0, At, B0); PG8_BAR; PG8_SCHED;
            PG8_LDB(B1, 1, 1); PG8_STAGE(PG8_SB(1, 0), b3, voffB);
            PG8_BAR; PG8_WAIT_L(0); PG8_MMA(0, 1, At, B1); PG8_BAR;
            PG8_LDA(At, 1, 1); PG8_STAGE(PG8_SA(1, 0), a3, voffA);
            PG8_BAR; PG8_WAIT_L(0); PG8_MMA(1, 0, At, B0); PG8_BAR; PG8_SCHED;
            PG8_STAGE(PG8_SB(1, 1), b3 + hstepB, voffB);
            PG8_WAIT_V(6); PG8_BAR; PG8_MMA(1, 1, At, B1); PG8_BAR;
            }
        }
        if constexpr (ALIGN_EPI) { if (wr == 0) PG8_BAR; }
        if constexpr (!Epi::AFTER_DRAIN) { E(acc, cur, wr, wc, fr, fq); S.done(cur); }
        if (!has_next) break;
#pragma unroll
        for (int a = 0; a < 2; ++a)
#pragma unroll
            for (int b = 0; b < 2; ++b)
#pragma unroll
                for (int m = 0; m < 4; ++m)
#pragma unroll
                    for (int n = 0; n < 2; ++n) acc[a][b][m][n] = (f32x4){0.f, 0.f, 0.f, 0.f};
        cur = nxt; cA = nA; cB = nB; ++ui;
        if constexpr (ALIGN_EPI) { if (wr == 1) PG8_BAR; }
    }
    PG8_WAIT_V(0);
    if constexpr (!ALIGN_EPI) { if (wr == 0) PG8_BAR; }
    PG8_BAR;
    if constexpr (Epi::AFTER_DRAIN) { E.fused(acc, cur, wr, wc, fr, fq, lds, wid, lane); S.done(cur); }
#undef PG8_SA
#undef PG8_SB
#undef PG8_STAGE
#undef PG8_LDA
#undef PG8_LDB
#undef PG8_MMA
#undef PG8_WAIT_V
#undef PG8_WAIT_L
#undef PG8_BAR
#undef PG8_SCHED
}
}
namespace att {
typedef __hip_bfloat16 hbf16;
typedef short bf16x8 __attribute__((ext_vector_type(8)));
typedef short s16x4 __attribute__((ext_vector_type(4)));
typedef float f32x16 __attribute__((ext_vector_type(16)));
typedef float f32x4 __attribute__((ext_vector_type(4)));
typedef unsigned u32x4 __attribute__((ext_vector_type(4)));
typedef unsigned short bf16_t;
#define ALAS __attribute__((address_space(3)))
typedef ALAS const char* lds_cptr;
constexpr int SEQ = 4096, QB = 256, KVBLK = 64;
constexpr int SLOTK = 12288, SLOTV = 8192, NSLOT = 3;
constexpr int L_K = 0, L_V = NSLOT * SLOTK, L_WS = L_V + NSLOT * SLOTV, L_OST = L_WS + 8 * 256, L_TBL = L_OST + 8 * 4096, TBL_N = 256 + 4096, L_NINF = L_TBL + TBL_N * 4,
              L_KM = L_NINF + 256, L_FLAG = L_KM + 4096, L_END = L_FLAG + 64;
constexpr int UP = 3584;
constexpr float SB_EXIT = -64.0f;
#define ASBAR() __builtin_amdgcn_sched_barrier(0)
#define AWAIT_BAR(N) asm volatile("s_waitcnt vmcnt(" #N ") lgkmcnt(0)\n\ts_barrier" ::: "memory")
__device__ __forceinline__ int crow(int r, int hi) { return (r & 3) + 8 * (r >> 2) + 4 * hi; }
__device__ __forceinline__ void glds16(const void* gsrc, unsigned lds_dst) { unsigned keep;
    asm volatile("s_mov_b32 %0, m0\n\ts_mov_b32 m0, %2\n\ts_nop 0\n\tglobal_load_lds_dwordx4 %1, off\n\ts_mov_b32 m0, %0" : "=&s"(keep) : "v"(gsrc), "s"(lds_dst) : "memory"); }
typedef float f32x2_t __attribute__((ext_vector_type(2))); typedef __bf16 bf16x2_t __attribute__((ext_vector_type(2)));
__device__ __forceinline__ unsigned cvtpk(float lo, float hi) { f32x2_t v = {lo, hi}; bf16x2_t b = __builtin_convertvector(v, bf16x2_t); return __builtin_bit_cast(unsigned, b); }
__device__ __forceinline__ float bflo(unsigned w) { return __uint_as_float(w << 16); }
__device__ __forceinline__ float bfhi(unsigned w) { return __uint_as_float(w & 0xffff0000u); }
__device__ __forceinline__ float max3f(float a, float b, float c) { float r; asm("v_max3_f32 %0, %1, %2, %3" : "=v"(r) : "v"(a), "v"(b), "v"(c)); return r; }
__device__ __forceinline__ float rowmax32(const f32x16& p0, const f32x16& p1) {
    float a = max3f(p0[0], p0[1], p0[2]), b = max3f(p0[3], p0[4], p0[5]), c = max3f(p1[0], p1[1], p1[2]), d = max3f(p1[3], p1[4], p1[5]);
    a = max3f(a, p0[6], p0[7]); b = max3f(b, p0[8], p0[9]); c = max3f(c, p1[6], p1[7]); d = max3f(d, p1[8], p1[9]);
    a = max3f(a, p0[10], p0[11]); b = max3f(b, p0[12], p0[13]); c = max3f(c, p1[10], p1[11]); d = max3f(d, p1[12], p1[13]);
    a = max3f(a, p0[14], p0[15]); c = max3f(c, p1[14], p1[15]);
    a = max3f(a, b, c); return max3f(a, d, d);
}
__device__ __forceinline__ float swap_max(float m) { auto rr = __builtin_amdgcn_permlane32_swap(__float_as_uint(m), __float_as_uint(m), false, false); return fmaxf(__uint_as_float(rr[0]), __uint_as_float(rr[1])); }
__device__ __forceinline__ float swap_add(float m) { auto rr = __builtin_amdgcn_permlane32_swap(__float_as_uint(m), __float_as_uint(m), false, false); return __uint_as_float(rr[0]) + __uint_as_float(rr[1]); }

template <int ND> __device__ __forceinline__ void qkt(f32x16& p0, f32x16& p1, lds_cptr kslot, const bf16x8* qr, const f32x16& cinit, int r32, int hi) {
    const lds_cptr kb = kslot + hi * 1024 + r32 * 16;
    bf16x8 kf[2 * ND];
#pragma unroll
    for (int d0 = 0; d0 < ND; ++d0) { kf[2 * d0] = *(const ALAS bf16x8*)(kb + d0 * 2048); kf[2 * d0 + 1] = *(const ALAS bf16x8*)(kb + d0 * 2048 + 512); }
    ASBAR();
#pragma unroll
    for (int d0 = 0; d0 < ND; ++d0) {
        if (d0 == 0) { p0 = __builtin_amdgcn_mfma_f32_32x32x16_bf16(kf[0], qr[0], cinit, 0, 0, 0); p1 = __builtin_amdgcn_mfma_f32_32x32x16_bf16(kf[1], qr[0], cinit, 0, 0, 0); }
        else { p0 = __builtin_amdgcn_mfma_f32_32x32x16_bf16(kf[2 * d0], qr[d0], p0, 0, 0, 0); p1 = __builtin_amdgcn_mfma_f32_32x32x16_bf16(kf[2 * d0 + 1], qr[d0], p1, 0, 0, 0); }
    }
}
__device__ __forceinline__ void pv(f32x16* o, int vb, bf16x8 pa0, bf16x8 pa1, bf16x8 pa2, bf16x8 pa3) {
#pragma unroll
    for (int d0 = 0; d0 < 2; ++d0) { s16x4 lo[4], hi[4];
#pragma unroll
        for (int ks = 0; ks < 4; ++ks) {
            asm volatile("ds_read_b64_tr_b16 %0,%1 offset:%c2" : "=&v"(lo[ks]) : "v"(vb), "i"(d0 * 4096 + ks * 1024) : "memory");
            asm volatile("ds_read_b64_tr_b16 %0,%1 offset:%c2" : "=&v"(hi[ks]) : "v"(vb), "i"(d0 * 4096 + ks * 1024 + 512) : "memory"); }
        asm volatile("s_waitcnt lgkmcnt(0)" ::: "memory"); ASBAR();
#define APK(k) (bf16x8){lo[k][0], lo[k][1], lo[k][2], lo[k][3], hi[k][0], hi[k][1], hi[k][2], hi[k][3]}
        o[d0] = __builtin_amdgcn_mfma_f32_32x32x16_bf16(pa0, APK(0), o[d0], 0, 0, 0);
        o[d0] = __builtin_amdgcn_mfma_f32_32x32x16_bf16(pa1, APK(1), o[d0], 0, 0, 0);
        o[d0] = __builtin_amdgcn_mfma_f32_32x32x16_bf16(pa2, APK(2), o[d0], 0, 0, 0);
        o[d0] = __builtin_amdgcn_mfma_f32_32x32x16_bf16(pa3, APK(3), o[d0], 0, 0, 0);
#undef APK
    }
}
__device__ __forceinline__ bf16x8 pk8(const f32x16& p, int b) { u32x4 w; w.x = cvtpk(p[b], p[b + 1]); w.y = cvtpk(p[b + 2], p[b + 3]); w.z = cvtpk(p[b + 4], p[b + 5]); w.w = cvtpk(p[b + 6], p[b + 7]); return __builtin_bit_cast(bf16x8, w); }

struct Tensors { const bf16_t* U; const bf16_t* QA; const bf16_t* KVA; const bf16_t* KR; bf16_t* Y; const float* BT; const float* KMEAN; int ypitch, ysub; };

template <int TYPE, int KNOB = 0> __device__ __forceinline__ void attn_unit(const Tensors& T, int b, int h, int qb, ALAS char* shm, unsigned lds0, int half) {
    constexpr int ND = (TYPE == 0) ? 6 : 4;
    int tid_ = threadIdx.x; asm volatile("" : "+v"(tid_));
    const int tid = tid_, lane = tid & 63, r32 = lane & 31, hi = lane >> 5; const int wid = __builtin_amdgcn_readfirstlane(tid >> 6);
    const long rowbase = (long)b * SEQ; const int q0 = qb * QB;
    const int NT = (q0 + QB) / KVBLK;
    const bf16_t *Qp, *Kp, *Vp; int pitchQ, pitchK, pitchV, gcol, ycol;
    if (TYPE == 0) { Qp = T.QA + h * 64; pitchQ = 384; Kp = T.KVA + h * 64; pitchK = 512; Vp = T.KVA + 256 + h * 64; pitchV = 512; }
    else { const int base = (TYPE == 1 ? 512 : 1280) + h * 64; Qp = T.U + base; Kp = T.U + base + 256; Vp = T.U + base + 512; pitchQ = pitchK = pitchV = UP; }
    gcol = 2560 + TYPE * 256 + h * 64; ycol = TYPE * 256 + h * 64;
    ALAS float* wsf = (ALAS float*)(shm + L_WS) + wid * 64;
    const long qrow = rowbase + q0 + wid * 32 + r32;
    bf16x8 qr[ND];
#pragma unroll
    for (int d0 = 0; d0 < 4; ++d0) qr[d0] = *(const bf16x8*)(Qp + qrow * pitchQ + d0 * 16 + hi * 8);
    if (TYPE == 0) {
#pragma unroll
        for (int d0 = 4; d0 < ND; ++d0) qr[d0] = *(const bf16x8*)(T.QA + qrow * 384 + 256 + h * 32 + (d0 - 4) * 16 + hi * 8);
    }
#pragma unroll
    for (int d0 = 0; d0 < ND; ++d0) asm volatile("" : "+v"(qr[d0]));
    const bf16_t* ksrc = Kp + (rowbase + lane) * pitchK + wid * 8;
    const bf16_t* vsrc = Vp + (rowbase + 16 * (wid & 3) + (lane >> 2)) * pitchV + (wid >> 2) * 32 + (lane & 3) * 8;
    const bf16_t* krsrc = T.KR + (rowbase + lane) * 32 + (wid & 3) * 8;
    const unsigned kdst = lds0 + L_K + wid * 1024, vdst = lds0 + L_V + wid * 1024, krdst = lds0 + L_K + (8 + (wid & 3)) * 1024;
#define DMA_TILE(t, s) do { if (KNOB == 1 && dma_skip) break; glds16(ksrc + (long)(t) * KVBLK * pitchK, (unsigned)__builtin_amdgcn_readfirstlane(kdst + (s) * SLOTK)); \
        if (TYPE == 0) glds16(krsrc + (long)(t) * KVBLK * 32, (unsigned)__builtin_amdgcn_readfirstlane(krdst + (s) * SLOTK)); \
        glds16(vsrc + (long)(t) * KVBLK * pitchV, (unsigned)__builtin_amdgcn_readfirstlane(vdst + (s) * SLOTV)); } while (0)
#define TILE_WAIT(more) do { if (KNOB == 5) break; if (more) { if (TYPE == 0) AWAIT_BAR(3); else AWAIT_BAR(2); } else AWAIT_BAR(0); } while (0)
#define EVEN_BAR() do { if (KNOB != 5) asm volatile("s_waitcnt lgkmcnt(0)\n\ts_barrier" ::: "memory"); } while (0)
    bool dma_skip = false; (void)dma_skip;
    const int vb0 = (int)(lds0 + L_V) + ((lane >> 4) & 1) * 32 + (lane & 3) * 8 + (4 * hi + ((lane & 15) >> 2)) * 64;
    const lds_cptr kbase = (lds_cptr)shm + L_K;
    const int qrel = wid * 32 + r32;
    f32x16 o[2]; o[0] = f32x16{}; o[1] = f32x16{};
    f32x16 p0, p1;

    if (TYPE != 1) {
        unsigned selmask = 0u;
        ALAS const float* tbl = (ALAS const float*)(shm + L_TBL);
        ALAS const float* ninf = (ALAS const float*)(shm + L_NINF);
        if (TYPE == 2) {
            const float* bt = T.BT + (size_t)h * TBL_N;
            const int nfill = 256 + q0 + 256;
            for (int i = tid; i < nfill; i += 512) ((ALAS float*)(shm + L_TBL))[i] = bt[i];
            if (tid < 64) ((ALAS float*)(shm + L_NINF))[tid] = -INFINITY;
            for (int i = tid; i < 16 * 64; i += 512) ((ALAS float*)(shm + L_KM))[i] = T.KMEAN[((size_t)b * 16 + (i >> 6)) * 256 + h * 64 + (i & 63)];
            asm volatile("s_waitcnt vmcnt(0) lgkmcnt(0)\n\ts_barrier" ::: "memory");
            float qf[32];
#pragma unroll
            for (int d0 = 0; d0 < 4; ++d0) { const u32x4 w = __builtin_bit_cast(u32x4, qr[d0]);
                qf[d0 * 8 + 0] = bflo(w.x); qf[d0 * 8 + 1] = bfhi(w.x); qf[d0 * 8 + 2] = bflo(w.y); qf[d0 * 8 + 3] = bfhi(w.y);
                qf[d0 * 8 + 4] = bflo(w.z); qf[d0 * 8 + 5] = bfhi(w.z); qf[d0 * 8 + 6] = bflo(w.w); qf[d0 * 8 + 7] = bfhi(w.w); }
            float v1 = -INFINITY, v2 = -INFINITY, v3 = -INFINITY; int i1 = -1, i2 = -1, i3 = -1;
            for (int j = 0; j < qb; ++j) {
                ALAS const float* km = (ALAS const float*)(shm + L_KM) + j * 64 + hi * 8;
                float g = 0.f;
#pragma unroll
                for (int d0 = 0; d0 < 4; ++d0) { const f32x4 a = *(ALAS const f32x4*)(km + d0 * 16), c = *(ALAS const f32x4*)(km + d0 * 16 + 4);
                    g += qf[d0 * 8 + 0] * a[0] + qf[d0 * 8 + 1] * a[1] + qf[d0 * 8 + 2] * a[2] + qf[d0 * 8 + 3] * a[3];
                    g += qf[d0 * 8 + 4] * c[0] + qf[d0 * 8 + 5] * c[1] + qf[d0 * 8 + 6] * c[2] + qf[d0 * 8 + 7] * c[3]; }
                g = swap_add(g);
                if (g > v1) { v3 = v2; i3 = i2; v2 = v1; i2 = i1; v1 = g; i1 = j; }
                else if (g > v2) { v3 = v2; i3 = i2; v2 = g; i2 = j; }
                else if (g > v3) { v3 = g; i3 = j; }
            }
            if (i1 >= 0) selmask |= 1u << i1;
            if (i2 >= 0) selmask |= 1u << i2;
            if (i3 >= 0) selmask |= 1u << i3;
        }
        constexpr float THR = 6.0f;
        float mref = 0.f, l_run = 0.f; bool started = false;
        f32x16 negm = f32x16{};
        DMA_TILE(0, 0); DMA_TILE(1, 1); dma_skip = true;
        if (half) TILE_WAIT(true);
        int sl = 0, sl2 = 2;
        for (int t = 0; t < NT; ++t) {
            if (half == 0) TILE_WAIT(t + 1 < NT); else { EVEN_BAR(); if (t + 2 < NT) DMA_TILE(t + 2, sl2); }
            const int jb = t - (NT - 4);
            const bool wave_active = (jb < 0) || (64 * jb <= wid * 32 + 31);
            bool sel = true;
            if (TYPE == 2 && jb < 0) sel = (selmask >> (t >> 2)) & 1u;
            const bool act = wave_active && (TYPE != 2 || __any(sel));
            if (act) {
                if (KNOB == 3 || KNOB == 7) { p0 = negm; p1 = negm; asm volatile("" : "+v"(p0), "+v"(p1)); } else qkt<ND>(p0, p1, kbase + sl * SLOTK, qr, negm, r32, hi);
                if (TYPE == 2) {
                    ALAS const float* pb = sel ? tbl + (q0 + qrel - 64 * t - 4 * hi + 197) : ninf;
#pragma unroll
                    for (int r = 0; r < 16; ++r) { const int ko = (r & 3) + 8 * (r >> 2); p0[r] += pb[59 - ko]; p1[r] += pb[27 - ko]; }
                }
                if (jb >= 0) {
#pragma unroll
                    for (int r = 0; r < 16; ++r) { const int kv = 64 * jb + 4 * hi + (r & 3) + 8 * (r >> 2); if (kv > qrel) p0[r] = -INFINITY; if (kv + 32 > qrel) p1[r] = -INFINITY; }
                }
                float mx = rowmax32(p0, p1);
                mx = swap_max(mx);
                float dl = 0.f;
                if (!started) { if (mx > -INFINITY) dl = mx; } else if (mx > THR) dl = mx;
                if (__any(dl != 0.f)) {
                    const float f = started ? __builtin_amdgcn_exp2f(-dl) : 1.0f;
                    mref += dl; l_run *= f;
#pragma unroll
                    for (int r = 0; r < 16; ++r) { p0[r] -= dl; p1[r] -= dl; negm[r] = -mref; }
                    if (hi == 0) wsf[r32] = f;
                    asm volatile("s_waitcnt lgkmcnt(0)" ::: "memory");
#pragma unroll
                    for (int r = 0; r < 16; ++r) { const float g = wsf[crow(r, hi)]; o[0][r] *= g; o[1][r] *= g; }
                    asm volatile("s_waitcnt lgkmcnt(0)" ::: "memory");
                }
                if (mx > -INFINITY) started = true;
#pragma unroll
                for (int r = 0; r < 16; ++r) { if (KNOB != 2) p0[r] = __builtin_amdgcn_exp2f(p0[r]); }
            }
            if (half == 0) { EVEN_BAR(); if (t + 2 < NT) DMA_TILE(t + 2, sl2); } else TILE_WAIT(t + 2 < NT);
            if (act) {
#pragma unroll
                for (int r = 0; r < 16; ++r) { if (KNOB != 2) p1[r] = __builtin_amdgcn_exp2f(p1[r]); }
                { const f32x16 sv = p0 + p1;
                  const float s0 = (sv[0] + sv[1]) + (sv[2] + sv[3]), s1 = (sv[4] + sv[5]) + (sv[6] + sv[7]), s2 = (sv[8] + sv[9]) + (sv[10] + sv[11]), s3 = (sv[12] + sv[13]) + (sv[14] + sv[15]);
                  l_run += (s0 + s1) + (s2 + s3); }
                if (KNOB == 4 || KNOB == 7) { bf16x8 a_ = pk8(p0, 0), b_ = pk8(p0, 8), c_ = pk8(p1, 0), d_ = pk8(p1, 8); asm volatile("" :: "v"(a_), "v"(b_), "v"(c_), "v"(d_)); } else
                pv(o, vb0 + sl * SLOTV, pk8(p0, 0), pk8(p0, 8), pk8(p1, 0), pk8(p1, 8));
            }
            sl = (sl == 2) ? 0 : sl + 1; sl2 = (sl2 == 2) ? 0 : sl2 + 1;
        }
        if (half == 0) EVEN_BAR();
        l_run = swap_add(l_run);
        if (hi == 0) wsf[32 + r32] = l_run;
        asm volatile("s_waitcnt lgkmcnt(0)" ::: "memory");
#pragma unroll
        for (int r = 0; r < 16; ++r) { const float f = __builtin_amdgcn_rcpf(wsf[32 + crow(r, hi)]); o[0][r] *= f; o[1][r] *= f; }
    } else {
        bf16x8 Ta, Tb, Tones;
        { short ta[8], tb[8];
#pragma unroll
          for (int j = 0; j < 8; ++j) { const int kk = 8 * (j >> 2) + 4 * hi + (j & 3); ta[j] = (kk > r32) ? (short)0x3F80 : (short)0; tb[j] = (16 + kk > r32) ? (short)0x3F80 : (short)0; }
          Ta = (bf16x8){ta[0], ta[1], ta[2], ta[3], ta[4], ta[5], ta[6], ta[7]}; Tb = (bf16x8){tb[0], tb[1], tb[2], tb[3], tb[4], tb[5], tb[6], tb[7]};
          Tones = (bf16x8){(short)0x3F80, (short)0x3F80, (short)0x3F80, (short)0x3F80, (short)0x3F80, (short)0x3F80, (short)0x3F80, (short)0x3F80}; }
        float c = 0.f;
        ALAS unsigned* flags = (ALAS unsigned*)(shm + L_FLAG);
        DMA_TILE(NT - 1, 0); DMA_TILE(NT - 2, 1);
        if (half) TILE_WAIT(true);
        int sl = 0, sl2 = 2; bool ran_out = true;
        const f32x16 zero16 = f32x16{};
        for (int i = 0; i < NT; ++i) {
            const int t = NT - 1 - i;
            if (half == 0) {
                TILE_WAIT(i + 1 < NT);
                if (i > 0) { const ALAS unsigned* fl = flags + ((i - 1) & 1) * 8; const unsigned all = fl[0] & fl[1] & fl[2] & fl[3] & fl[4] & fl[5] & fl[6] & fl[7];
                             if (__builtin_amdgcn_readfirstlane(all) != 0u) { ran_out = false; break; } }
            } else { EVEN_BAR(); if (i + 2 < NT) DMA_TILE(t - 2, sl2); }
            const int jb = t - (NT - 4);
            const bool wave_active = (jb < 0) || (64 * jb < wid * 32 + 31);
            f32x16 D0, D1;
            if (wave_active) {
                qkt<ND>(p0, p1, kbase + sl * SLOTK, qr, zero16, r32, hi);
                f32x16 L0, L1;
#pragma unroll
                for (int r = 0; r < 16; ++r) {
                    { const float z = p0[r]; const float e = __builtin_amdgcn_exp2f(-fabsf(z)); const float sp = fmaxf(z, 0.f) + __builtin_amdgcn_logf(1.0f + e); p0[r] = z - sp; L0[r] = -sp; }
                    { const float z = p1[r]; const float e = __builtin_amdgcn_exp2f(-fabsf(z)); const float sp = fmaxf(z, 0.f) + __builtin_amdgcn_logf(1.0f + e); p1[r] = z - sp; L1[r] = -sp; }
                }
                if (jb >= 0) {
#pragma unroll
                    for (int r = 0; r < 16; ++r) { const int kv = 64 * jb + 4 * hi + (r & 3) + 8 * (r >> 2);
                        if (kv >= qrel) { p0[r] = -INFINITY; L0[r] = 0.f; } if (kv + 32 >= qrel) { p1[r] = -INFINITY; L1[r] = 0.f; } }
                }
                const bf16x8 B0 = pk8(L0, 0), B1 = pk8(L0, 8), B2 = pk8(L1, 0), B3 = pk8(L1, 8);
                f32x16 X = __builtin_amdgcn_mfma_f32_32x32x16_bf16(Tones, B2, zero16, 0, 0, 0);
                X = __builtin_amdgcn_mfma_f32_32x32x16_bf16(Tones, B3, X, 0, 0, 0);
                D0 = __builtin_amdgcn_mfma_f32_32x32x16_bf16(Ta, B0, X, 0, 0, 0);
                D0 = __builtin_amdgcn_mfma_f32_32x32x16_bf16(Tb, B1, D0, 0, 0, 0);
                D1 = __builtin_amdgcn_mfma_f32_32x32x16_bf16(Ta, B2, zero16, 0, 0, 0);
                D1 = __builtin_amdgcn_mfma_f32_32x32x16_bf16(Tb, B3, D1, 0, 0, 0);
                f32x16 TT = __builtin_amdgcn_mfma_f32_32x32x16_bf16(Tones, B0, X, 0, 0, 0);
                TT = __builtin_amdgcn_mfma_f32_32x32x16_bf16(Tones, B1, TT, 0, 0, 0);
#pragma unroll
                for (int r = 0; r < 16; ++r) { p0[r] += D0[r] + c; p1[r] += D1[r] + c; }
                c += TT[0];
            }
            { const bool done = __all(c < SB_EXIT); if (lane == 0) flags[(i & 1) * 8 + wid] = done ? 1u : 0u; }
            bool stop_after = false;
            if (half == 0) { EVEN_BAR(); if (i + 2 < NT) DMA_TILE(t - 2, sl2); }
            else { TILE_WAIT(i + 2 < NT);
                   const ALAS unsigned* fl = flags + (i & 1) * 8; const unsigned all = fl[0] & fl[1] & fl[2] & fl[3] & fl[4] & fl[5] & fl[6] & fl[7];
                   stop_after = __builtin_amdgcn_readfirstlane(all) != 0u; }
            if (wave_active) {
#pragma unroll
                for (int r = 0; r < 16; ++r) { p0[r] = __builtin_amdgcn_exp2f(p0[r]); p1[r] = __builtin_amdgcn_exp2f(p1[r]); }
                pv(o, vb0 + sl * SLOTV, pk8(p0, 0), pk8(p0, 8), pk8(p1, 0), pk8(p1, 8));
            }
            if (stop_after) { ran_out = false; break; }
            sl = (sl == 2) ? 0 : sl + 1; sl2 = (sl2 == 2) ? 0 : sl2 + 1;
        }
        if (half == 0 && ran_out) EVEN_BAR();
    }
    {
        ALAS bf16_t* stg = (ALAS bf16_t*)(shm + L_OST) + wid * 2048;
#pragma unroll
        for (int r = 0; r < 16; ++r) { const int orow = crow(r, hi);
#pragma unroll
            for (int d0 = 0; d0 < 2; ++d0) stg[orow * 64 + d0 * 32 + r32] = (bf16_t)(cvtpk(o[d0][r], 0.f) & 0xffffu); }
        asm volatile("s_waitcnt lgkmcnt(0)" ::: "memory");
#pragma unroll
        for (int i = 0; i < 4; ++i) { const int row = i * 8 + (lane >> 3), ch = lane & 7;
            const u32x4 v = *(ALAS const u32x4*)(stg + row * 64 + ch * 8);
            const long grow = rowbase + q0 + wid * 32 + row;
            const u32x4 g = *(const u32x4*)(T.U + grow * UP + gcol + ch * 8);
            float x[8] = {bflo(v.x), bfhi(v.x), bflo(v.y), bfhi(v.y), bflo(v.z), bfhi(v.z), bflo(v.w), bfhi(v.w)};
            const float gg[8] = {bflo(g.x), bfhi(g.x), bflo(g.y), bfhi(g.y), bflo(g.z), bfhi(g.z), bflo(g.w), bfhi(g.w)};
#pragma unroll
            for (int j = 0; j < 8; ++j) x[j] *= gg[j] / (1.0f + __expf(-gg[j]));
            u32x4 w; w.x = cvtpk(x[0], x[1]); w.y = cvtpk(x[2], x[3]); w.z = cvtpk(x[4], x[5]); w.w = cvtpk(x[6], x[7]);
            if (KNOB == 0) *(u32x4*)(T.Y + grow * T.ypitch + (ycol - T.ysub) + ch * 8) = w; else if (w.x == 0x12345678u && w.y == 0x9abcdef0u) *(u32x4*)(T.Y + grow * 1024 + ycol + ch * 8) = w; }
    }
    asm volatile("s_waitcnt vmcnt(0) lgkmcnt(0)\n\ts_barrier" ::: "memory");
#undef DMA_TILE
#undef TILE_WAIT
#undef EVEN_BAR
}
#undef ASBAR
#undef AWAIT_BAR
}
namespace att {
#define SBAR() __builtin_amdgcn_sched_barrier(0)
#ifdef CONSERVATIVE_BAR
#define WAIT_BAR(N) asm volatile("s_waitcnt vmcnt(0) lgkmcnt(0)\n\ts_barrier\n\ts_barrier" ::: "memory")
#else
#define WAIT_BAR(N) asm volatile("s_waitcnt vmcnt(" #N ") lgkmcnt(0)\n\ts_barrier" ::: "memory")
#endif
typedef short v4i16_t __attribute__((ext_vector_type(4)));
__device__ __forceinline__ void kload8(bf16x8* kf, lds_cptr kp) {
    kf[0] = *(const ALAS bf16x8*)(kp);        kf[1] = *(const ALAS bf16x8*)(kp + 512);
    kf[2] = *(const ALAS bf16x8*)(kp + 2048); kf[3] = *(const ALAS bf16x8*)(kp + 2560);
    kf[4] = *(const ALAS bf16x8*)(kp + 4096); kf[5] = *(const ALAS bf16x8*)(kp + 4608);
    kf[6] = *(const ALAS bf16x8*)(kp + 6144); kf[7] = *(const ALAS bf16x8*)(kp + 6656);
}
__device__ __forceinline__ void kload2(bf16x8* kf, lds_cptr kp, int j) { kf[2 * j] = *(const ALAS bf16x8*)(kp + j * 2048); kf[2 * j + 1] = *(const ALAS bf16x8*)(kp + j * 2048 + 512); }
__device__ __forceinline__ s16x4 vtr(lds_cptr p) { return __builtin_bit_cast(s16x4, __builtin_amdgcn_ds_read_tr16_b64_v4i16((ALAS v4i16_t*)p)); }
__device__ __forceinline__ void cmask(f32x16& p0, f32x16& p1, int jb, int qrel, int hi) {
    const float NEG = -INFINITY; const int kb = 64 * jb + 4 * hi;
#pragma unroll
    for (int r = 0; r < 16; ++r) { const int kv = kb + (r & 3) + 8 * (r >> 2); if (kv > qrel) p0[r] = NEG; if (kv + 32 > qrel) p1[r] = NEG; }
}

__device__ __forceinline__ float rowmax_cv(const f32x16& p0, const f32x16& p1) {
    float a = __builtin_fmaxf(__builtin_fmaxf(p0[0], p0[1]), p1[0]), b = __builtin_fmaxf(__builtin_fmaxf(p0[2], p0[3]), p1[1]); a = __builtin_fmaxf(__builtin_fmaxf(a, p1[2]), p1[3]);
#pragma unroll
    for (int r = 4; r < 16; r += 4) { a = __builtin_fmaxf(__builtin_fmaxf(a, p0[r]), p0[r + 1]); b = __builtin_fmaxf(__builtin_fmaxf(b, p0[r + 2]), p0[r + 3]); a = __builtin_fmaxf(__builtin_fmaxf(a, p1[r]), p1[r + 1]); b = __builtin_fmaxf(__builtin_fmaxf(b, p1[r + 2]), p1[r + 3]); }
    return __builtin_fmaxf(a, b);
}
#ifndef TUNED_THR
#define TUNED_THR 8.0f
#endif
__device__ __forceinline__ void moba_unit_tuned(const Tensors& T, int b, int h, int qb, ALAS char* shm, unsigned lds0) {
    int tid_ = threadIdx.x; asm volatile("" : "+v"(tid_));
    const int tid = tid_, lane = tid & 63, r32 = lane & 31, hi = lane >> 5; const int wid = __builtin_amdgcn_readfirstlane(tid >> 6);
    const long rowbase = (long)b * SEQ; const int q0 = qb * QB;
    const int NT = (q0 + QB) / KVBLK;
    const bf16_t* Qp = T.U + 1280 + h * 64; const bf16_t* Kp = T.U + 1536 + h * 64; const bf16_t* Vp = T.U + 1792 + h * 64;
    const int gcol = 2560 + 512 + h * 64, ycol = 512 + h * 64;
    ALAS float* wsf = (ALAS float*)(shm + L_WS) + wid * 64;
    const long qrow = rowbase + q0 + wid * 32 + r32;
    const bf16_t* ksrc = Kp + (rowbase + lane) * UP + wid * 8;
    const bf16_t* vsrc = Vp + (rowbase + 16 * (wid & 3) + (lane >> 2)) * UP + (wid >> 2) * 32 + (lane & 3) * 8;
    const unsigned kdst = lds0 + L_K + wid * 1024, vdst = lds0 + L_V + wid * 1024;
#define DMA_K(t, si) glds16(ksrc + (long)(t) * KVBLK * UP, (unsigned)__builtin_amdgcn_readfirstlane(kdst + (si) * SLOTK))
#define DMA_V(t, si) glds16(vsrc + (long)(t) * KVBLK * UP, (unsigned)__builtin_amdgcn_readfirstlane(vdst + (si) * SLOTV))
    const int vb0 = (int)(lds0 + L_V) + ((lane >> 4) & 1) * 32 + (lane & 3) * 8 + (4 * hi + ((lane & 15) >> 2)) * 64;
    const lds_cptr shm3 = (lds_cptr)shm; const lds_cptr kp0 = shm3 + L_K + hi * 1024 + r32 * 16;
    const lds_cptr vp0 = shm3 + L_V + ((lane >> 4) & 1) * 32 + (lane & 3) * 8 + (4 * hi + ((lane & 15) >> 2)) * 64;
    const int qrel = wid * 32 + r32;
    ALAS const float* tbl = (ALAS const float*)(shm + L_TBL);
    ALAS const float* ninf = (ALAS const float*)(shm + L_NINF);
    bf16x8 qr[4];
#pragma unroll
    for (int d0 = 0; d0 < 4; ++d0) qr[d0] = *(const bf16x8*)(Qp + qrow * UP + d0 * 16 + hi * 8);
    unsigned selmask = 0u;
    {
        const float* bt = T.BT + (size_t)h * TBL_N;
        const int nfill = (256 + q0 + 256) < 1408 ? (256 + q0 + 256) : 1408;
        for (int i = tid; i < nfill; i += 512) ((ALAS float*)(shm + L_TBL))[i] = bt[i];
        if (tid < 64) ((ALAS float*)(shm + L_NINF))[tid] = -INFINITY;
        if (tid == 64) ((ALAS float*)(shm + L_TBL))[256 + 1024] = bt[256 + 1024];
        for (int i = tid; i < 16 * 64; i += 512) ((ALAS float*)(shm + L_KM))[i] = T.KMEAN[((size_t)b * 16 + (i >> 6)) * 256 + h * 64 + (i & 63)];
        asm volatile("s_waitcnt vmcnt(0) lgkmcnt(0)\n\ts_barrier" ::: "memory");
        float qf[32];
#pragma unroll
        for (int d0 = 0; d0 < 4; ++d0) { const u32x4 w = __builtin_bit_cast(u32x4, qr[d0]);
            qf[d0 * 8 + 0] = bflo(w.x); qf[d0 * 8 + 1] = bfhi(w.x); qf[d0 * 8 + 2] = bflo(w.y); qf[d0 * 8 + 3] = bfhi(w.y);
            qf[d0 * 8 + 4] = bflo(w.z); qf[d0 * 8 + 5] = bfhi(w.z); qf[d0 * 8 + 6] = bflo(w.w); qf[d0 * 8 + 7] = bfhi(w.w); }
        float v1 = -INFINITY, v2 = -INFINITY, v3 = -INFINITY; int i1 = -1, i2 = -1, i3 = -1;
        for (int j = 0; j < qb; ++j) {
            ALAS const float* km = (ALAS const float*)(shm + L_KM) + j * 64 + hi * 8;
            float g = 0.f;
#pragma unroll
            for (int d0 = 0; d0 < 4; ++d0) { const f32x4 a = *(ALAS const f32x4*)(km + d0 * 16), c = *(ALAS const f32x4*)(km + d0 * 16 + 4);
                g += qf[d0 * 8 + 0] * a[0] + qf[d0 * 8 + 1] * a[1] + qf[d0 * 8 + 2] * a[2] + qf[d0 * 8 + 3] * a[3];
                g += qf[d0 * 8 + 4] * c[0] + qf[d0 * 8 + 5] * c[1] + qf[d0 * 8 + 6] * c[2] + qf[d0 * 8 + 7] * c[3]; }
            g = swap_add(g);
            if (g > v1) { v3 = v2; i3 = i2; v2 = v1; i2 = i1; v1 = g; i1 = j; }
            else if (g > v2) { v3 = v2; i3 = i2; v2 = g; i2 = j; }
            else if (g > v3) { v3 = g; i3 = j; }
        }
        if (i1 >= 0) selmask |= 1u << i1;
        if (i2 >= 0) selmask |= 1u << i2;
        if (i3 >= 0) selmask |= 1u << i3;
        selmask |= 1u << qb;
    }
#pragma unroll
    for (int d0 = 0; d0 < 4; ++d0) asm volatile("" : "+v"(qr[d0]));
    float c31 = tbl[256 + 1024]; asm volatile("s_waitcnt lgkmcnt(0)" : "+v"(c31) :: "memory");
    const int tfar = (q0 + 32 * wid - 853) >= 0 ? (q0 + 32 * wid - 853) / 64 : -1;
    DMA_K(0, 0); DMA_V(0, 0); DMA_K(1, 1);
    bf16x8 kf[8];
    float mhat = 0.f, l_reg = 0.f; f32x16 o[2]; o[0] = f32x16{}; o[1] = f32x16{}; f32x16 negm = f32x16{}; asm volatile("" : "+v"(negm));
    bool resc = false; bool started = false;
#if defined(NO_BIAS_PROBE)
#define BIAS(P0, P1, t) do { const bool sel_ = (selmask >> ((t) >> 2)) & 1u; const float add_ = sel_ ? 0.f : -INFINITY; _Pragma("unroll") for (int r = 0; r < 16; ++r) { P0[r] += add_; P1[r] += add_; } } while (0)
#else
#define BIAS8(P, base, r0) do { typedef float f32x8_ __attribute__((ext_vector_type(8))); f32x8_ bv_; \
        _Pragma("unroll") for (int r = 0; r < 8; ++r) { const int ko = ((r0 + r) & 3) + 8 * ((r0 + r) >> 2); bv_[r] = pb_[(base) - ko]; } \
        asm volatile("s_waitcnt lgkmcnt(0)" : "+v"(bv_) :: "memory"); \
        _Pragma("unroll") for (int r = 0; r < 8; ++r) P[r0 + r] += bv_[r]; } while (0)
#define BIAS(P0, P1, t) do { const bool sel_ = (selmask >> ((t) >> 2)) & 1u; \
        if ((t) <= tfar) { const float add_ = sel_ ? c31 : -INFINITY;          \
            _Pragma("unroll") for (int r = 0; r < 16; ++r) { P0[r] += add_; P1[r] += add_; } } \
        else { ALAS const float* pb_ = sel_ ? tbl + (q0 + qrel - 64 * (t) - 4 * hi + 197) : ninf; \
            BIAS8(P0, 59, 0); BIAS8(P0, 59, 8); BIAS8(P1, 27, 0); BIAS8(P1, 27, 8); } } while (0)
#endif
#define CMASK(P0, P1, t) do { int jb_ = (t) - (NT - 4); if (jb_ >= 0) cmask(P0, P1, jb_, qrel, hi); } while (0)
#define DECIDE(C0, C1, rm) do { resc = false; float dl = 0.f; \
        if (!started) { if (rm > -INFINITY) dl = rm; } else if (rm > TUNED_THR) dl = rm; \
        if (__builtin_expect(__any(dl != 0.f), 0)) { const float f = started ? __builtin_amdgcn_exp2f(-dl) : 1.0f; mhat += dl; \
            _Pragma("unroll") for (int r = 0; r < 16; ++r) { C0[r] -= dl; C1[r] -= dl; } \
            _Pragma("unroll") for (int r = 0; r < 16; ++r) negm[r] = -mhat; asm volatile("" : "+v"(negm)); \
            l_reg *= f; if (hi == 0) wsf[r32] = f; resc = true; } \
        if (rm > -INFINITY) started = true; } while (0)
#define RESC() do { if (resc) { asm volatile("s_waitcnt lgkmcnt(0)" ::: "memory"); \
        _Pragma("unroll") for (int d_ = 0; d_ < 2; ++d_) _Pragma("unroll") for (int r = 0; r < 16; ++r) o[d_][r] *= wsf[crow(r, hi)]; } } while (0)
    f32x16 pA0, pA1, pB0, pB1;
    int ip = 0, ic = 0, in_ = 1;
#define ROT() do { ip = ic; ic = in_; in_ = (in_ == NSLOT - 1) ? 0 : in_ + 1; } while (0)
    DMA_K(2, 2);
    WAIT_BAR(3);
    qkt<4>(pA0, pA1, shm3 + L_K, qr, negm, r32, hi);
    BIAS(pA0, pA1, 0); CMASK(pA0, pA1, 0);
    { float rm = rowmax_cv(pA0, pA1); rm = swap_max(rm); DECIDE(pA0, pA1, rm); }
#pragma unroll
    for (int r = 0; r < 16; ++r) { pA0[r] = __builtin_amdgcn_exp2f(pA0[r]); pA1[r] = __builtin_amdgcn_exp2f(pA1[r]); }
    WAIT_BAR(0);
    RESC();
    DMA_K(3, 0); DMA_V(1, 1);
    ROT();
    kload8(kf, kp0 + ic * SLOTK);
    WAIT_BAR(2);
    s16x4 vlo[8], vhi[8]; u32x4 pw0, pw1, pw2, pw3;
#define PKW(P, B) cvtpk(P[B], P[B + 1])
#define PAF(k) __builtin_bit_cast(bf16x8, pw##k)
#define VFR(i) (bf16x8){vlo[i][0], vlo[i][1], vlo[i][2], vlo[i][3], vhi[i][0], vhi[i][1], vhi[i][2], vhi[i][3]}
#define PIN(x) asm volatile("" : "+v"(x))
#define GAPA(MF, A0, A1, A2, A3, W0, W1, PW) do { MF; sacc += A0; sacc += A1; sacc += A2; sacc += A3; PIN(sacc); W0; W1; PIN(PW); SBAR(); } while (0)
#define EX(v) __builtin_amdgcn_exp2f(v)
#define GAPB(MF, X, B) do { MF; X[B] = EX(X[B]); X[B + 1] = EX(X[B + 1]); X[B + 2] = EX(X[B + 2]); X[B + 3] = EX(X[B + 3]); PIN(X); SBAR(); } while (0)
#define VRD(i) do { vlo[i] = vtr(vp_ + (((i) >> 2) * 4096 + ((i) & 3) * 1024)); vhi[i] = vtr(vp_ + (((i) >> 2) * 4096 + ((i) & 3) * 1024 + 512)); } while (0)
#define KRD(G, j) do { if (G) { kload2(kf, kp0 + in_ * SLOTK, j); SBAR(); } } while (0)
#define MFQ(c, a, b_) __builtin_amdgcn_mfma_f32_32x32x16_bf16(a, b_, c, 0, 0, 0)
#define STEP(C0, C1, P0, P1, t, GK, GV, GL) do { SBAR(); \
    const lds_cptr vp_ = vp0 + ip * SLOTV; \
    VRD(0); SBAR(); float sacc = (P0[0] + P0[1]); \
    GAPA(C0 = MFQ(negm, kf[0], qr[0]), P0[2], P0[3], P0[4], P0[5],     pw0[0] = PKW(P0, 0), pw0[1] = PKW(P0, 2), pw0); \
    VRD(4); SBAR(); GAPA(C1 = MFQ(negm, kf[1], qr[0]), P0[6], P0[7], P0[8], P0[9],     pw0[2] = PKW(P0, 4), pw0[3] = PKW(P0, 6), pw0); \
    VRD(1); SBAR(); GAPA(C0 = MFQ(C0, kf[2], qr[1]),   P0[10], P0[11], P0[12], P0[13], pw1[0] = PKW(P0, 8), pw1[1] = PKW(P0, 10), pw1); \
    VRD(5); SBAR(); GAPA(C1 = MFQ(C1, kf[3], qr[1]),   P0[14], P0[15], P1[0], P1[1],   pw1[2] = PKW(P0, 12), pw1[3] = PKW(P0, 14), pw1); \
    VRD(2); SBAR(); GAPA(C0 = MFQ(C0, kf[4], qr[2]),   P1[2], P1[3], P1[4], P1[5],     pw2[0] = PKW(P1, 0), pw2[1] = PKW(P1, 2), pw2); \
    VRD(6); SBAR(); GAPA(C1 = MFQ(C1, kf[5], qr[2]),   P1[6], P1[7], P1[8], P1[9],     pw2[2] = PKW(P1, 4), pw2[3] = PKW(P1, 6), pw2); \
    VRD(3); SBAR(); GAPA(C0 = MFQ(C0, kf[6], qr[3]),   P1[10], P1[11], P1[12], P1[13], pw3[0] = PKW(P1, 8), pw3[1] = PKW(P1, 10), pw3); \
    VRD(7); SBAR(); GAPA(C1 = MFQ(C1, kf[7], qr[3]),   P1[14], P1[15], 0.f, 0.f,       pw3[2] = PKW(P1, 12), pw3[3] = PKW(P1, 14), pw3); \
    l_reg += sacc; \
    if (GK) { DMA_K((t) + 3, ic); } if (GV) { DMA_V((t) + 1, in_); } \
    BIAS(C0, C1, t); CMASK(C0, C1, t); \
    { float rm = rowmax_cv(C0, C1); rm = swap_max(rm); DECIDE(C0, C1, rm); } \
    SBAR(); \
    GAPB(o[0] = MFQ(o[0], PAF(0), VFR(0)), C0, 0); \
    GAPB(o[1] = MFQ(o[1], PAF(0), VFR(4)), C0, 4); \
    KRD(GL, 0); GAPB(o[0] = MFQ(o[0], PAF(1), VFR(1)), C0, 8); \
    KRD(GL, 1); GAPB(o[1] = MFQ(o[1], PAF(1), VFR(5)), C0, 12); \
    KRD(GL, 2); GAPB(o[0] = MFQ(o[0], PAF(2), VFR(2)), C1, 0); \
    KRD(GL, 3); GAPB(o[1] = MFQ(o[1], PAF(2), VFR(6)), C1, 4); \
    GAPB(o[0] = MFQ(o[0], PAF(3), VFR(3)), C1, 8); \
    GAPB(o[1] = MFQ(o[1], PAF(3), VFR(7)), C1, 12); \
    } while (0)
    int t = 1;
#undef CMASK
#define CMASK(P0, P1, t) do {} while (0)
    for (; t + 5 < NT; t += 2) {
        STEP(pB0, pB1, pA0, pA1, t, true, true, true);     WAIT_BAR(2); RESC(); ROT();
        STEP(pA0, pA1, pB0, pB1, t + 1, true, true, true); WAIT_BAR(2); RESC(); ROT();
    }
#undef CMASK
#define CMASK(P0, P1, t) do { int jb_ = (t) - (NT - 4); if (jb_ >= 0) cmask(P0, P1, jb_, qrel, hi); } while (0)
#define ENDW(tt) do { if ((tt) + 3 < NT) { WAIT_BAR(2); } else if ((tt) + 2 < NT) { WAIT_BAR(1); } else { WAIT_BAR(0); } } while (0)
    for (; t + 1 < NT; t += 2) {
        STEP(pB0, pB1, pA0, pA1, t, (t + 3 < NT), (t + 1 < NT), (t + 1 < NT));         ENDW(t);     RESC(); ROT();
        STEP(pA0, pA1, pB0, pB1, t + 1, (t + 4 < NT), (t + 2 < NT), (t + 2 < NT));     ENDW(t + 1); RESC(); ROT();
    }
    u32x4 gq[4];
#pragma unroll
    for (int i = 0; i < 4; ++i) gq[i] = *(const u32x4*)(T.U + (rowbase + q0 + wid * 32 + i * 8 + (lane >> 3)) * UP + gcol + (lane & 7) * 8);
    STEP(pB0, pB1, pA0, pA1, NT - 1, false, false, false); RESC();
    { float sacc = pB0[0] + pB0[1];
#pragma unroll
      for (int r = 2; r < 16; ++r) sacc += pB0[r];
#pragma unroll
      for (int r = 0; r < 16; ++r) sacc += pB1[r];
      l_reg += sacc;
      SBAR(); pv(o, vb0 + ic * SLOTV, pk8(pB0, 0), pk8(pB0, 8), pk8(pB1, 0), pk8(pB1, 8)); }
    l_reg = swap_add(l_reg);
    if (hi == 0) wsf[32 + r32] = l_reg;
    asm volatile("s_waitcnt lgkmcnt(0)" ::: "memory");
#pragma unroll
    for (int r = 0; r < 16; ++r) { const float f = __builtin_amdgcn_rcpf(wsf[32 + crow(r, hi)]); o[0][r] *= f; o[1][r] *= f; }
    {
        ALAS bf16_t* stg = (ALAS bf16_t*)(shm + L_OST) + wid * 2048;
#pragma unroll
        for (int r = 0; r < 16; ++r) { const int orow = crow(r, hi);
#pragma unroll
            for (int d0 = 0; d0 < 2; ++d0) stg[orow * 64 + d0 * 32 + r32] = (bf16_t)(cvtpk(o[d0][r], 0.f) & 0xffffu); }
        asm volatile("s_waitcnt lgkmcnt(0)" ::: "memory");
#pragma unroll
        for (int i = 0; i < 4; ++i) asm volatile("" : "+v"(gq[i]));
#pragma unroll
        for (int i = 0; i < 4; ++i) { const int row = i * 8 + (lane >> 3), ch = lane & 7;
            const u32x4 v = *(ALAS const u32x4*)(stg + row * 64 + ch * 8);
            const long grow = rowbase + q0 + wid * 32 + row;
            const u32x4 g = gq[i];
            float x[8] = {bflo(v.x), bfhi(v.x), bflo(v.y), bfhi(v.y), bflo(v.z), bfhi(v.z), bflo(v.w), bfhi(v.w)};
            const float gg[8] = {bflo(g.x), bfhi(g.x), bflo(g.y), bfhi(g.y), bflo(g.z), bfhi(g.z), bflo(g.w), bfhi(g.w)};
#pragma unroll
            for (int j = 0; j < 8; ++j) x[j] *= gg[j] * __builtin_amdgcn_rcpf(1.0f + __expf(-gg[j]));
            u32x4 w; w.x = cvtpk(x[0], x[1]); w.y = cvtpk(x[2], x[3]); w.z = cvtpk(x[4], x[5]); w.w = cvtpk(x[6], x[7]);
            *(u32x4*)(T.Y + grow * T.ypitch + (ycol - T.ysub) + ch * 8) = w; }
    }
    asm volatile("s_waitcnt vmcnt(0) lgkmcnt(0)\n\ts_barrier" ::: "memory");
#undef DMA_K
#undef DMA_V
#undef BIAS
#undef BIAS8
#undef CMASK
#undef DECIDE
#undef RESC
#undef ROT
#undef PKW
#undef PAF
#undef VFR
#undef PIN
#undef GAPA
#undef EX
#undef GAPB
#undef VRD
#undef KRD
#undef MFQ
#undef STEP
#undef ENDW
}

__device__ __forceinline__ void kload12(bf16x8* kf, lds_cptr kp) {
#pragma unroll
    for (int j = 0; j < 6; ++j) { kf[2 * j] = *(const ALAS bf16x8*)(kp + j * 2048); kf[2 * j + 1] = *(const ALAS bf16x8*)(kp + j * 2048 + 512); }
}
__device__ __forceinline__ void mla_unit_tuned(const Tensors& T, int b, int h, int qb, ALAS char* shm, unsigned lds0) {
    int tid_ = threadIdx.x; asm volatile("" : "+v"(tid_));
    const int tid = tid_, lane = tid & 63, r32 = lane & 31, hi = lane >> 5; const int wid = __builtin_amdgcn_readfirstlane(tid >> 6);
    const long rowbase = (long)b * SEQ; const int q0 = qb * QB;
    const int NT = (q0 + QB) / KVBLK;
    const bf16_t* Kp = T.KVA + h * 64; const bf16_t* Vp = T.KVA + 256 + h * 64;
    const int gcol = 2560 + h * 64, ycol = h * 64;
    ALAS float* wsf = (ALAS float*)(shm + L_WS) + wid * 64;
    const long qrow = rowbase + q0 + wid * 32 + r32;
    bf16x8 qr[6];
#pragma unroll
    for (int d0 = 0; d0 < 4; ++d0) qr[d0] = *(const bf16x8*)(T.QA + qrow * 384 + h * 64 + d0 * 16 + hi * 8);
#pragma unroll
    for (int d0 = 4; d0 < 6; ++d0) qr[d0] = *(const bf16x8*)(T.QA + qrow * 384 + 256 + h * 32 + (d0 - 4) * 16 + hi * 8);
#pragma unroll
    for (int d0 = 0; d0 < 6; ++d0) asm volatile("" : "+v"(qr[d0]));
    const bf16_t* ksrc = Kp + (rowbase + lane) * 512 + wid * 8;
    const bf16_t* krsrc = T.KR + (rowbase + lane) * 32 + (wid & 3) * 8;
    const bf16_t* vsrc = Vp + (rowbase + 16 * (wid & 3) + (lane >> 2)) * 512 + (wid >> 2) * 32 + (lane & 3) * 8;
    const unsigned kdst = lds0 + L_K + wid * 1024, krdst = lds0 + L_K + (8 + (wid & 3)) * 1024, vdst = lds0 + L_V + wid * 1024;
#define DMA_K(t, si) do { glds16(ksrc + (long)(t) * KVBLK * 512, (unsigned)__builtin_amdgcn_readfirstlane(kdst + (si) * SLOTK)); \
                          glds16(krsrc + (long)(t) * KVBLK * 32, (unsigned)__builtin_amdgcn_readfirstlane(krdst + (si) * SLOTK)); } while (0)
#define DMA_V(t, si) glds16(vsrc + (long)(t) * KVBLK * 512, (unsigned)__builtin_amdgcn_readfirstlane(vdst + (si) * SLOTV))
    const int vb0 = (int)(lds0 + L_V) + ((lane >> 4) & 1) * 32 + (lane & 3) * 8 + (4 * hi + ((lane & 15) >> 2)) * 64;
    const lds_cptr shm3 = (lds_cptr)shm; const lds_cptr kp0 = shm3 + L_K + hi * 1024 + r32 * 16;
    const lds_cptr vp0 = shm3 + L_V + ((lane >> 4) & 1) * 32 + (lane & 3) * 8 + (4 * hi + ((lane & 15) >> 2)) * 64;
    const int qrel = wid * 32 + r32;
    DMA_K(0, 0); DMA_V(0, 0); DMA_K(1, 1);
    bf16x8 kf[12];
    float mhat = 0.f, l_reg = 0.f; f32x16 o[2]; o[0] = f32x16{}; o[1] = f32x16{};
    const f32x16 zero16 = f32x16{};
    bool resc = false;
#define CMASK(P0, P1, t) do { int jb_ = (t) - (NT - 4); if (jb_ >= 0) cmask(P0, P1, jb_, qrel, hi); } while (0)
#define DECIDE(C0, C1, rmraw) do { resc = false; const float rel_ = (rmraw) - mhat; const float dl = (rel_ > 8.0f) ? rel_ : 0.f; \
        if (__builtin_expect(__any(dl != 0.f), 0)) { const float f = __builtin_amdgcn_exp2f(-dl); mhat += dl; l_reg *= f; if (hi == 0) wsf[r32] = f; resc = true; } \
        _Pragma("unroll") for (int r = 0; r < 16; ++r) { C0[r] -= mhat; C1[r] -= mhat; } } while (0)
#define RESC() do { if (resc) { asm volatile("s_waitcnt lgkmcnt(0)" ::: "memory"); \
        _Pragma("unroll") for (int d_ = 0; d_ < 2; ++d_) _Pragma("unroll") for (int r = 0; r < 16; ++r) o[d_][r] *= wsf[crow(r, hi)]; } } while (0)
    f32x16 pA0, pA1, pB0, pB1;
    int ip = 0, ic = 0, in_ = 1;
#define ROT() do { ip = ic; ic = in_; in_ = (in_ == NSLOT - 1) ? 0 : in_ + 1; } while (0)
    DMA_K(2, 2);
    WAIT_BAR(5);
    qkt<6>(pA0, pA1, shm3 + L_K, qr, zero16, r32, hi);
    CMASK(pA0, pA1, 0);
    { float rm = rowmax_cv(pA0, pA1); rm = swap_max(rm); mhat = rm;
#pragma unroll
      for (int r = 0; r < 16; ++r) { pA0[r] = __builtin_amdgcn_exp2f(pA0[r] - mhat); pA1[r] = __builtin_amdgcn_exp2f(pA1[r] - mhat); } }
    WAIT_BAR(0);
    DMA_K(3, 0); DMA_V(1, 1);
    ROT();
    kload12(kf, kp0 + ic * SLOTK);
    WAIT_BAR(3);
    s16x4 vlo[8], vhi[8]; u32x4 pw0, pw1, pw2, pw3;
#define PKW(P, B) cvtpk(P[B], P[B + 1])
#define PAF(k) __builtin_bit_cast(bf16x8, pw##k)
#define VFR(i) (bf16x8){vlo[i][0], vlo[i][1], vlo[i][2], vlo[i][3], vhi[i][0], vhi[i][1], vhi[i][2], vhi[i][3]}
#define PIN(x) asm volatile("" : "+v"(x))
#define GAPA(MF, A0, A1, A2, A3, W0, W1, PW) do { MF; sacc += A0; sacc += A1; sacc += A2; sacc += A3; PIN(sacc); W0; W1; PIN(PW); SBAR(); } while (0)
#define EX(v) __builtin_amdgcn_exp2f(v)
#define GAPB(MF, X, B) do { MF; X[B] = EX(X[B]); X[B + 1] = EX(X[B + 1]); X[B + 2] = EX(X[B + 2]); X[B + 3] = EX(X[B + 3]); PIN(X); SBAR(); } while (0)
#define VRD(i) do { vlo[i] = vtr(vp_ + (((i) >> 2) * 4096 + ((i) & 3) * 1024)); vhi[i] = vtr(vp_ + (((i) >> 2) * 4096 + ((i) & 3) * 1024 + 512)); } while (0)
#define KRD(G, j) do { if (G) { kload2(kf, kp0 + in_ * SLOTK, j); SBAR(); } } while (0)
#define MFQ(c, a, b_) __builtin_amdgcn_mfma_f32_32x32x16_bf16(a, b_, c, 0, 0, 0)
#define STEP(C0, C1, P0, P1, t, GK, GV, GL) do { SBAR(); \
    const lds_cptr vp_ = vp0 + ip * SLOTV; \
    VRD(0); SBAR(); float sacc = (P0[0] + P0[1]); \
    GAPA(C0 = MFQ(zero16, kf[0], qr[0]), P0[2], P0[3], P0[4], P0[5],     pw0[0] = PKW(P0, 0), pw0[1] = PKW(P0, 2), pw0); \
    VRD(4); SBAR(); GAPA(C1 = MFQ(zero16, kf[1], qr[0]), P0[6], P0[7], P0[8], P0[9],     pw0[2] = PKW(P0, 4), pw0[3] = PKW(P0, 6), pw0); \
    VRD(1); SBAR(); GAPA(C0 = MFQ(C0, kf[2], qr[1]),   P0[10], P0[11], P0[12], P0[13], pw1[0] = PKW(P0, 8), pw1[1] = PKW(P0, 10), pw1); \
    VRD(5); SBAR(); GAPA(C1 = MFQ(C1, kf[3], qr[1]),   P0[14], P0[15], P1[0], P1[1],   pw1[2] = PKW(P0, 12), pw1[3] = PKW(P0, 14), pw1); \
    VRD(2); SBAR(); GAPA(C0 = MFQ(C0, kf[4], qr[2]),   P1[2], P1[3], P1[4], P1[5],     pw2[0] = PKW(P1, 0), pw2[1] = PKW(P1, 2), pw2); \
    VRD(6); SBAR(); GAPA(C1 = MFQ(C1, kf[5], qr[2]),   P1[6], P1[7], P1[8], P1[9],     pw2[2] = PKW(P1, 4), pw2[3] = PKW(P1, 6), pw2); \
    VRD(3); SBAR(); GAPA(C0 = MFQ(C0, kf[6], qr[3]),   P1[10], P1[11], P1[12], P1[13], pw3[0] = PKW(P1, 8), pw3[1] = PKW(P1, 10), pw3); \
    VRD(7); SBAR(); GAPA(C1 = MFQ(C1, kf[7], qr[3]),   P1[14], P1[15], 0.f, 0.f,       pw3[2] = PKW(P1, 12), pw3[3] = PKW(P1, 14), pw3); \
    C0 = MFQ(C0, kf[8], qr[4]); C1 = MFQ(C1, kf[9], qr[4]); C0 = MFQ(C0, kf[10], qr[5]); C1 = MFQ(C1, kf[11], qr[5]); SBAR(); \
    l_reg += sacc; \
    if (GK) { DMA_K((t) + 3, ic); } if (GV) { DMA_V((t) + 1, in_); } \
    CMASK(C0, C1, t); \
    { float rm = rowmax_cv(C0, C1); rm = swap_max(rm); DECIDE(C0, C1, rm); } \
    SBAR(); \
    GAPB(o[0] = MFQ(o[0], PAF(0), VFR(0)), C0, 0); \
    KRD(GL, 0); GAPB(o[1] = MFQ(o[1], PAF(0), VFR(4)), C0, 4); \
    KRD(GL, 1); GAPB(o[0] = MFQ(o[0], PAF(1), VFR(1)), C0, 8); \
    KRD(GL, 2); GAPB(o[1] = MFQ(o[1], PAF(1), VFR(5)), C0, 12); \
    KRD(GL, 3); GAPB(o[0] = MFQ(o[0], PAF(2), VFR(2)), C1, 0); \
    KRD(GL, 4); GAPB(o[1] = MFQ(o[1], PAF(2), VFR(6)), C1, 4); \
    KRD(GL, 5); GAPB(o[0] = MFQ(o[0], PAF(3), VFR(3)), C1, 8); \
    GAPB(o[1] = MFQ(o[1], PAF(3), VFR(7)), C1, 12); \
    } while (0)
    int t = 1;
#undef CMASK
#define CMASK(P0, P1, t) do {} while (0)
    for (; t + 5 < NT; t += 2) {
        STEP(pB0, pB1, pA0, pA1, t, true, true, true);     WAIT_BAR(3); RESC(); ROT();
        STEP(pA0, pA1, pB0, pB1, t + 1, true, true, true); WAIT_BAR(3); RESC(); ROT();
    }
#undef CMASK
#define CMASK(P0, P1, t) do { int jb_ = (t) - (NT - 4); if (jb_ >= 0) cmask(P0, P1, jb_, qrel, hi); } while (0)
#define ENDW(tt) do { if ((tt) + 3 < NT) { WAIT_BAR(3); } else if ((tt) + 2 < NT) { WAIT_BAR(1); } else { WAIT_BAR(0); } } while (0)
    for (; t + 1 < NT; t += 2) {
        STEP(pB0, pB1, pA0, pA1, t, (t + 3 < NT), (t + 1 < NT), (t + 1 < NT));         ENDW(t);     RESC(); ROT();
        STEP(pA0, pA1, pB0, pB1, t + 1, (t + 4 < NT), (t + 2 < NT), (t + 2 < NT));     ENDW(t + 1); RESC(); ROT();
    }
    u32x4 gq[4];
#pragma unroll
    for (int i = 0; i < 4; ++i) gq[i] = *(const u32x4*)(T.U + (rowbase + q0 + wid * 32 + i * 8 + (lane >> 3)) * UP + gcol + (lane & 7) * 8);
    STEP(pB0, pB1, pA0, pA1, NT - 1, false, false, false); RESC();
    { float sacc = pB0[0] + pB0[1];
#pragma unroll
      for (int r = 2; r < 16; ++r) sacc += pB0[r];
#pragma unroll
      for (int r = 0; r < 16; ++r) sacc += pB1[r];
      l_reg += sacc;
      SBAR(); pv(o, vb0 + ic * SLOTV, pk8(pB0, 0), pk8(pB0, 8), pk8(pB1, 0), pk8(pB1, 8)); }
    l_reg = swap_add(l_reg);
    if (hi == 0) wsf[32 + r32] = l_reg;
    asm volatile("s_waitcnt lgkmcnt(0)" ::: "memory");
#pragma unroll
    for (int r = 0; r < 16; ++r) { const float f = __builtin_amdgcn_rcpf(wsf[32 + crow(r, hi)]); o[0][r] *= f; o[1][r] *= f; }
    {
        ALAS bf16_t* stg = (ALAS bf16_t*)(shm + L_OST) + wid * 2048;
#pragma unroll
        for (int r = 0; r < 16; ++r) { const int orow = crow(r, hi);
#pragma unroll
            for (int d0 = 0; d0 < 2; ++d0) stg[orow * 64 + d0 * 32 + r32] = (bf16_t)(cvtpk(o[d0][r], 0.f) & 0xffffu); }
        asm volatile("s_waitcnt lgkmcnt(0)" ::: "memory");
#pragma unroll
        for (int i = 0; i < 4; ++i) asm volatile("" : "+v"(gq[i]));
#pragma unroll
        for (int i = 0; i < 4; ++i) { const int row = i * 8 + (lane >> 3), ch = lane & 7;
            const u32x4 v = *(ALAS const u32x4*)(stg + row * 64 + ch * 8);
            const long grow = rowbase + q0 + wid * 32 + row;
            const u32x4 g = gq[i];
            float x[8] = {bflo(v.x), bfhi(v.x), bflo(v.y), bfhi(v.y), bflo(v.z), bfhi(v.z), bflo(v.w), bfhi(v.w)};
            const float gg[8] = {bflo(g.x), bfhi(g.x), bflo(g.y), bfhi(g.y), bflo(g.z), bfhi(g.z), bflo(g.w), bfhi(g.w)};
#pragma unroll
            for (int j = 0; j < 8; ++j) x[j] *= gg[j] * __builtin_amdgcn_rcpf(1.0f + __expf(-gg[j]));
            u32x4 w; w.x = cvtpk(x[0], x[1]); w.y = cvtpk(x[2], x[3]); w.z = cvtpk(x[4], x[5]); w.w = cvtpk(x[6], x[7]);
            *(u32x4*)(T.Y + grow * T.ypitch + (ycol - T.ysub) + ch * 8) = w; }
    }
    asm volatile("s_waitcnt vmcnt(0) lgkmcnt(0)\n\ts_barrier" ::: "memory");
#undef DMA_K
#undef DMA_V
#undef CMASK
#undef DECIDE
#undef RESC
#undef ROT
#undef PKW
#undef PAF
#undef VFR
#undef PIN
#undef GAPA
#undef EX
#undef GAPB
#undef VRD
#undef KRD
#undef MFQ
#undef STEP
#undef ENDW
}
#undef SBAR
#undef WAIT_BAR
}
namespace att {
constexpr int SBW = 6, SB_K = 0, SB_V = SBW * 8192, SB_STG = 2 * SBW * 8192, SB_END = SB_STG + 8 * 4096;
__device__ __forceinline__ void sb_unit_res(const Tensors& T, int b, int h, int qb, ALAS char* shm, unsigned lds0, ALAS unsigned* flags) {
    int tid_ = threadIdx.x; asm volatile("" : "+v"(tid_));
    const int tid = tid_, lane = tid & 63, r32 = lane & 31, hi = lane >> 5; const int wid = __builtin_amdgcn_readfirstlane(tid >> 6);
    const long rowbase = (long)b * SEQ; const int q0 = qb * QB;
    const int NT = (q0 + QB) / KVBLK;
    const bf16_t* Qp = T.U + 512 + h * 64; const bf16_t* Kp = Qp + 256; const bf16_t* Vp = Qp + 512;
    const int gcol = 2560 + 256 + h * 64, ycol = 256 + h * 64;
    const bf16_t* ksrc = Kp + (rowbase + lane) * UP + wid * 8;
    const bf16_t* vsrc = Vp + (rowbase + 16 * (wid & 3) + (lane >> 2)) * UP + (wid >> 2) * 32 + (lane & 3) * 8;
    const unsigned kdst = lds0 + SB_K + wid * 1024, vdst = lds0 + SB_V + wid * 1024;
    const int vb0 = (int)(lds0 + SB_V) + ((lane >> 4) & 1) * 32 + (lane & 3) * 8 + (4 * hi + ((lane & 15) >> 2)) * 64;
    const lds_cptr kbase = (lds_cptr)shm + SB_K;
    const int qrel = wid * 32 + r32;
    int base = NT - 1, nW = (base + 1 < SBW) ? base + 1 : SBW;
#define DMA_WIN() do { for (int s_ = 0; s_ < nW; ++s_) { glds16(ksrc + (long)(base - s_) * KVBLK * UP, (unsigned)__builtin_amdgcn_readfirstlane(kdst + s_ * 8192)); \
                                                          glds16(vsrc + (long)(base - s_) * KVBLK * UP, (unsigned)__builtin_amdgcn_readfirstlane(vdst + s_ * 8192)); } } while (0)
    DMA_WIN();
    const long qrow = rowbase + q0 + wid * 32 + r32;
    bf16x8 qr[4];
#pragma unroll
    for (int d0 = 0; d0 < 4; ++d0) qr[d0] = *(const bf16x8*)(Qp + qrow * UP + d0 * 16 + hi * 8);
    bf16x8 Ta, Tb, Tones;
    { short ta[8], tb[8];
#pragma unroll
      for (int j = 0; j < 8; ++j) { const int kk = 8 * (j >> 2) + 4 * hi + (j & 3); ta[j] = (kk > r32) ? (short)0x3F80 : (short)0; tb[j] = (16 + kk > r32) ? (short)0x3F80 : (short)0; }
      Ta = (bf16x8){ta[0], ta[1], ta[2], ta[3], ta[4], ta[5], ta[6], ta[7]}; Tb = (bf16x8){tb[0], tb[1], tb[2], tb[3], tb[4], tb[5], tb[6], tb[7]};
      Tones = (bf16x8){(short)0x3F80, (short)0x3F80, (short)0x3F80, (short)0x3F80, (short)0x3F80, (short)0x3F80, (short)0x3F80, (short)0x3F80}; }
    u32x4 gt[4];
#pragma unroll
    for (int i = 0; i < 4; ++i) gt[i] = *(const u32x4*)(T.U + (rowbase + q0 + wid * 32 + i * 8 + (lane >> 3)) * UP + gcol + (lane & 7) * 8);
#pragma unroll
    for (int d0 = 0; d0 < 4; ++d0) asm volatile("" : "+v"(qr[d0]));
#pragma unroll
    for (int i = 0; i < 4; ++i) asm volatile("" : "+v"(gt[i]));
    float c = 0.f; f32x16 o[2]; o[0] = f32x16{}; o[1] = f32x16{};
    const f32x16 zero16 = f32x16{};
    bool mydone = false;
    for (;;) {
        asm volatile("s_waitcnt vmcnt(0) lgkmcnt(0)\n\ts_barrier" ::: "memory");
        if (!mydone) {
            for (int s = 0; s < nW; ++s) {
                const int t = base - s, jb = t - (NT - 4);
                const bool wave_active = (jb < 0) || (64 * jb < wid * 32 + 31);
                if (wave_active) {
                    f32x16 p0, p1, D0, D1;
                    qkt<4>(p0, p1, kbase + s * 8192, qr, zero16, r32, hi);
                    f32x16 L0, L1;
#pragma unroll
                    for (int r = 0; r < 16; ++r) {
                        { const float z = p0[r]; const float e = __builtin_amdgcn_exp2f(-fabsf(z)); const float sp = fmaxf(z, 0.f) + __builtin_amdgcn_logf(1.0f + e); p0[r] = z - sp; L0[r] = -sp; }
                        { const float z = p1[r]; const float e = __builtin_amdgcn_exp2f(-fabsf(z)); const float sp = fmaxf(z, 0.f) + __builtin_amdgcn_logf(1.0f + e); p1[r] = z - sp; L1[r] = -sp; }
                    }
                    if (jb >= 0) {
#pragma unroll
                        for (int r = 0; r < 16; ++r) { const int kv = 64 * jb + 4 * hi + (r & 3) + 8 * (r >> 2);
                            if (kv >= qrel) { p0[r] = -INFINITY; L0[r] = 0.f; } if (kv + 32 >= qrel) { p1[r] = -INFINITY; L1[r] = 0.f; } }
                    }
                    const bf16x8 B0 = pk8(L0, 0), B1 = pk8(L0, 8), B2 = pk8(L1, 0), B3 = pk8(L1, 8);
                    f32x16 X = __builtin_amdgcn_mfma_f32_32x32x16_bf16(Tones, B2, zero16, 0, 0, 0);
                    X = __builtin_amdgcn_mfma_f32_32x32x16_bf16(Tones, B3, X, 0, 0, 0);
                    D0 = __builtin_amdgcn_mfma_f32_32x32x16_bf16(Ta, B0, X, 0, 0, 0);
                    D0 = __builtin_amdgcn_mfma_f32_32x32x16_bf16(Tb, B1, D0, 0, 0, 0);
                    D1 = __builtin_amdgcn_mfma_f32_32x32x16_bf16(Ta, B2, zero16, 0, 0, 0);
                    D1 = __builtin_amdgcn_mfma_f32_32x32x16_bf16(Tb, B3, D1, 0, 0, 0);
                    f32x16 TT = __builtin_amdgcn_mfma_f32_32x32x16_bf16(Tones, B0, X, 0, 0, 0);
                    TT = __builtin_amdgcn_mfma_f32_32x32x16_bf16(Tones, B1, TT, 0, 0, 0);
#pragma unroll
                    for (int r = 0; r < 16; ++r) { p0[r] += D0[r] + c; p1[r] += D1[r] + c; }
                    c += TT[0];
#pragma unroll
                    for (int r = 0; r < 16; ++r) { p0[r] = __builtin_amdgcn_exp2f(p0[r]); p1[r] = __builtin_amdgcn_exp2f(p1[r]); }
                    pv(o, vb0 + s * 8192, pk8(p0, 0), pk8(p0, 8), pk8(p1, 0), pk8(p1, 8));
                }
                if (__all(c < SB_EXIT)) { mydone = true; break; }
            }
        }
        base -= nW;
        if (base < 0) break;
        if (lane == 0) flags[wid] = mydone ? 1u : 0u;
        asm volatile("s_waitcnt lgkmcnt(0)\n\ts_barrier" ::: "memory");
        { const unsigned all = flags[0] & flags[1] & flags[2] & flags[3] & flags[4] & flags[5] & flags[6] & flags[7];
          if (__builtin_amdgcn_readfirstlane(all) != 0u) break; }
        nW = (base + 1 < SBW) ? base + 1 : SBW;
        DMA_WIN();
    }
    {
        ALAS bf16_t* stg = (ALAS bf16_t*)(shm + SB_STG) + wid * 2048;
#pragma unroll
        for (int r = 0; r < 16; ++r) { const int orow = crow(r, hi);
#pragma unroll
            for (int d0 = 0; d0 < 2; ++d0) stg[orow * 64 + d0 * 32 + r32] = (bf16_t)(cvtpk(o[d0][r], 0.f) & 0xffffu); }
        asm volatile("s_waitcnt lgkmcnt(0)" ::: "memory");
#pragma unroll
        for (int i = 0; i < 4; ++i) { const int row = i * 8 + (lane >> 3), ch = lane & 7;
            const u32x4 v = *(ALAS const u32x4*)(stg + row * 64 + ch * 8);
            const long grow = rowbase + q0 + wid * 32 + row;
            const u32x4 g = gt[i];
            float x[8] = {bflo(v.x), bfhi(v.x), bflo(v.y), bfhi(v.y), bflo(v.z), bfhi(v.z), bflo(v.w), bfhi(v.w)};
            const float gg[8] = {bflo(g.x), bfhi(g.x), bflo(g.y), bfhi(g.y), bflo(g.z), bfhi(g.z), bflo(g.w), bfhi(g.w)};
#pragma unroll
            for (int j = 0; j < 8; ++j) x[j] *= gg[j] * __builtin_amdgcn_rcpf(1.0f + __expf(-gg[j]));
            u32x4 w; w.x = cvtpk(x[0], x[1]); w.y = cvtpk(x[2], x[3]); w.z = cvtpk(x[4], x[5]); w.w = cvtpk(x[6], x[7]);
            *(u32x4*)(T.Y + grow * T.ypitch + (ycol - T.ysub) + ch * 8) = w; }
    }
    asm volatile("s_waitcnt vmcnt(0) lgkmcnt(0)\n\ts_barrier" ::: "memory");
#undef DMA_WIN
}
}

constexpr int NWAVES = 8, NTHREADS = NWAVES * 64;
constexpr int BATCH = 8, SEQ = 4096, DM = 1024, DEPTH = 4, M = BATCH * SEQ, D_IN = 3424, NU = 3584;
constexpr float NORM_EPS = 1e-6f;
constexpr float LOG2E = 1.4426950408889634f;
constexpr float QSCALE_64 = 0.125f * LOG2E;
constexpr float QSCALE_96 = 0.10206207261596575f * LOG2E;
constexpr size_t MiB = 1u << 20;
constexpr size_t WS_CTL = 0, CTL_ZERO_BYTES = 64 * 1024;
constexpr size_t WS_WIN = 1 * MiB, WS_WOUT = 29 * MiB, WS_WQ2 = 37 * MiB, WS_WKV2 = 38 * MiB, WS_WPW = 39 * MiB;
constexpr size_t WS_ROPE = 39 * MiB + 512 * 1024, WS_BT = 40 * MiB, WS_KMEAN = 40 * MiB + 256 * 1024;
constexpr size_t WS_SSQQ = 41 * MiB, WS_SSQKV = 41 * MiB + 512 * 1024, WS_SSQO = 42 * MiB, WS_KR = 44 * MiB, WS_CONVH = 46 * MiB, WS_QA = 62 * MiB, WS_KVA = 86 * MiB;
constexpr size_t WS_HNY = 118 * MiB;
constexpr size_t WS_U = 182 * MiB;
constexpr size_t WS_XB = 406 * MiB;
constexpr size_t WS_RSTD = 40 * MiB + 384 * 1024;
constexpr size_t WS_END = 470 * MiB;
static_assert(WS_WIN + (size_t)DEPTH * NU * DM * 2 <= WS_WOUT && WS_WOUT + (size_t)DEPTH * DM * DM * 2 <= WS_WQ2 && WS_WPW + (size_t)DEPTH * 256 * 256 * 2 <= WS_ROPE, "ws map (weights)");
static_assert(WS_ROPE + 2 * SEQ * 16 * 4 <= WS_BT && WS_BT + 4 * 4352 * 4 <= WS_KMEAN && WS_KMEAN + BATCH * 16 * 256 * 4 <= WS_SSQQ && WS_SSQO + (size_t)M * 16 * 4 <= WS_KR, "ws map (tables)");
static_assert(WS_KR + (size_t)M * 32 * 2 <= WS_CONVH && WS_CONVH + (size_t)M * 256 * 2 <= WS_QA && WS_QA + (size_t)M * 384 * 2 <= WS_KVA && WS_KVA + (size_t)M * 512 * 2 <= WS_HNY &&
              WS_HNY + (size_t)M * DM * 2 <= WS_U && WS_U + (size_t)M * NU * 2 <= WS_XB && WS_XB + (size_t)M * DM * 2 <= WS_END && WS_RSTD + (size_t)M * 4 <= WS_SSQQ, "ws map (activations)");
constexpr int CW_BAR = 4096, CW_QUEUE = 8192;
constexpr int RING_OFF = 0, RING_BYTES = 131072, LDSCTL_OFF = RING_BYTES, MISC_OFF = LDSCTL_OFF + 320, LDS_BYTES = 147456;
#ifndef PH_MASK
#define PH_MASK 0xFFFF
#endif
#define PH_EN(k) ((PH_MASK >> (k)) & 1)
static_assert(att::L_END <= RING_BYTES, "attention LDS map");
static_assert(att::SB_END <= RING_BYTES, "stick-breaking LDS map");
#define GAS __attribute__((address_space(1)))
#define LAS __attribute__((address_space(3)))
typedef unsigned short bf16;
typedef unsigned v4u __attribute__((ext_vector_type(4)));
typedef float f32x4 __attribute__((ext_vector_type(4)));
typedef short bf16x8 __attribute__((ext_vector_type(8)));
typedef GAS unsigned gu32;
typedef GAS unsigned long long gu64;
#define RLX_AGENT __ATOMIC_RELAXED, __HIP_MEMORY_SCOPE_AGENT
#define LDS_WAIT() asm volatile("s_waitcnt lgkmcnt(0)" ::: "memory")
#define VM_WAIT() asm volatile("s_waitcnt vmcnt(0)" ::: "memory")
__device__ __forceinline__ unsigned long long rt() { return __builtin_amdgcn_s_memrealtime(); }
__device__ __forceinline__ unsigned f2bf(float f) { unsigned u = __builtin_bit_cast(unsigned, f); return (u + 0x7fffu + ((u >> 16) & 1u)) >> 16; }
typedef float pk2_f2 __attribute__((ext_vector_type(2))); typedef __bf16 pk2_b2 __attribute__((ext_vector_type(2)));
__device__ __forceinline__ unsigned pk2(float lo, float hi) { pk2_f2 v = {lo, hi}; pk2_b2 b = __builtin_convertvector(v, pk2_b2); return __builtin_bit_cast(unsigned, b); }
#define XB_TMO      128
#define XB_XCNT(j)  (256  + 64 * (j))
#define XB_XSUB(j)  (1280 + 64 * (j))
#define XB_XGEN(j)  (2304 + 64 * (j))
#define XB_TOP      3328
#define XB_TOPGEN   3392
#define XCD_BAR_WORDS 3456
#define XB_SPIN_CAP (1u << 18)

__device__ __forceinline__ unsigned xb_ld(unsigned* p)              { return __hip_atomic_load(p, __ATOMIC_RELAXED, __HIP_MEMORY_SCOPE_AGENT); }
__device__ __forceinline__ unsigned xb_add(unsigned* p, unsigned v) { return __hip_atomic_fetch_add(p, v, __ATOMIC_RELAXED, __HIP_MEMORY_SCOPE_AGENT); }
__device__ __forceinline__ unsigned xb_xcc_id() { return (unsigned)__builtin_amdgcn_s_getreg((3 << 11) | 20) & 0xFu; }
#define XB_SPIN(cond, bar) do { unsigned _sp = 0; while (cond) { __builtin_amdgcn_s_sleep(1); \
    if ((++_sp & 255u) == 0u) { if (xb_ld(&(bar)[XB_TMO])) break; if (_sp > XB_SPIN_CAP) { atomicAdd(&(bar)[XB_TMO], 1u); break; } } } } while (0)

struct XcdBarrier {
    unsigned* bar; unsigned x;
    volatile LAS unsigned* st;
};

__device__ __forceinline__ XcdBarrier xcd_barrier_post(unsigned* bar, volatile LAS unsigned* st) {
    XcdBarrier b; b.bar = bar; b.x = xb_xcc_id(); b.st = st;
    if (threadIdx.x == 0) (void)xb_add(&bar[XB_XCNT(b.x)], 1u);
    return b;
}
__device__ __forceinline__ void xcd_barrier_complete(unsigned* bar, unsigned x, unsigned& nloc, unsigned& nx) {
    const unsigned G = gridDim.x * gridDim.y * gridDim.z;
    unsigned sum, cnt, mine, sp = 0u;
    for (;;) {
        sum = 0u; cnt = 0u; mine = 0u;
#pragma unroll
        for (unsigned j = 0; j < 16; ++j) { const unsigned c = xb_ld(&bar[XB_XCNT(j)]); sum += c; cnt += (c > 0u) ? 1u : 0u; mine = (j == x) ? c : mine; }
        if (sum == G) break;
        __builtin_amdgcn_s_sleep(1);
        if ((++sp & 255u) == 0u) { if (xb_ld(&bar[XB_TMO])) break; if (sp > XB_SPIN_CAP) { atomicAdd(&bar[XB_TMO], 1u); break; } }
    }
    nloc = mine > 0u ? mine : 1u; nx = cnt > 0u ? cnt : 1u;
}

__device__ __forceinline__ void xcd_barrier(const XcdBarrier& b) {
    asm volatile("s_waitcnt vmcnt(0)" ::: "memory");
    __syncthreads();
    if (threadIdx.x == 0) {
        unsigned* bar = b.bar;
        __builtin_amdgcn_s_waitcnt(0);
        unsigned nloc = b.st[0], nx = b.st[1];
        if (nloc == 0u) { xcd_barrier_complete(bar, b.x, nloc, nx); b.st[0] = nloc; b.st[1] = nx; }
        const unsigned old = xb_add(&bar[XB_XSUB(b.x)], 1u);
        const unsigned gen = old / nloc;
        if (old + 1u == (gen + 1u) * nloc) {
            __builtin_amdgcn_fence(__ATOMIC_RELEASE, "agent");
            asm volatile("s_waitcnt vmcnt(0)" ::: "memory");
            const unsigned og = xb_add(&bar[XB_TOP], 1u);
            const unsigned tg = og / nx;
            if (og + 1u == (tg + 1u) * nx) xb_add(&bar[XB_TOPGEN], 1u);
            else XB_SPIN(xb_ld(&bar[XB_TOPGEN]) == tg, bar);
            __builtin_amdgcn_fence(__ATOMIC_ACQUIRE, "agent");
            xb_add(&bar[XB_XGEN(b.x)], 1u);
            asm volatile("s_waitcnt vmcnt(0)" ::: "memory");
        } else {
            XB_SPIN(xb_ld(&bar[XB_XGEN(b.x)]) == gen, bar);
            __builtin_amdgcn_fence(__ATOMIC_ACQUIRE, "agent");
            asm volatile("s_waitcnt vmcnt(0)" ::: "memory");
        }
    }
    __syncthreads();
}

struct Frame {
    LAS unsigned char* lds;
    volatile LAS unsigned* MISC;
    gu32* ctl;
    int tid, lane, wave, G, gw, NGW;
    const float* in[16];
    float* out; unsigned char* ws;
};
#define LOCAL_FRAME() Frame F = F0; { int t_ = threadIdx.x; asm volatile("" : "+v"(t_)); F.tid = t_; F.lane = t_ & 63; F.wave = __builtin_amdgcn_readfirstlane(t_ >> 6); \
    F.gw = blockIdx.x * NWAVES + F.wave; unsigned char* w_ = F0.ws; asm volatile("" : "+s"(w_)); F.ws = w_; }
__device__ __forceinline__ float wave_sum(float v) {
#pragma unroll
    for (int o = 1; o < 64; o <<= 1) v += __shfl_xor(v, o);
    return v;
}
__device__ __forceinline__ int ropemap(int j) { const int f = j >> 3, jj = j & 7; return jj < 4 ? 4 * f + jj : 16 + 4 * f + (jj - 4); }
__device__ __forceinline__ int src_in(int n) {
    const int t = n >> 8, c = n & 255;
    if (t == 0) return c < 192 ? c : -1;
    if (t == 1) return c < 128 ? 192 + c : (c < 160 ? 320 + ropemap(c - 128) : -1);
    return 352 + (t - 2) * 256 + c;
}
__device__ __forceinline__ int src_q(int n) {
    if (n < 256) return (n >> 6) * 96 + (n & 63);
    if (n < 384) { const int j = n - 256; return (j >> 5) * 96 + 64 + ropemap(j & 31); }
    return -1;
}
__device__ __forceinline__ int src_kv(int n) {
    if (n < 256) return (n >> 6) * 128 + (n & 63);
    const int j = n - 256; return (j >> 6) * 128 + 64 + (j & 63);
}
template <int MAP> __device__ __forceinline__ void cvt_weight(const float* __restrict__ W, const float* __restrict__ gv, bf16* __restrict__ Wt, int N, int K, int Ksrc, int Nsrc, int gt, int ngt) {
    constexpr int CU = 2;
    const int items = N * (K / 8);
    for (int it0 = gt; it0 < items; it0 += CU * ngt) {
        float w[CU][8], g[CU][8]; unsigned okm[CU];
#pragma unroll
        for (int u = 0; u < CU; ++u) { const int it = it0 + u * ngt; const int wv_ = it >> 6, ln_ = it & 63, N8 = N >> 3; const int n = (wv_ % N8) * 8 + (ln_ & 7), kc = (wv_ / N8) * 8 + (ln_ >> 3);
            const int sc = MAP == 0 ? src_in(n) : MAP == 1 ? src_q(n) : MAP == 2 ? src_kv(n) : n;
            const bool ok = (it < items) && (sc >= 0); okm[u] = 0u;
#pragma unroll
            for (int i = 0; i < 8; ++i) { const int kk = kc * 8 + i; const bool okk = ok && (kk < Ksrc); okm[u] |= okk ? (1u << i) : 0u;
                w[u][i] = W[okk ? (size_t)kk * Nsrc + sc : (size_t)0]; g[u][i] = gv ? gv[okk ? kk : 0] : 1.0f; } }
#pragma unroll
        for (int u = 0; u < CU; ++u) { const int it = it0 + u * ngt; const int wv_ = it >> 6, ln_ = it & 63, N8 = N >> 3; const int n = (wv_ % N8) * 8 + (ln_ & 7), kc = (wv_ / N8) * 8 + (ln_ >> 3);
            if (it < items) { float v[8];
#pragma unroll
                for (int i = 0; i < 8; ++i) v[i] = ((okm[u] >> i) & 1u) ? w[u][i] * g[u][i] : 0.0f;
                v4u o; o.x = pk2(v[0], v[1]); o.y = pk2(v[2], v[3]); o.z = pk2(v[4], v[5]); o.w = pk2(v[6], v[7]);
                *(GAS v4u*)(Wt + (size_t)n * K + kc * 8) = o; } }
    }
}
__device__ __forceinline__ void row_to_bf16_rstd(const f32x4 (&v)[4], bf16* orow, float* rstd, int lane) {
    float s = 0.f;
#pragma unroll
    for (int j = 0; j < 4; ++j) s += (v[j][0] * v[j][0] + v[j][1] * v[j][1]) + (v[j][2] * v[j][2] + v[j][3] * v[j][3]);
    const float r = 1.0f / sqrtf(wave_sum(s) * (1.0f / 1024.0f) + NORM_EPS);
    if (lane == 0) *rstd = r;
#pragma unroll
    for (int j = 0; j < 4; ++j) *(GAS unsigned long long*)(orow + 4 * lane + 256 * j) = (unsigned long long)pk2(v[j][0], v[j][1]) | ((unsigned long long)pk2(v[j][2], v[j][3]) << 32);
}

__device__ __forceinline__ void p_prologue(Frame& F0) {
    LOCAL_FRAME();
    const int gt = blockIdx.x * NTHREADS + F.tid, ngt = F.G * NTHREADS;
    for (int l = 0; l < DEPTH; ++l) {
        cvt_weight<0>(F.in[2] + (size_t)l * DM * D_IN, F.in[1] + l * DM, (bf16*)(F.ws + WS_WIN) + (size_t)l * NU * DM, NU, DM, DM, D_IN, gt, ngt);
        cvt_weight<1>(F.in[4] + (size_t)l * 192 * 384, F.in[3] + l * 192, (bf16*)(F.ws + WS_WQ2) + (size_t)l * 512 * 256, 512, 256, 192, 384, gt, ngt);
        cvt_weight<2>(F.in[6] + (size_t)l * 128 * 512, F.in[5] + l * 128, (bf16*)(F.ws + WS_WKV2) + (size_t)l * 512 * 256, 512, 256, 128, 512, gt, ngt);
        cvt_weight<3>(F.in[12] + (size_t)l * 256 * 256, nullptr, (bf16*)(F.ws + WS_WPW) + (size_t)l * 256 * 256, 256, 256, 256, 256, gt, ngt);
        cvt_weight<3>(F.in[14] + (size_t)l * DM * DM, nullptr, (bf16*)(F.ws + WS_WOUT) + (size_t)l * DM * DM, DM, DM, DM, DM, gt, ngt);
    }
    float* cosT = (float*)(F.ws + WS_ROPE); float* sinT = cosT + SEQ * 16;
    for (int it = gt; it < SEQ * 16; it += ngt) { const int pos = it >> 4, i = it & 15;
        const float freq = powf(10000.0f, -(float)i / 16.0f); const float ang = (float)pos * freq;
        cosT[it] = cosf(ang); sinT[it] = sinf(ang); }
    float* BT = (float*)(F.ws + WS_BT);
    for (int it = gt; it < 4 * att::TBL_N; it += ngt) { const int h = it / att::TBL_N, idx = it % att::TBL_N; const int dist = idx - 256; const int n = dist > 0 ? dist : 0;
        int bucket;
        if (n < 16) bucket = n;
        else { bucket = 16 + (int)floor((log2((double)n) - 4.0) * (8.0 / 3.0) + 1e-9); if (bucket > 31) bucket = 31; }
        BT[it] = F.in[7][bucket * 4 + h] * 1.4426950408889634f; }
    const float* x = F.in[0]; bf16* XB = (bf16*)(F.ws + WS_XB); float* RS = (float*)(F.ws + WS_RSTD);
    for (int m0 = F.gw * 4; m0 < M; m0 += F.NGW * 4) { f32x4 v[4][4];
#pragma unroll
        for (int r = 0; r < 4; ++r)
#pragma unroll
            for (int j = 0; j < 4; ++j) v[r][j] = *(const f32x4*)(x + (size_t)(m0 + r) * DM + 4 * F.lane + 256 * j);
#pragma unroll
        for (int r = 0; r < 4; ++r) row_to_bf16_rstd(v[r], XB + (size_t)(m0 + r) * DM, RS + m0 + r, F.lane); }
}

__device__ __forceinline__ void conv_unit(Frame& F0, int l, int unit) {
    LOCAL_FRAME();
    const bf16* U = (const bf16*)(F.ws + WS_U); bf16* CH = (bf16*)(F.ws + WS_CONVH);
    LAS float* xg = (LAS float*)F.lds;
    const int r0 = unit * 64, s0 = r0 & (SEQ - 1);
    {
        v4u av[6], gv[6];
#pragma unroll
        for (int k = 0; k < 6; ++k) { const int it = F.tid + k * NTHREADS; const int rr = it >> 5, cg = it & 31; const int srow = r0 - 30 + rr;
            if (it < 94 * 32 && s0 - 30 + rr >= 0) { av[k] = *(const GAS v4u*)(U + (size_t)srow * NU + 2048 + cg * 8); gv[k] = *(const GAS v4u*)(U + (size_t)srow * NU + 2304 + cg * 8); }
            else { av[k] = (v4u){0u, 0u, 0u, 0u}; gv[k] = (v4u){0u, 0u, 0u, 0u}; } }
#pragma unroll
        for (int k = 0; k < 6; ++k) { const int it = F.tid + k * NTHREADS; const int rr = it >> 5, cg = it & 31;
            if (it < 94 * 32) {
                const float a8[8] = {pg8::bf_lo(av[k].x), pg8::bf_hi(av[k].x), pg8::bf_lo(av[k].y), pg8::bf_hi(av[k].y), pg8::bf_lo(av[k].z), pg8::bf_hi(av[k].z), pg8::bf_lo(av[k].w), pg8::bf_hi(av[k].w)};
                const float g8[8] = {pg8::bf_lo(gv[k].x), pg8::bf_hi(gv[k].x), pg8::bf_lo(gv[k].y), pg8::bf_hi(gv[k].y), pg8::bf_lo(gv[k].z), pg8::bf_hi(gv[k].z), pg8::bf_lo(gv[k].w), pg8::bf_hi(gv[k].w)};
                float o[8];
#pragma unroll
                for (int j = 0; j < 8; ++j) o[j] = a8[j] * __builtin_amdgcn_rcpf(1.0f + __expf(-g8[j]));
                *(LAS f32x4*)(xg + rr * 256 + cg * 8) = (f32x4){o[0], o[1], o[2], o[3]}; *(LAS f32x4*)(xg + rr * 256 + cg * 8 + 4) = (f32x4){o[4], o[5], o[6], o[7]}; } }
    }
    __syncthreads();
    const int c = F.tid & 255, rh = F.tid >> 8;
    float y[32];
    { float win[62], wt[31];
      const float* dw = F.in[8] + (size_t)l * 31 * 256 + c;
#pragma unroll
      for (int w = 0; w < 31; ++w) wt[w] = dw[w * 256];
#pragma unroll
      for (int i = 0; i < 62; ++i) win[i] = xg[(rh * 32 + i) * 256 + c];
      const float bias = F.in[9][l * 256 + c];
#pragma unroll
      for (int s = 0; s < 32; ++s) { float a = bias;
#pragma unroll
          for (int w = 0; w < 31; ++w) a += wt[w] * win[s + w];
          y[s] = a; } }
    __syncthreads();
#pragma unroll
    for (int s = 0; s < 32; ++s) xg[(rh * 32 + s) * 256 + c] = y[s];
    __syncthreads();
    const f32x4 lg = *(const f32x4*)(F.in[10] + l * 256 + 4 * F.lane), lb = *(const f32x4*)(F.in[11] + l * 256 + 4 * F.lane);
#pragma unroll
    for (int i = 0; i < 8; ++i) { const int row = 8 * F.wave + i;
        const f32x4 v = *(LAS f32x4*)(xg + row * 256 + 4 * F.lane);
        const float mean = wave_sum((v[0] + v[1]) + (v[2] + v[3])) * (1.0f / 256.0f);
        const f32x4 d = v - mean;
        const float var = wave_sum((d[0] * d[0] + d[1] * d[1]) + (d[2] * d[2] + d[3] * d[3])) * (1.0f / 256.0f);
        const float rstd = 1.0f / sqrtf(var + NORM_EPS);
        f32x4 o = d * rstd * lg + lb;
#pragma unroll
        for (int j = 0; j < 4; ++j) o[j] = o[j] * __builtin_amdgcn_rcpf(1.0f + __expf(-o[j]));
        *(GAS unsigned long long*)(CH + (size_t)(r0 + row) * 256 + 4 * F.lane) = (unsigned long long)pk2(o[0], o[1]) | ((unsigned long long)pk2(o[2], o[3]) << 32); }
    __syncthreads();
}
__device__ __forceinline__ void kmean_unit(Frame& F0, int item) {
    LOCAL_FRAME();
    const bf16* U = (const bf16*)(F.ws + WS_U); float* KM = (float*)(F.ws + WS_KMEAN);
    LAS float* part = (LAS float*)F.lds;
    const int cg = F.tid & 31, rg = F.tid >> 5; const size_t base = (size_t)item * 256 + rg * 16;
    float a[8];
#pragma unroll
    for (int j = 0; j < 8; ++j) a[j] = 0.f;
#pragma unroll
    for (int i = 0; i < 16; ++i) { const v4u k = *(const GAS v4u*)(U + (base + i) * NU + 1536 + cg * 8);
        a[0] += pg8::bf_lo(k.x); a[1] += pg8::bf_hi(k.x); a[2] += pg8::bf_lo(k.y); a[3] += pg8::bf_hi(k.y); a[4] += pg8::bf_lo(k.z); a[5] += pg8::bf_hi(k.z); a[6] += pg8::bf_lo(k.w); a[7] += pg8::bf_hi(k.w); }
#pragma unroll
    for (int j = 0; j < 8; ++j) part[rg * 256 + cg * 8 + j] = a[j];
    __syncthreads();
    if (F.tid < 256) { float s = 0.f;
#pragma unroll
        for (int r = 0; r < 16; ++r) s += part[r * 256 + F.tid];
        KM[(size_t)item * 256 + F.tid] = s * (1.0f / 256.0f); }
    __syncthreads();
}
__device__ __forceinline__ void p_residual(Frame& F0, int l) {
    LOCAL_FRAME();
    bf16* XB = (bf16*)(F.ws + WS_XB); float* RS = (float*)(F.ws + WS_RSTD);
    const bf16* T = (const bf16*)(F.ws + WS_U); const float* SS = (const float*)(F.ws + WS_SSQO);
    const float* gp = F.in[15] + l * DM;
    f32x4 g[2][2];
#pragma unroll
    for (int j = 0; j < 2; ++j) { g[j][0] = *(const f32x4*)(gp + 8 * F.lane + 512 * j); g[j][1] = *(const f32x4*)(gp + 8 * F.lane + 512 * j + 4); }
    constexpr int R = 4;
    for (int m0 = F.gw * R; m0 < M; m0 += F.NGW * R) {
        v4u xw[R][2], tw[R][2]; f32x4 sq[R][4];
#pragma unroll
        for (int r = 0; r < R; ++r) { const size_t m = (size_t)(m0 + r);
#pragma unroll
            for (int j = 0; j < 2; ++j) { xw[r][j] = *(const GAS v4u*)(XB + m * DM + 8 * F.lane + 512 * j); tw[r][j] = *(const GAS v4u*)(T + m * DM + 8 * F.lane + 512 * j); }
#pragma unroll
            for (int q = 0; q < 4; ++q) sq[r][q] = *(const f32x4*)(SS + m * 16 + 4 * q); }
#pragma unroll
        for (int r = 0; r < R; ++r) { const size_t m = (size_t)(m0 + r);
            const float ss = (((sq[r][0][0] + sq[r][0][1]) + (sq[r][0][2] + sq[r][0][3])) + ((sq[r][1][0] + sq[r][1][1]) + (sq[r][1][2] + sq[r][1][3]))) + (((sq[r][2][0] + sq[r][2][1]) + (sq[r][2][2] + sq[r][2][3])) + ((sq[r][3][0] + sq[r][3][1]) + (sq[r][3][2] + sq[r][3][3])));
            const float rstd = 1.0f / sqrtf(ss * (1.0f / 1024.0f) + NORM_EPS);
            f32x4 v[2][2]; float s2 = 0.f;
#pragma unroll
            for (int j = 0; j < 2; ++j) {
                const f32x4 xa = (f32x4){pg8::bf_lo(xw[r][j].x), pg8::bf_hi(xw[r][j].x), pg8::bf_lo(xw[r][j].y), pg8::bf_hi(xw[r][j].y)}, xb = (f32x4){pg8::bf_lo(xw[r][j].z), pg8::bf_hi(xw[r][j].z), pg8::bf_lo(xw[r][j].w), pg8::bf_hi(xw[r][j].w)};
                const f32x4 ta = (f32x4){pg8::bf_lo(tw[r][j].x), pg8::bf_hi(tw[r][j].x), pg8::bf_lo(tw[r][j].y), pg8::bf_hi(tw[r][j].y)}, tb = (f32x4){pg8::bf_lo(tw[r][j].z), pg8::bf_hi(tw[r][j].z), pg8::bf_lo(tw[r][j].w), pg8::bf_hi(tw[r][j].w)};
                v[j][0] = xa + ta * rstd * g[j][0]; v[j][1] = xb + tb * rstd * g[j][1];
#pragma unroll
                for (int h = 0; h < 2; ++h) s2 += (v[j][h][0] * v[j][h][0] + v[j][h][1] * v[j][h][1]) + (v[j][h][2] * v[j][h][2] + v[j][h][3] * v[j][h][3]); }
            if (l + 1 < DEPTH) {
                const float rn = 1.0f / sqrtf(wave_sum(s2) * (1.0f / 1024.0f) + NORM_EPS);
                if (F.lane == 0) RS[m] = rn;
#pragma unroll
                for (int j = 0; j < 2; ++j) { v4u o; o.x = pk2(v[j][0][0], v[j][0][1]); o.y = pk2(v[j][0][2], v[j][0][3]); o.z = pk2(v[j][1][0], v[j][1][1]); o.w = pk2(v[j][1][2], v[j][1][3]);
                    *(GAS v4u*)(XB + m * DM + 8 * F.lane + 512 * j) = o; }
            } else {
#pragma unroll
                for (int j = 0; j < 2; ++j) { *(f32x4*)(F.out + m * DM + 8 * F.lane + 512 * j) = v[j][0]; *(f32x4*)(F.out + m * DM + 8 * F.lane + 512 * j + 4) = v[j][1]; }
            }
        }
    }
}


#if defined(DBG_SEL)
#ifndef DBG_LAYER
#define DBG_LAYER 0
#endif
#ifndef DBG_AMP
#define DBG_AMP 4.0f
#endif
constexpr int CW_DBG = 12288;
__device__ __forceinline__ float blk_sum(float v, LAS float* red, int tid) {
    v = wave_sum(v);
    __syncthreads();
    if ((tid & 63) == 0) red[tid >> 6] = v;
    __syncthreads();
    float s = 0.f;
#pragma unroll
    for (int i = 0; i < 8; ++i) s += red[i];
    __syncthreads();
    return s;
}
__device__ __forceinline__ float blk_max(float v, LAS float* red, int tid) {
#pragma unroll
    for (int o = 1; o < 64; o <<= 1) v = fmaxf(v, __shfl_xor(v, o));
    __syncthreads();
    if ((tid & 63) == 0) red[tid >> 6] = v;
    __syncthreads();
    float s = red[0];
#pragma unroll
    for (int i = 1; i < 8; ++i) s = fmaxf(s, red[i]);
    __syncthreads();
    return s;
}
__device__ __forceinline__ float bfv(const bf16* p) { return __uint_as_float(((unsigned)*p) << 16); }
__device__ __forceinline__ int dbg_bucket(int dist) { const int n = dist > 0 ? dist : 0; if (n < 16) return n; int b = 16 + (int)(log((double)n / 16.0) / log(64.0) * 16.0 + 1e-9); return b > 31 ? 31 : b; }
__device__ __forceinline__ void dbg_report(Frame& F, float num, float den, int tid) {
    if (tid == 0) { float e = sqrtf(num) / fmaxf(sqrtf(den), 1e-20f); if (!(e == e)) e = 100.f; atomicMax((unsigned*)(F.ctl + CW_DBG), __float_as_uint(e)); }
}
__device__ __forceinline__ void dbg_task(Frame& F, int l, int mixer, int b, int t, int h) {
    const int tid = threadIdx.x;
    const bf16* U = (const bf16*)(F.ws + WS_U); const bf16* Y = (const bf16*)(F.ws + WS_HNY);
    LAS float* sc = (LAS float*)F.lds;
    LAS float* aux = sc + 4096;
    LAS float* qv = aux + 4096;
    LAS float* vec = qv + 128;
    LAS float* red = vec + 256;
    LAS int* sel = (LAS int*)(red + 16);
    const size_t row = (size_t)b * SEQ + t; const size_t rb = (size_t)b * SEQ;
    float yn = 0.f, ycmp = 0.f; int ycol = 0;
    __syncthreads();
    if (mixer == 0) {
        const float* guq = F.in[3] + l * 192; const float* wuq = F.in[4] + (size_t)l * 192 * 384;
        const float* gkv = F.in[5] + l * 128; const float* wukv = F.in[6] + (size_t)l * 128 * 512;
        float ssq = 0.f;
        for (int r = 0; r < 192; ++r) { const float c = bfv(U + row * NU + r); ssq += c * c; }
        const float rq = 1.0f / sqrtf(ssq / 192.0f + NORM_EPS);
        if (tid < 96) { float a = 0.f; for (int r = 0; r < 192; ++r) a += bfv(U + row * NU + r) * rq * guq[r] * wuq[r * 384 + h * 96 + tid]; qv[tid] = a; }
        __syncthreads();
        if (tid < 16) { const float fr = powf(10000.0f, -(float)tid / 16.0f), ang = (float)t * fr, c = cosf(ang), s = sinf(ang); const float x1 = qv[64 + tid], x2 = qv[80 + tid]; qv[64 + tid] = x1 * c - x2 * s; qv[80 + tid] = x1 * s + x2 * c; }
        __syncthreads();
        if (tid < 128) { float a = 0.f; for (int d = 0; d < 64; ++d) a += wukv[tid * 512 + h * 128 + d] * qv[d]; vec[tid] = a * gkv[tid]; }
        __syncthreads();
        const float scale = 0.10206207261596575f;
        for (int s = tid; s <= t; s += NTHREADS) {
            const bf16* ur = U + (rb + s) * NU + 256;
            float ss = 0.f, dn = 0.f;
            for (int r = 0; r < 128; ++r) { const float c = bfv(ur + r); ss += c * c; dn += c * vec[r]; }
            const float rk = 1.0f / sqrtf(ss / 128.0f + NORM_EPS);
            aux[s] = rk;
            float dr = 0.f;
            for (int i = 0; i < 16; ++i) {
                const int f = i >> 2, jj = i & 3; const float x1 = bfv(ur + 128 + 8 * f + jj), x2 = bfv(ur + 128 + 8 * f + 4 + jj);
                const float fr = powf(10000.0f, -(float)i / 16.0f), ang = (float)s * fr, c = cosf(ang), sn = sinf(ang);
                dr += (x1 * c - x2 * sn) * qv[64 + i] + (x1 * sn + x2 * c) * qv[80 + i]; }
            sc[s] = (dn * rk + dr) * scale;
        }
        __syncthreads();
        float mx = -INFINITY; for (int s = tid; s <= t; s += NTHREADS) mx = fmaxf(mx, sc[s]);
        mx = blk_max(mx, red, tid);
        float sm = 0.f; for (int s = tid; s <= t; s += NTHREADS) { const float p = expf(sc[s] - mx); sc[s] = p; sm += p; }
        sm = blk_sum(sm, red, tid);
        { const int r = tid & 127, q4 = tid >> 7; float a = 0.f;
          for (int s = q4; s <= t; s += 4) a += sc[s] * bfv(U + (rb + s) * NU + 256 + r) * aux[s];
          __syncthreads(); ((LAS float*)F.lds)[8192 + 512 + tid] = a; __syncthreads();
          if (tid < 128) vec[128 + tid] = (((LAS float*)F.lds)[8192 + 512 + tid] + ((LAS float*)F.lds)[8192 + 512 + 128 + tid] + ((LAS float*)F.lds)[8192 + 512 + 256 + tid] + ((LAS float*)F.lds)[8192 + 512 + 384 + tid]) * gkv[tid] / sm; }
        __syncthreads();
        if (tid < 64) { float o = 0.f; for (int r = 0; r < 128; ++r) o += vec[128 + r] * wukv[r * 512 + h * 128 + 64 + tid]; yn = o; }
        ycol = h * 64;
    } else if (mixer == 1) {
        const bf16* qp = U + row * NU + 512 + h * 64;
        if (tid < 64) qv[tid] = bfv(qp + tid) / LOG2E;
        __syncthreads();
        for (int s = tid; s < t; s += NTHREADS) { const bf16* kp = U + (rb + s) * NU + 768 + h * 64; float z = 0.f; for (int d = 0; d < 64; ++d) z += qv[d] * bfv(kp + d);
            const float sp = fmaxf(z, 0.f) + log1pf(expf(-fabsf(z)));
            sc[s] = z - sp;
            aux[s] = -sp; }
        __syncthreads();
        if (tid == 0) { float run = 0.f; for (int s = t - 1; s >= 0; --s) { const float a = expf(sc[s] + run); run += aux[s]; sc[s] = a; } }
        __syncthreads();
        if (tid < 64) { float o = 0.f; for (int s = 0; s < t; ++s) { const float a = sc[s]; if (a != 0.f) o += a * bfv(U + (rb + s) * NU + 1024 + h * 64 + tid); } yn = o; }
        ycol = 256 + h * 64;
    } else {
        const bf16* qp = U + row * NU + 1280 + h * 64;
        if (tid < 64) qv[tid] = bfv(qp + tid) / LOG2E;
        __syncthreads();
        const int own = t >> 8;
        { const int j = tid >> 5, dg = tid & 31; float g = 0.f;
          if (j < own) { float m0 = 0.f, m1 = 0.f; for (int s = 0; s < 256; ++s) { const bf16* kp = U + (rb + j * 256 + s) * NU + 1536 + h * 64 + 2 * dg; m0 += bfv(kp); m1 += bfv(kp + 1); }
              g = (m0 * qv[2 * dg] + m1 * qv[2 * dg + 1]) * (1.0f / 256.0f); }
#pragma unroll
          for (int o = 1; o < 32; o <<= 1) g += __shfl_xor(g, o);
          if (dg == 0) vec[j] = (j < own) ? g : -INFINITY; }
        __syncthreads();
        if (tid == 0) { float v1 = -INFINITY, v2 = -INFINITY, v3 = -INFINITY; int i1 = -1, i2 = -1, i3 = -1;
            for (int j = 0; j < own; ++j) { const float g = vec[j];
                if (g > v1) { v3 = v2; i3 = i2; v2 = v1; i2 = i1; v1 = g; i1 = j; } else if (g > v2) { v3 = v2; i3 = i2; v2 = g; i2 = j; } else if (g > v3) { v3 = g; i3 = j; } }
            sel[0] = i1; sel[1] = i2; sel[2] = i3; }
        __syncthreads();
        const int s0 = sel[0], s1 = sel[1], s2 = sel[2];
        const float* rb_ = F.in[7];
        for (int s = tid; s <= t; s += NTHREADS) { const int blk = s >> 8; const bool ok = (blk == own) || blk == s0 || blk == s1 || blk == s2;
            float z = -INFINITY;
            if (ok) { const bf16* kp = U + (rb + s) * NU + 1536 + h * 64; z = 0.f; for (int d = 0; d < 64; ++d) z += qv[d] * bfv(kp + d); z += rb_[dbg_bucket(t - s) * 4 + h]; }
            sc[s] = z; }
        __syncthreads();
        float mx = -INFINITY; for (int s = tid; s <= t; s += NTHREADS) mx = fmaxf(mx, sc[s]);
        mx = blk_max(mx, red, tid);
        float sm = 0.f; for (int s = tid; s <= t; s += NTHREADS) { const float p = expf(sc[s] - mx); sc[s] = p; sm += p; }
        sm = blk_sum(sm, red, tid);
        if (tid < 64) { float o = 0.f; for (int s = 0; s <= t; ++s) { const float p = sc[s]; if (p != 0.f) o += p * bfv(U + (rb + s) * NU + 1792 + h * 64 + tid); } yn = o / sm; }
        ycol = 512 + h * 64;
    }
    float num = 0.f, den = 0.f;
    if (tid < 64) { const float g = bfv(U + row * NU + 2560 + ycol + tid); yn *= g / (1.0f + expf(-g)); ycmp = bfv(Y + row * DM + ycol + tid); num = (ycmp - yn) * (ycmp - yn); den = yn * yn; }
    num = blk_sum(num, red, tid); den = blk_sum(den, red, tid);
    dbg_report(F, num, den, tid);
    __syncthreads();
}
__device__ __forceinline__ void dbg_check(Frame& F, int l) {
    constexpr int ts[24] = {0, 1, 2, 5, 17, 31, 32, 33, 63, 64, 100, 255, 256, 257, 300, 511, 512, 1000, 1023, 1024, 2047, 2048, 3000, 4095};
    for (int task = blockIdx.x; task < 576; task += F.G) {
        const int h = task & 3, ti = (task >> 2) % 24, bb = (task / 96) & 1, mixer = task / 192;
        if (!((DBG_SEL >> mixer) & 1)) continue;
        int t = 0;
#pragma unroll
        for (int i = 0; i < 24; ++i) if (i == ti) t = ts[i];
        dbg_task(F, l, mixer, bb ? 7 : 0, t, h);
    }
}
__device__ __forceinline__ void dbg_check_u(Frame& F, int l) {
    if (blockIdx.x != 0) return;
    const bf16* U = (const bf16*)(F.ws + WS_U); const bf16* HN = (const bf16*)(F.ws + WS_XB); const float* W = F.in[2] + (size_t)l * DM * D_IN;
    const int tid = threadIdx.x;
    const int rsel = tid >> 7, cs = tid & 127;
    const size_t row = rsel == 0 ? 0 : rsel == 1 ? 4097 : rsel == 2 ? 20000 : 32767;
    int ucol, src;
    if (cs < 32) { ucol = 256 + 128 + cs; src = 320 + ropemap(cs); }
    else if (cs < 64) { const int c = 6 * (cs - 32); ucol = c; src = c; }
    else if (cs < 96) { const int c = 4 * (cs - 64); ucol = 256 + c; src = 192 + c; }
    else { const int k = cs - 96; const int tile = 2 + (k % 12), c = (k * 37) & 255; ucol = tile * 256 + c; src = 352 + (tile - 2) * 256 + c; }
    float a = 0.f;
    for (int k = 0; k < DM; ++k) a += bfv(HN + row * DM + k) * F.in[1][l * DM + k] * W[(size_t)k * D_IN + src];
    a *= ((const float*)(F.ws + WS_RSTD))[row];
    if (ucol >= 512 && ucol < 768) a *= QSCALE_64;
    if (ucol >= 1280 && ucol < 1536) a *= QSCALE_64;
    const float u = bfv(U + row * NU + ucol);
    float e = fabsf(u - a) / (fabsf(a) + 0.05f); if (!(e == e)) e = 100.f;
    atomicMax((unsigned*)(F.ctl + CW_DBG), __float_as_uint(e));
}
#endif
struct Args { const float* in[16]; float* out; unsigned char* ws; int mode, pad; };
__global__ void __launch_bounds__(NTHREADS, 2) hymba_fwd(Args args) {
    extern __shared__ __attribute__((aligned(16))) unsigned char lds[];
    Frame F;
    F.lds = (LAS unsigned char*)lds;
    F.MISC = (volatile LAS unsigned*)(F.lds + MISC_OFF);
    F.tid = threadIdx.x; F.lane = F.tid & 63; F.wave = __builtin_amdgcn_readfirstlane(F.tid >> 6);
    F.G = gridDim.x; F.gw = blockIdx.x * NWAVES + F.wave; F.NGW = F.G * NWAVES;
#pragma unroll
    for (int i = 0; i < 16; ++i) F.in[i] = args.in[i];
    F.out = args.out; F.ws = args.ws; F.ctl = (gu32*)(args.ws + WS_CTL);
#if defined(ZERO_ALL_LDS)
    for (int u = F.tid; u < LDS_BYTES / 4; u += NTHREADS) ((LAS unsigned*)(F.lds))[u] = 0u;
#endif
    for (int u = F.tid; u < (LDS_BYTES - LDSCTL_OFF) / 4; u += NTHREADS) ((LAS unsigned*)(F.lds + LDSCTL_OFF))[u] = 0u;
    __syncthreads();
    { const unsigned simd = (unsigned)__builtin_amdgcn_s_getreg((1 << 11) | (4 << 6) | 4) & 3u; if (F.lane == 0) F.MISC[32 + F.wave] = simd; }
    __syncthreads();
    int whalf = 0;
    { const unsigned me = F.MISC[32 + F.wave]; int rank = 0;
#pragma unroll
      for (int j = 0; j < NWAVES; ++j) rank += (j < F.wave && F.MISC[32 + j] == me) ? 1 : 0;
#if defined(ANTI_HALF)
      whalf = __builtin_amdgcn_readfirstlane((int)(me & 1u)); }
#else
      whalf = __builtin_amdgcn_readfirstlane(rank & 1); }
#endif
    XcdBarrier bar = xcd_barrier_post((unsigned*)(F.ctl + CW_BAR), F.MISC + 8);
    const unsigned lds0 = (unsigned)(uintptr_t)lds;
#ifndef DUP_PHASE
#define DUP_PHASE 0
#endif
#if DUP_PHASE
#define DUP_BEGIN(k) _Pragma("nounroll") for (int rep_ = 0; rep_ < ((DUP_PHASE == (k)) ? 2 : 1); ++rep_) { if (rep_) GRID_BAR();
#define DUP_END(k) }
#define DUP_REP rep_
#else
#define DUP_BEGIN(k) { const int rep_ = 0; (void)rep_;
#define DUP_END(k) }
#define DUP_REP 0
#endif
#define GRID_BAR() do { XcdBarrier b_ = bar; asm volatile("" : "+s"(b_.x)); xcd_barrier(b_); } while (0)

#define PHASE_PTRS() unsigned char* ws_ = F.ws; asm volatile("" : "+s"(ws_)); \
    bf16* const HNY = (bf16*)(ws_ + WS_HNY); bf16* const UB = (bf16*)(ws_ + WS_U); \
    float* const SSQQ = (float*)(ws_ + WS_SSQQ); float* const SSQKV = (float*)(ws_ + WS_SSQKV); float* const SSQO = (float*)(ws_ + WS_SSQO); \
    bf16* const KRB = (bf16*)(ws_ + WS_KR); bf16* const QAB = (bf16*)(ws_ + WS_QA); bf16* const KVAB = (bf16*)(ws_ + WS_KVA); bf16* const CHB = (bf16*)(ws_ + WS_CONVH); \
    const float* const cosT = (const float*)(ws_ + WS_ROPE); const float* const sinT = cosT + SEQ * 16; \
    (void)HNY; (void)UB; (void)SSQQ; (void)SSQKV; (void)SSQO; (void)KRB; (void)QAB; (void)KVAB; (void)CHB; (void)cosT; (void)sinT

#if PH_EN(0)
    p_prologue(F);
#if DUP_PHASE == 9
    GRID_BAR(); p_prologue(F);
#endif
#endif
    GRID_BAR();

    for (int l = 0; l < DEPTH; ++l) {
#if PH_EN(1)
        DUP_BEGIN(1)
        {
            PHASE_PTRS();
            pg8::Gemm g{(const bf16*)(ws_ + WS_XB), (const bf16*)(ws_ + WS_WIN) + (size_t)l * NU * DM, M, NU, DM, DM}; pg8::StaticOrder S; S.init(M, NU, F.G, (int)blockIdx.x);
            pg8::EpiIn E{UB, SSQQ, SSQKV, KRB, cosT, sinT, QSCALE_64, (const float*)(ws_ + WS_RSTD)};
            pg8::gemm_phase<pg8::EpiIn, pg8::StaticOrder, true, true>(F.lds + RING_OFF, g, S, E);
        }
        DUP_END(1)
#endif
        GRID_BAR();
        if (args.mode == 2) return;
        DUP_BEGIN(2)
#if PH_EN(2)
        {
            PHASE_PTRS();
            pg8::Gemm g{UB, (const bf16*)(ws_ + WS_WQ2) + (size_t)l * 512 * 256, M, 512, 256, NU}; pg8::StaticOrder S; S.init(M, 512, F.G, (int)blockIdx.x);
            pg8::EpiQ E{QAB, SSQQ, cosT, sinT, QSCALE_96, NORM_EPS};
            pg8::gemm_phase<pg8::EpiQ, pg8::StaticOrder, true, true>(F.lds + RING_OFF, g, S, E);
        }
        __syncthreads();
#endif
#if PH_EN(8)
        {
            PHASE_PTRS();
            pg8::Gemm g{UB + 256, (const bf16*)(ws_ + WS_WKV2) + (size_t)l * 512 * 256, M, 512, 256, NU}; pg8::StaticOrder S; S.init(M, 512, F.G, (int)blockIdx.x);
            pg8::EpiKV E{KVAB, SSQKV, NORM_EPS};
            pg8::gemm_phase<pg8::EpiKV, pg8::StaticOrder, true, true>(F.lds + RING_OFF, g, S, E);
        }
        __syncthreads();
#endif
#if PH_EN(3)
        for (int u = blockIdx.x; u < M / 64; u += F.G) conv_unit(F, l, u);
        for (int it = blockIdx.x; it < BATCH * 16; it += F.G) kmean_unit(F, it);
#endif
        DUP_END(2)
        GRID_BAR();
        DUP_BEGIN(3)
#if PH_EN(4)
        {
            PHASE_PTRS();
            pg8::Gemm g{CHB, (const bf16*)(ws_ + WS_WPW) + (size_t)l * 256 * 256, M, 256, 256, 256}; pg8::StaticOrder S; S.init(M, 256, F.G, (int)blockIdx.x);
            pg8::EpiPW E{HNY, UB, F.in[13] + l * 256};
            pg8::gemm_phase<pg8::EpiPW, pg8::StaticOrder, true, true>(F.lds + RING_OFF, g, S, E);
        }
        __syncthreads();
#endif
#if PH_EN(5)
        {
            PHASE_PTRS();
            const att::Tensors AT{UB, QAB, KVAB, KRB, HNY, (const float*)(ws_ + WS_BT), (const float*)(ws_ + WS_KMEAN), 1024, 0};
            const int x0 = (int)(xb_xcc_id() & 7u);
            int xcur = x0;
            gu32* const qbase = F.ctl + CW_QUEUE + (l * 8) * 64 + 16 * DUP_REP;
            gu32* qctr = qbase + x0 * 64;
            for (;;) {
                if (F.tid == 0) F.MISC[16] = __hip_atomic_fetch_add(qctr, 1u, RLX_AGENT);
                __syncthreads();
                const int idx = (int)F.MISC[16];
                if (idx >= 192) {
                    __syncthreads();
                    { int t8 = (int)threadIdx.x; asm volatile("" : "+v"(t8));
                      if (t8 < 8) F.MISC[24 + t8] = __hip_atomic_load(qbase + t8 * 64, RLX_AGENT); }
                    __syncthreads();
                    int best = -1; unsigned bv = 192u;
#pragma unroll
                    for (int j = 0; j < 8; ++j) { const unsigned v = F.MISC[24 + j]; if (v < bv) { bv = v; best = j; } }
                    __syncthreads();
                    best = __builtin_amdgcn_readfirstlane(best);
                    if (best < 0) break;
                    xcur = best; qctr = qbase + best * 64; continue;
                }
                int type, qb, bh;
                if (idx < 128) { const int g = idx >> 5, j = idx & 31; type = (j < 16) ? 0 : 2; qb = 15 - (j & 15); bh = xcur * 4 + g; }
                else { const int s = idx - 128; type = 1; qb = 15 - (s & 15); bh = xcur * 4 + (s >> 4); }
                const int b = bh >> 2, h = bh & 3;
#if defined(DUP_TYPE)
                if (DUP_REP == 1 && type != DUP_TYPE) { __syncthreads(); continue; }
#endif
#if defined(CMP_TUNED)
                if (DUP_REP == 1) { if (type == 2 && l == 0) { att::Tensors A2 = AT; A2.Y = QAB; A2.ypitch = 256; A2.ysub = 512; att::moba_unit_tuned(A2, b, h, qb, (LAS char*)(F.lds + RING_OFF), lds0 + RING_OFF); } else __syncthreads(); continue; }
#endif
#if defined(DUP_KNOB)
                if (DUP_REP == 1) { att::attn_unit<DUP_TYPE, DUP_KNOB>(AT, b, h, qb, (LAS char*)(F.lds + RING_OFF), lds0 + RING_OFF, whalf); continue; }
#endif
#if defined(TUNED_MLA)
                if (type == 0) att::mla_unit_tuned(AT, b, h, qb, (LAS char*)(F.lds + RING_OFF), lds0 + RING_OFF);
#else
                if (type == 0) att::attn_unit<0>(AT, b, h, qb, (LAS char*)(F.lds + RING_OFF), lds0 + RING_OFF, whalf);
#endif
#if !defined(TUNED_MOBA)
                else if (type == 2) att::attn_unit<2>(AT, b, h, qb, (LAS char*)(F.lds + RING_OFF), lds0 + RING_OFF, whalf);
#else
#if defined(TUNED_QB_LO)
                else if (type == 2 && qb >= TUNED_QB_LO && qb <= TUNED_QB_HI) att::moba_unit_tuned(AT, b, h, qb, (LAS char*)(F.lds + RING_OFF), lds0 + RING_OFF);
                else if (type == 2) att::attn_unit<2>(AT, b, h, qb, (LAS char*)(F.lds + RING_OFF), lds0 + RING_OFF, whalf);
#else
                else if (type == 2) att::moba_unit_tuned(AT, b, h, qb, (LAS char*)(F.lds + RING_OFF), lds0 + RING_OFF);
#endif
#endif
#if defined(SB_RES)
                else att::sb_unit_res(AT, b, h, qb, (LAS char*)(F.lds + RING_OFF), lds0 + RING_OFF, (LAS unsigned*)(F.MISC + 48));
#else
                else att::attn_unit<1>(AT, b, h, qb, (LAS char*)(F.lds + RING_OFF), lds0 + RING_OFF, whalf);
#endif
            }
        }
#endif
        DUP_END(3)
        GRID_BAR();
#if defined(CMP_TUNED)
        if (l == 0) {
            PHASE_PTRS();
            float best = 0.f;
            int t_ = threadIdx.x; asm volatile("" : "+v"(t_)); const int lane_ = t_ & 63; const int gw_ = blockIdx.x * NWAVES + __builtin_amdgcn_readfirstlane(t_ >> 6);
            for (int m = gw_; m < M; m += F.NGW) {
                float num = 0.f, den = 0.f;
#pragma unroll
                for (int j = 0; j < 4; ++j) { const float ya = __uint_as_float(((unsigned)HNY[(size_t)m * 1024 + 512 + lane_ * 4 + j]) << 16), yb = __uint_as_float(((unsigned)QAB[(size_t)m * 256 + lane_ * 4 + j]) << 16);
                    num += (ya - yb) * (ya - yb); den += ya * ya; }
#pragma unroll
                for (int o = 1; o < 16; o <<= 1) { num += __shfl_xor(num, o); den += __shfl_xor(den, o); }
                float e = sqrtf(num) / (sqrtf(den) + 1e-4f); if (!(e == e)) e = 1000.f;
#if CMP_TUNED == 2
                e = (e > 0.05f) ? (float)(1 + (m & 4095)) : 0.f;
#endif
                best = fmaxf(best, e);
            }
#pragma unroll
            for (int o = 1; o < 64; o <<= 1) best = fmaxf(best, __shfl_xor(best, o));
            if (lane_ == 0) atomicMax((unsigned*)(F.ctl + 12290), __float_as_uint(best));
        }
#endif
        if (args.mode == 1) return;
#if PH_EN(6)
        DUP_BEGIN(4)
        {
            PHASE_PTRS();
            pg8::Gemm g{HNY, (const bf16*)(ws_ + WS_WOUT) + (size_t)l * DM * DM, M, DM, DM, DM}; pg8::StaticOrderT<8> S; S.init(M, DM, F.G, (int)blockIdx.x);
            pg8::EpiOut E{UB, SSQO};
            pg8::gemm_phase<pg8::EpiOut, pg8::StaticOrderT<8>, true, true>(F.lds + RING_OFF, g, S, E);
        }
        DUP_END(4)
#endif
        GRID_BAR();
#if PH_EN(7)
        p_residual(F, l);
#if DUP_PHASE == 5
        if (l == 0) { GRID_BAR(); p_residual(F, l); }
#endif
#if DUP_PHASE == 6
        GRID_BAR(); GRID_BAR(); GRID_BAR(); GRID_BAR();
#endif
#endif
        if (l + 1 < DEPTH) GRID_BAR();
    }
#if defined(CMP_TUNED)
    GRID_BAR();
    { const float e = __uint_as_float(__hip_atomic_load(F.ctl + 12290, RLX_AGENT));
#if CMP_TUNED == 1
      const float sc = 1.0f + fminf(e, 3.0f);
#else
      const float sc = 1.0f + e / 4096.0f;
#endif
      for (size_t i = (size_t)blockIdx.x * NTHREADS + threadIdx.x; i < (size_t)M * DM; i += (size_t)F.G * NTHREADS) F.out[i] *= sc; }
#endif
}

#if defined(DBG_SEL)
__global__ void __launch_bounds__(NTHREADS, 1) dbg_kernel(Args args, int which) {
    extern __shared__ __attribute__((aligned(16))) unsigned char lds[];
    Frame F; F.lds = (LAS unsigned char*)lds; F.MISC = nullptr; F.tid = threadIdx.x; F.lane = F.tid & 63; F.wave = F.tid >> 6; F.G = gridDim.x; F.gw = 0; F.NGW = 0;
    for (int i = 0; i < 16; ++i) F.in[i] = args.in[i];
    F.out = args.out; F.ws = args.ws; F.ctl = (gu32*)(args.ws + WS_CTL);
    if (which == 0) dbg_check_u(F, 0);
    else if (which == 1) dbg_check(F, 0);
    else { const float e = __uint_as_float(__hip_atomic_load(F.ctl + CW_DBG, RLX_AGENT)); const float sc = 1.0f + fminf(2.0f, DBG_AMP * e);
      for (size_t i = (size_t)blockIdx.x * NTHREADS + threadIdx.x; i < (size_t)M * DM; i += (size_t)F.G * NTHREADS) F.out[i] *= sc; }
}
#endif
extern "C" void kernel_launch(void* const* d_in, const int* in_sizes, int n_in, void* d_out, int out_size, void* d_ws, size_t ws_size, hipStream_t stream) {
    static int grid = 0;
    if (grid == 0) {
        if (n_in != 16 || in_sizes[0] != M * DM || out_size != M * DM || ws_size < WS_END) { fprintf(stderr, "kernel_launch: unexpected shapes (n_in %d, in0 %d, out %d, ws %zu < %zu); nothing launched\n", n_in, n_in > 0 ? in_sizes[0] : -1, out_size, ws_size, (size_t)WS_END); grid = -1; return; }
        int dev = 0, cus = 0, per_cu = 0;
        if (hipGetDevice(&dev) != hipSuccess || hipDeviceGetAttribute(&cus, hipDeviceAttributeMultiprocessorCount, dev) != hipSuccess) { grid = -1; return; }
        if (hipFuncSetAttribute((const void*)hymba_fwd, hipFuncAttributeMaxDynamicSharedMemorySize, LDS_BYTES) != hipSuccess) { fprintf(stderr, "kernel_launch: hipFuncSetAttribute failed\n"); grid = -1; return; }
        if (hipOccupancyMaxActiveBlocksPerMultiprocessor(&per_cu, (const void*)hymba_fwd, NTHREADS, LDS_BYTES) != hipSuccess || per_cu < 1) fprintf(stderr, "kernel_launch: occupancy query reports %d\n", per_cu);
        (void)hipGetLastError();
        grid = cus;
    }
    if (grid < 0) return;
    if (hipMemsetAsync((char*)d_ws + WS_CTL, 0, CTL_ZERO_BYTES, stream) != hipSuccess) return;
    Args a{};
    for (int i = 0; i < 16; ++i) a.in[i] = (const float*)d_in[i];
    a.out = (float*)d_out; a.ws = (unsigned char*)d_ws; a.mode = 0; a.pad = 0;
#if defined(DBG_SEL)
    hipFuncSetAttribute((const void*)dbg_kernel, hipFuncAttributeMaxDynamicSharedMemorySize, LDS_BYTES);
    if ((DBG_SEL >> 3) & 1) { a.mode = 2; hipLaunchKernelGGL(hymba_fwd, dim3(grid), dim3(NTHREADS), LDS_BYTES, stream, a); hipLaunchKernelGGL(dbg_kernel, dim3(grid), dim3(NTHREADS), LDS_BYTES, stream, a, 0); hipMemsetAsync((char*)d_ws + WS_CTL, 0, 49152, stream); }
    if (DBG_SEL & 7) { a.mode = 1; hipLaunchKernelGGL(hymba_fwd, dim3(grid), dim3(NTHREADS), LDS_BYTES, stream, a); hipLaunchKernelGGL(dbg_kernel, dim3(grid), dim3(NTHREADS), LDS_BYTES, stream, a, 1); hipMemsetAsync((char*)d_ws + WS_CTL, 0, 49152, stream); }
    a.mode = 0;
    hipLaunchKernelGGL(hymba_fwd, dim3(grid), dim3(NTHREADS), LDS_BYTES, stream, a);
    hipLaunchKernelGGL(dbg_kernel, dim3(grid), dim3(NTHREADS), LDS_BYTES, stream, a, 2);
#else
    hipLaunchKernelGGL(hymba_fwd, dim3(grid), dim3(NTHREADS), LDS_BYTES, stream, a);
#endif
}
```
